# Optimizing an MI355X kernel written in HIP

```python
import math
import jax
import jax.numpy as jnp
from jax import lax
import numpy as np

D_MODEL = 1024
BATCH = 8
SEQ = 2048
DEPTH = 4

GRID_W = 64
CTX_LEN = 256
HEAD_DIM = 64
ROPE_THETA = 10000.0
Q_BLOCK = 128
RMS_EPS = 1e-6
SUBLN_EPS = 1e-5

A_HEADS = D_MODEL // (2 * HEAD_DIM)
A_KV_HEADS = A_HEADS // 4
A_WIDTH = A_HEADS * HEAD_DIM
A_KV_WIDTH = A_KV_HEADS * HEAD_DIM
A_COLS = A_WIDTH + 2 * A_KV_WIDTH

B_HEADS = D_MODEL // (2 * HEAD_DIM)
B_WIDTH = B_HEADS * HEAD_DIM
RWKV_W_LORA = 64
RWKV_A_LORA = 64
RWKV_V_LORA = 32
RWKV_G_LORA = 128
RWKV_GN_EPS = 64e-5
DECAY_SCALE = math.exp(-0.5)
B_SPLITS = (B_WIDTH, 2 * B_WIDTH, 3 * B_WIDTH, 3 * B_WIDTH + RWKV_W_LORA,
            3 * B_WIDTH + RWKV_W_LORA + RWKV_A_LORA)
B_COLS = 3 * B_WIDTH + RWKV_W_LORA + RWKV_A_LORA + RWKV_G_LORA
EVEN_COLS = A_COLS + B_COLS

C_HEADS = D_MODEL // (2 * HEAD_DIM)
C_QK = C_HEADS * 2 * HEAD_DIM
ODD_COLS = 2 * C_QK + C_HEADS * 2 * HEAD_DIM

N_GROUPS = 4
EXPERTS_PER_GROUP = 8
N_EXPERTS = N_GROUPS * EXPERTS_PER_GROUP
TOP_K = 2
EXPERT_HIDDEN = D_MODEL // 2
EXPERT_BLOCK = 128

N_EVEN = (DEPTH + 1) // 2
N_ODD = DEPTH // 2

kernel_name = 'hybrid_gqa_rwkv7_diffattn_hmoe_dit'


def rms_norm(x, gain=None, eps=RMS_EPS):
    xf = x.astype(jnp.float32)
    y = xf * lax.rsqrt(jnp.mean(xf * xf, axis=-1, keepdims=True) + eps)
    if gain is not None:
        y = y * gain.astype(jnp.float32)
    return y.astype(x.dtype)


def modulate(h, shift, scale):
    return h * (1.0 + scale) + shift


def axial_rope_tables(rows):
    nf = HEAD_DIM // 4
    inv = ROPE_THETA ** (-jnp.arange(nf, dtype=jnp.float32) / nf)
    r_idx = jnp.repeat(jnp.arange(rows, dtype=jnp.float32), GRID_W)
    c_idx = jnp.tile(jnp.arange(GRID_W, dtype=jnp.float32), rows)
    ang = jnp.concatenate([r_idx[:, None] * inv, c_idx[:, None] * inv], axis=-1)
    return jnp.cos(ang), jnp.sin(ang)


def apply_axial_rope(x, cos, sin):
    shp = x.shape
    nf = shp[-1] // 4
    n_head_axes = x.ndim - 3
    xr = x.astype(jnp.float32).reshape(*shp[:-1], 2, 2, nf)
    cs = cos.reshape(cos.shape[0], *([1] * n_head_axes), 2, nf)
    sn = sin.reshape(sin.shape[0], *([1] * n_head_axes), 2, nf)
    x1, x2 = xr[..., 0, :], xr[..., 1, :]
    out = jnp.stack([x1 * cs - x2 * sn, x1 * sn + x2 * cs], axis=-2)
    return out.reshape(shp).astype(x.dtype)


def sweep_query_blocks(attend, q):
    b, t = q.shape[:2]
    nblk = t // Q_BLOCK
    qb = jnp.moveaxis(q.reshape(b, nblk, Q_BLOCK, *q.shape[2:]), 1, 0)
    ob = jnp.moveaxis(lax.map(attend, qb), 0, 1)
    return ob.reshape(b, t, *ob.shape[3:])


def gqa_project(pa, q_gain, k_gain):
    b, t, _ = pa.shape
    q = pa[..., :A_WIDTH].reshape(b, t, A_KV_HEADS, A_HEADS // A_KV_HEADS, HEAD_DIM)
    k = pa[..., A_WIDTH:A_WIDTH + A_KV_WIDTH].reshape(b, t, A_KV_HEADS, HEAD_DIM)
    v = pa[..., A_WIDTH + A_KV_WIDTH:].reshape(b, t, A_KV_HEADS, HEAD_DIM)
    return rms_norm(q, q_gain), rms_norm(k, k_gain), v


def gqa_attend(q, k, v):
    s = jnp.einsum('bqhgd,bkhd->bhgqk', q, k, preferred_element_type=jnp.float32) * HEAD_DIM ** -0.5
    p = jax.nn.softmax(s, axis=-1).astype(v.dtype)
    return jnp.einsum('bhgqk,bkhd->bqhgd', p, v)


def token_shift(u, mu_prev, mu_next):
    zero = jnp.zeros_like(u[:, :1])
    prev = jnp.concatenate([zero, u[:, :-1]], axis=1)
    nxt = jnp.concatenate([u[:, 1:], zero], axis=1)
    return u + mu_prev * (prev - u) + mu_next * (nxt - u)


def rwkv_prepare(u, v_first, p):
    b, t, _ = u.shape
    u = token_shift(u, p['mu_prev'], p['mu_next'])
    r, k, v, wlr, alr, glr = jnp.split(u, B_SPLITS, axis=-1)
    if v_first is None:
        v_first = v
    else:
        v = v + (v_first - v) * jax.nn.sigmoid(p['v0'] + (v @ p['v1']) @ p['v2'])
    heads = lambda z: z.astype(jnp.float32).reshape(b, t, B_HEADS, HEAD_DIM)
    kk = heads(k * p['k_k'])
    kk = kk / jnp.maximum(jnp.linalg.norm(kk, axis=-1, keepdims=True), 1e-12)
    k_a = p['k_a'].astype(jnp.float32).reshape(B_HEADS, HEAD_DIM)
    tw = jnp.tanh(wlr)
    dirs = []
    for dr in range(2):
        w = jnp.exp(-DECAY_SCALE * jax.nn.sigmoid(heads(p['w0'][dr] + tw @ p['w2'][dr])))
        a = jax.nn.sigmoid(heads(p['a0'][dr] + alr @ p['a2'][dr]))
        kd = heads(k) * (1.0 + (a - 1.0) * k_a)
        dirs.append({'w': w, 'a': a, 'k': kd})
    g = jax.nn.sigmoid(glr) @ p['g2']
    return {'r': heads(r), 'v': heads(v), 'kk': kk, 'g': g, 'dirs': dirs}, v_first


def delta_scan(s0, seq, dr, reverse):
    dd = seq['dirs'][dr]
    xs = tuple(jnp.moveaxis(z, 1, 0) for z in (seq['r'], dd['w'], dd['k'], seq['v'], seq['kk'], dd['a']))

    def step(s, inp):
        r_t, w_t, k_t, v_t, kk_t, a_t = inp
        s_kk = jnp.einsum('bhvk,bhk->bhv', s, kk_t)
        s = (s * w_t[:, :, None, :] - s_kk[..., None] * (kk_t * a_t)[:, :, None, :]
             + v_t[..., None] * k_t[:, :, None, :])
        return s, jnp.einsum('bhvk,bhk->bhv', s, r_t)

    s_last, ys = lax.scan(step, s0, xs, reverse=reverse)
    return s_last, jnp.moveaxis(ys, 0, 1)


def rwkv_readout(y, seq, p):
    b, t = y.shape[:2]
    mu = jnp.mean(y, axis=-1, keepdims=True)
    var = jnp.mean(jnp.square(y - mu), axis=-1, keepdims=True)
    gn_w = p['gn_w'].astype(jnp.float32).reshape(B_HEADS, HEAD_DIM)
    gn_b = p['gn_b'].astype(jnp.float32).reshape(B_HEADS, HEAD_DIM)
    y = (y - mu) * lax.rsqrt(var + RWKV_GN_EPS) * gn_w + gn_b
    r_k = p['r_k'].astype(jnp.float32)
    for dd in seq['dirs']:
        y = y + jnp.sum(seq['r'] * dd['k'] * r_k, axis=-1, keepdims=True) * seq['v']
    g = seq['g']
    return (y.reshape(b, t, B_WIDTH) * g.astype(jnp.float32)).astype(g.dtype)


def rwkv_mix(u_lat, u_ctx, v_first, p):
    vf_lat, vf_ctx = (None, None) if v_first is None else v_first
    lat, vf_lat = rwkv_prepare(u_lat, vf_lat, p)
    ctx, vf_ctx = rwkv_prepare(u_ctx, vf_ctx, p)
    s0 = jnp.zeros((u_lat.shape[0], B_HEADS, HEAD_DIM, HEAD_DIM), jnp.float32)
    y_lat = 0.0
    y_ctx = 0.0
    for dr, reverse in enumerate((False, True)):
        s_ctx, yc = delta_scan(s0, ctx, dr, reverse)
        _, yl = delta_scan(s_ctx, lat, dr, reverse)
        y_lat = y_lat + yl
        y_ctx = y_ctx + yc
    return rwkv_readout(y_lat, lat, p), rwkv_readout(y_ctx, ctx, p), (vf_lat, vf_ctx)


def even_mixer(hl, hc, v_first, p, cos, sin):
    b, t, _ = hl.shape
    pl = hl @ p['w_in']
    pc = hc @ p['w_in']
    ql, kl, vl = gqa_project(pl[..., :A_COLS], p['q_gain'], p['k_gain'])
    qc, kc, vc = gqa_project(pc[..., :A_COLS], p['q_gain'], p['k_gain'])
    ql = apply_axial_rope(ql, cos, sin)
    kl = apply_axial_rope(kl, cos, sin)
    k_all = jnp.concatenate([kc, kl], axis=1)
    v_all = jnp.concatenate([vc, vl], axis=1)
    al = sweep_query_blocks(lambda qb: gqa_attend(qb, k_all, v_all), ql).reshape(b, t, A_WIDTH)
    ac = gqa_attend(qc, kc, vc).reshape(b, hc.shape[1], A_WIDTH)
    bl, bc, v_first = rwkv_mix(pl[..., A_COLS:], pc[..., A_COLS:], v_first, p)
    out_l = jnp.concatenate([al, bl], axis=-1) @ p['w_out']
    out_c = jnp.concatenate([ac, bc], axis=-1) @ p['w_out']
    return out_l, out_c, v_first


def diff_attend(q, k, v, lam):
    s = jnp.einsum('bqhcd,bkhcd->bhcqk', q, k, preferred_element_type=jnp.float32) * HEAD_DIM ** -0.5
    pr = jax.nn.softmax(s, axis=-1)
    pr = pr[:, :, 0] - lam * pr[:, :, 1]
    return jnp.einsum('bhqk,bkhe->bqhe', pr.astype(v.dtype), v)


def diff_mixer(hl, hc, p, lambda_init, cos, sin, need_ctx):
    def split_q(z):
        return z.reshape(*z.shape[:2], C_HEADS, 2, HEAD_DIM)

    def split_kv(z):
        k = z[..., :C_QK].reshape(*z.shape[:2], C_HEADS, 2, HEAD_DIM)
        v = z[..., C_QK:].reshape(*z.shape[:2], C_HEADS, 2 * HEAD_DIM)
        return k, v

    def finish(o):
        o = rms_norm(o, p['subln'], SUBLN_EPS) * (1.0 - lambda_init)
        return o.reshape(*o.shape[:2], C_HEADS * 2 * HEAD_DIM) @ p['w_out']

    pl = hl @ p['w_in']
    ql = apply_axial_rope(split_q(pl[..., :C_QK]), cos, sin)
    kl, vl = split_kv(pl[..., C_QK:])
    kl = apply_axial_rope(kl, cos, sin)
    kc, vc = split_kv(hc @ p['w_in'][:, C_QK:])
    f32 = jnp.float32
    lam = (jnp.exp(jnp.sum(p['lq1'].astype(f32) * p['lk1'].astype(f32)))
           - jnp.exp(jnp.sum(p['lq2'].astype(f32) * p['lk2'].astype(f32))) + lambda_init)
    k_all = jnp.concatenate([kc, kl], axis=1)
    v_all = jnp.concatenate([vc, vl], axis=1)
    out_l = finish(sweep_query_blocks(lambda qb: diff_attend(qb, k_all, v_all, lam), ql))
    if not need_ctx:
        return out_l, None
    qc = split_q(hc @ p['w_in'][:, :C_QK])
    return out_l, finish(diff_attend(qc, kc, vc, lam))


def grouped_expert_mlp(h, expert_id, w_gate, w_up, w_down):
    n, d = h.shape
    k = expert_id.shape[1]
    m = n * k
    e_flat = expert_id.reshape(m)
    tok = jnp.arange(m, dtype=jnp.int32) // k
    counts = jnp.bincount(e_flat, length=N_EXPERTS).astype(jnp.int32)
    padded = (counts + EXPERT_BLOCK - 1) // EXPERT_BLOCK * EXPERT_BLOCK
    pad_end = jnp.cumsum(padded)
    pad_start = pad_end - padded
    raw_start = jnp.cumsum(counts) - counts
    order = jnp.argsort(e_flat)
    e_sorted = e_flat[order]
    slot_sorted = pad_start[e_sorted] + jnp.arange(m, dtype=jnp.int32) - raw_start[e_sorted]
    n_blocks = -(-(m + N_EXPERTS * (EXPERT_BLOCK - 1)) // EXPERT_BLOCK)
    slot_tok = jnp.full((n_blocks * EXPERT_BLOCK,), n, jnp.int32).at[slot_sorted].set(tok[order])
    block_start = jnp.arange(n_blocks, dtype=jnp.int32) * EXPERT_BLOCK
    block_expert = jnp.minimum(jnp.searchsorted(pad_end, block_start, side='right'), N_EXPERTS - 1)
    h_pad = jnp.concatenate([h, jnp.zeros((1, d), h.dtype)], axis=0)
    xb = h_pad[slot_tok].reshape(n_blocks, EXPERT_BLOCK, d)

    def run_block(args):
        xblk, e = args
        return (jax.nn.silu(xblk @ w_gate[e]) * (xblk @ w_up[e])) @ w_down[e]

    yb = lax.map(run_block, (xb, block_expert)).reshape(n_blocks * EXPERT_BLOCK, d)
    slot = jnp.zeros((m,), jnp.int32).at[order].set(slot_sorted)
    return yb[slot].reshape(n, k, d)


def moe_ffn(h, w_grp, b_grp, w_rt, b_rt, w_gate, w_up, w_down):
    n = h.shape[0]
    f32 = jnp.float32
    hf = h.astype(f32)
    grp_logits = hf @ w_grp.astype(f32) + b_grp.astype(f32)
    grp_sel = jnp.argmax(grp_logits, axis=-1)
    grp_w = jnp.take_along_axis(jax.nn.softmax(grp_logits, axis=-1), grp_sel[:, None], axis=1)
    exp_logits = (hf @ w_rt.astype(f32) + b_rt.astype(f32)).reshape(n, N_GROUPS, EXPERTS_PER_GROUP)
    exp_logits = jnp.take_along_axis(exp_logits, grp_sel[:, None, None], axis=1)[:, 0]
    top_p, top_i = lax.top_k(jax.nn.softmax(exp_logits, axis=-1), TOP_K)
    gates = grp_w * top_p / jnp.sum(top_p, axis=-1, keepdims=True)
    expert_id = (grp_sel[:, None] * EXPERTS_PER_GROUP + top_i).astype(jnp.int32)
    y = grouped_expert_mlp(h, expert_id, w_gate, w_up, w_down)
    return jnp.einsum('nk,nkd->nd', gates.astype(h.dtype), y)


def setup_inputs(seed: int = 0) -> dict:
    key = jax.random.key(seed)
    ks = iter(jax.random.split(key, 48))
    d = D_MODEL

    def nrm(shape, scale=1.0):
        return scale * jax.random.normal(next(ks), shape, jnp.float32)

    def unif(shape, lo, hi):
        return jax.random.uniform(next(ks), shape, jnp.float32, lo, hi)

    return {
        'x': nrm((BATCH, SEQ, d)),
        'c': nrm((BATCH, d)),
        'ctx': nrm((BATCH, CTX_LEN, d)),
        'c_ctx': nrm((d,)),
        'mod_w': nrm((DEPTH, d, 6 * d), 0.3 * d ** -0.5),
        'mod_b': nrm((DEPTH, 6 * d), 0.02),
        'ev_w_in': nrm((N_EVEN, d, EVEN_COLS), d ** -0.5),
        'ev_w_out': nrm((N_EVEN, A_WIDTH + B_WIDTH, d), (A_WIDTH + B_WIDTH) ** -0.5),
        'ev_q_gain': 1.0 + nrm((N_EVEN, HEAD_DIM), 0.05),
        'ev_k_gain': 1.0 + nrm((N_EVEN, HEAD_DIM), 0.05),
        'ev_mu_prev': unif((N_EVEN, B_COLS), 0.0, 0.5),
        'ev_mu_next': unif((N_EVEN, B_COLS), 0.0, 0.5),
        'ev_w0': -1.0 + nrm((N_EVEN, 2, B_WIDTH), 0.5),
        'ev_w2': nrm((N_EVEN, 2, RWKV_W_LORA, B_WIDTH), 0.5 * RWKV_W_LORA ** -0.5),
        'ev_a0': nrm((N_EVEN, 2, B_WIDTH), 0.5),
        'ev_a2': nrm((N_EVEN, 2, RWKV_A_LORA, B_WIDTH), 0.5 * RWKV_A_LORA ** -0.5),
        'ev_g2': nrm((N_EVEN, RWKV_G_LORA, B_WIDTH), RWKV_G_LORA ** -0.5),
        'ev_k_k': 0.85 + nrm((N_EVEN, B_WIDTH), 0.05),
        'ev_k_a': 1.0 + nrm((N_EVEN, B_WIDTH), 0.05),
        'ev_r_k': nrm((N_EVEN, B_HEADS, HEAD_DIM), 0.1),
        'ev_gn_w': 1.0 + nrm((N_EVEN, B_WIDTH), 0.05),
        'ev_gn_b': nrm((N_EVEN, B_WIDTH), 0.02),
        'ev_v0': nrm((N_EVEN - 1, B_WIDTH), 0.5),
        'ev_v1': nrm((N_EVEN - 1, B_WIDTH, RWKV_V_LORA), B_WIDTH ** -0.5),
        'ev_v2': nrm((N_EVEN - 1, RWKV_V_LORA, B_WIDTH), RWKV_V_LORA ** -0.5),
        'od_w_in': nrm((N_ODD, d, ODD_COLS), d ** -0.5),
        'od_w_out': nrm((N_ODD, C_HEADS * 2 * HEAD_DIM, d), d ** -0.5),
        'od_lq1': nrm((N_ODD, HEAD_DIM), 0.1),
        'od_lk1': nrm((N_ODD, HEAD_DIM), 0.1),
        'od_lq2': nrm((N_ODD, HEAD_DIM), 0.1),
        'od_lk2': nrm((N_ODD, HEAD_DIM), 0.1),
        'od_subln': 1.0 + nrm((N_ODD, 2 * HEAD_DIM), 0.05),
        'moe_w_grp': nrm((DEPTH, d, N_GROUPS), d ** -0.5),
        'moe_b_grp': nrm((DEPTH, N_GROUPS), 0.01),
        'moe_w_rt': nrm((DEPTH, d, N_EXPERTS), d ** -0.5),
        'moe_b_rt': nrm((DEPTH, N_EXPERTS), 0.01),
        'moe_w_gate': nrm((DEPTH, N_EXPERTS, d, EXPERT_HIDDEN), d ** -0.5),
        'moe_w_up': nrm((DEPTH, N_EXPERTS, d, EXPERT_HIDDEN), d ** -0.5),
        'moe_w_down': nrm((DEPTH, N_EXPERTS, EXPERT_HIDDEN, d), EXPERT_HIDDEN ** -0.5),
        'final_gain': 1.0 + nrm((d,), 0.05),
    }


def reference(x, c, ctx, c_ctx, mod_w, mod_b, ev_w_in, ev_w_out, ev_q_gain, ev_k_gain,
              ev_mu_prev, ev_mu_next, ev_w0, ev_w2, ev_a0, ev_a2, ev_g2, ev_k_k, ev_k_a, ev_r_k,
              ev_gn_w, ev_gn_b, ev_v0, ev_v1, ev_v2, od_w_in, od_w_out, od_lq1, od_lk1, od_lq2,
              od_lk2, od_subln, moe_w_grp, moe_b_grp, moe_w_rt, moe_b_rt, moe_w_gate, moe_w_up,
              moe_w_down, final_gain):
    bsz, n_lat, d = x.shape
    rows = n_lat // GRID_W
    cos, sin = axial_rope_tables(rows)
    cond_lat = jax.nn.silu(c)
    cond_ctx = jax.nn.silu(c_ctx)[None, :]
    xc = ctx
    v_first = None
    for layer in range(DEPTH):
        last = layer == DEPTH - 1
        mods_l = jnp.split((cond_lat @ mod_w[layer] + mod_b[layer])[:, None, :], 6, axis=-1)
        mods_c = jnp.split((cond_ctx @ mod_w[layer] + mod_b[layer])[:, None, :], 6, axis=-1)
        hl = modulate(rms_norm(x), mods_l[0], mods_l[1])
        hc = modulate(rms_norm(xc), mods_c[0], mods_c[1])
        if layer % 2 == 0:
            e = layer // 2
            p = {'w_in': ev_w_in[e], 'w_out': ev_w_out[e], 'q_gain': ev_q_gain[e],
                 'k_gain': ev_k_gain[e], 'mu_prev': ev_mu_prev[e], 'mu_next': ev_mu_next[e],
                 'w0': ev_w0[e], 'w2': ev_w2[e], 'a0': ev_a0[e], 'a2': ev_a2[e], 'g2': ev_g2[e],
                 'k_k': ev_k_k[e], 'k_a': ev_k_a[e], 'r_k': ev_r_k[e], 'gn_w': ev_gn_w[e],
                 'gn_b': ev_gn_b[e]}
            if e > 0:
                p['v0'] = ev_v0[e - 1]
                p['v1'] = ev_v1[e - 1]
                p['v2'] = ev_v2[e - 1]
            out_l, out_c, v_first = even_mixer(hl, hc, v_first, p, cos, sin)
        else:
            o = layer // 2
            p = {'w_in': od_w_in[o], 'w_out': od_w_out[o], 'lq1': od_lq1[o], 'lk1': od_lk1[o],
                 'lq2': od_lq2[o], 'lk2': od_lk2[o], 'subln': od_subln[o]}
            lambda_init = 0.8 - 0.6 * math.exp(-0.3 * layer)
            out_l, out_c = diff_mixer(hl, hc, p, lambda_init, cos, sin, not last)
        x = x + mods_l[2] * out_l
        hl = modulate(rms_norm(x), mods_l[3], mods_l[4])
        moe_p = (moe_w_grp[layer], moe_b_grp[layer], moe_w_rt[layer], moe_b_rt[layer],
                 moe_w_gate[layer], moe_w_up[layer], moe_w_down[layer])
        if last:
            x = x + mods_l[5] * moe_ffn(hl.reshape(-1, d), *moe_p).reshape(x.shape)
        else:
            xc = xc + mods_c[2] * out_c
            hc = modulate(rms_norm(xc), mods_c[3], mods_c[4])
            n_ctx = hc.shape[0] * hc.shape[1]
            y = moe_ffn(jnp.concatenate([hc.reshape(-1, d), hl.reshape(-1, d)], axis=0), *moe_p)
            xc = xc + mods_c[5] * y[:n_ctx].reshape(xc.shape)
            x = x + mods_l[5] * y[n_ctx:].reshape(x.shape)
    return rms_norm(x, final_gain)
```

```cpp
#include <hip/hip_runtime.h>
#include <stdint.h>
#include <stdio.h>

#ifndef ONE_LAUNCH
#define ONE_LAUNCH 0
#endif

typedef _Float16 half_t;
typedef _Float16 h4_t __attribute__((ext_vector_type(4)));
typedef _Float16 h8_t __attribute__((ext_vector_type(8)));

constexpr int D = 1024, NB = 8, NLAT = 2048, NCTX = 256, SEQA = NLAT + NCTX  , M = NB * SEQA  ;
constexpr int DEPTH = 4;
constexpr int EVEN_COLS = 2560, ODD_COLS = 3072;
constexpr int NEXP = 32, EH = 512;
constexpr int LISTCAP = 36864, MAXSLOT = 40960;
constexpr float DECAY_SCALE = 0.60653065971263342f;
constexpr float GN_EPS = 64e-5f;
constexpr int NT = 256;
constexpr int LDS_BYTES = 65536;

constexpr size_t WS_BAR = 0;
constexpr size_t WS_CNT = 16384;
constexpr size_t WS_ZERO_BYTES = 32768;
constexpr size_t WS_MODS = 32768;
constexpr size_t WS_XS = 1u << 20;
constexpr size_t SZ_F32_1024 = (size_t)M * 1024 * 4;
constexpr size_t SZ_H16_1024 = (size_t)M * 1024 * 2;
constexpr size_t SZ_F32_512 = (size_t)M * 512 * 4;
constexpr size_t WS_H16 = WS_XS + SZ_F32_1024;
constexpr size_t WS_BIG = WS_H16 + SZ_H16_1024;
constexpr size_t SZ_BIG = (size_t)M * 3072 * 4;
constexpr size_t WS_Q16 = WS_BIG + SZ_BIG;
constexpr size_t WS_K16 = WS_Q16 + SZ_H16_1024;
constexpr size_t WS_V16 = WS_K16 + SZ_H16_1024;
constexpr size_t WS_MIX16 = WS_V16 + SZ_H16_1024;
constexpr size_t WS_SR = WS_MIX16 + SZ_H16_1024;
constexpr size_t WS_SV = WS_SR + SZ_F32_512;
constexpr size_t WS_SKK = WS_SV + SZ_F32_512;
constexpr size_t WS_SW = WS_SKK + SZ_F32_512;
constexpr size_t WS_SKA = WS_SW + 2 * SZ_F32_512;
constexpr size_t WS_SKD = WS_SKA + 2 * SZ_F32_512;
constexpr size_t WS_G = WS_SKD + 2 * SZ_F32_512;
constexpr size_t WS_VF = WS_G + SZ_F32_512;
constexpr size_t WS_BONUS = WS_VF + SZ_F32_512;
constexpr size_t WS_LIST = WS_BONUS + (size_t)M * 8 * 4;
constexpr size_t WS_GATE = WS_LIST + (size_t)NEXP * LISTCAP * 4;
constexpr size_t WS_ESLOT = WS_GATE + (size_t)M * 2 * 4;
constexpr size_t WS_END = WS_ESLOT + (size_t)M * 2 * 4;
constexpr size_t WS_YSC = WS_BIG;
constexpr size_t WS_ATT32 = WS_BIG;
constexpr size_t WS_HM16 = WS_BIG;
constexpr size_t WS_YOUT = WS_BIG + (size_t)MAXSLOT * 512 * 2;
static_assert(WS_YOUT + (size_t)MAXSLOT * 1024 * 4 <= WS_BIG + SZ_BIG, "BIG region too small");
static_assert(WS_END < (size_t)1000 * 1000 * 1000, "workspace too large");

struct Params {
    const float *x, *c, *ctx, *c_ctx, *mod_w, *mod_b, *ev_w_in, *ev_w_out, *ev_q_gain, *ev_k_gain, *ev_mu_prev, *ev_mu_next, *ev_w0, *ev_w2,
        *ev_a0, *ev_a2, *ev_g2, *ev_k_k, *ev_k_a, *ev_r_k, *ev_gn_w, *ev_gn_b, *ev_v0, *ev_v1, *ev_v2, *od_w_in, *od_w_out, *od_lq1, *od_lk1,
        *od_lq2, *od_lk2, *od_subln, *moe_w_grp, *moe_b_grp, *moe_w_rt, *moe_b_rt, *moe_w_gate, *moe_w_up, *moe_w_down, *final_gain;
    float* out;
    unsigned char* ws;
};

__device__ __forceinline__ float wave_sum(float v) {
#pragma unroll
    for (int m = 32; m >= 1; m >>= 1) v += __shfl_xor(v, m, 64);
    return v;
}
__device__ __forceinline__ float sum16(float v) {
#pragma unroll
    for (int m = 8; m >= 1; m >>= 1) v += __shfl_xor(v, m, 64);
    return v;
}
__device__ __forceinline__ float sigmoidf_(float x) { return 1.f / (1.f + expf(-x)); }
__device__ __forceinline__ float siluf_(float x) { return x / (1.f + expf(-x)); }
__device__ __forceinline__ int mods_row(int r) { const int b = r / SEQA, s = r - b * SEQA; return s < NCTX ? 8 : b; }
__device__ __forceinline__ const float* mods_ptr(const Params& p, int layer, int mr, int chunk) {
    return (const float*)(p.ws + WS_MODS) + ((size_t)(layer * 9 + mr)) * 6144 + chunk * 1024;
}
template <class T> __device__ __forceinline__ T* wsp(const Params& p, size_t off) { return (T*)(p.ws + off); }

__device__ void phase_mods(const Params& p, int bid, int nb, unsigned char* smem) {
    float* cond = (float*)smem;
    float* part = cond + 9 * 1024;
    const int t = threadIdx.x;
    for (int i = t; i < 9 * 1024; i += NT) { const int r = i >> 10, d = i & 1023; const float v = (r < 8) ? p.c[r * 1024 + d] : p.c_ctx[d]; cond[i] = siluf_(v); }
    __syncthreads();
    float* mods = wsp<float>(p, WS_MODS);
    for (int item = bid; item < 512; item += nb) {
        const int layer = item >> 7, col0 = (item & 127) * 48;
        const int cq = t % 12, dg = t / 12;
        if (dg < 16) {
            float acc[9][4];
#pragma unroll
            for (int r = 0; r < 9; ++r)
#pragma unroll
                for (int j = 0; j < 4; ++j) acc[r][j] = 0.f;
            const float* W = p.mod_w + (size_t)layer * 1024 * 6144 + col0 + cq * 4;
            for (int i = 0; i < 64; ++i) {
                const int d = dg * 64 + i;
                const float4 w = *(const float4*)(W + (size_t)d * 6144);
#pragma unroll
                for (int r = 0; r < 9; ++r) { const float cv = cond[r * 1024 + d]; acc[r][0] += cv * w.x; acc[r][1] += cv * w.y; acc[r][2] += cv * w.z; acc[r][3] += cv * w.w; }
            }
#pragma unroll
            for (int r = 0; r < 9; ++r)
#pragma unroll
                for (int j = 0; j < 4; ++j) part[(dg * 9 + r) * 48 + cq * 4 + j] = acc[r][j];
        }
        __syncthreads();
        for (int o = t; o < 9 * 48; o += NT) {
            const int r = o / 48, cc = o % 48;
            float s = p.mod_b[layer * 6144 + col0 + cc];
            for (int g = 0; g < 16; ++g) s += part[(g * 9 + r) * 48 + cc];
            mods[((size_t)(layer * 9 + r)) * 6144 + col0 + cc] = s;
        }
        __syncthreads();
    }
}

__device__ void phase_copy(const Params& p, int bid, int nb) {
    float4* XS = wsp<float4>(p, WS_XS);
    for (size_t i = (size_t)bid * NT + threadIdx.x; i < (size_t)M * 256; i += (size_t)nb * NT) {
        const int r = (int)(i >> 8), c4 = (int)(i & 255);
        const int b = r / SEQA, s = r - b * SEQA;
        const float4* src = (s < NCTX) ? (const float4*)(p.ctx + ((size_t)(b * NCTX + s)) * 1024) : (const float4*)(p.x + ((size_t)(b * NLAT + s - NCTX)) * 1024);
        XS[i] = src[c4];
    }
}

__device__ __forceinline__ void norm_row_store(const Params& p, int layer, int r, int chunk_shift, const float4 (&v)[4], float ss, int lane, float* hbuf  ) {
    const float rstd = rsqrtf(ss * (1.f / 1024.f) + 1e-6f);
    const int mr = mods_row(r);
    const float4* sh = (const float4*)mods_ptr(p, layer, mr, chunk_shift);
    const float4* sc = (const float4*)mods_ptr(p, layer, mr, chunk_shift + 1);
    half_t* H = wsp<half_t>(p, WS_H16) + (size_t)r * 1024;
#pragma unroll
    for (int j = 0; j < 4; ++j) {
        const float4 a = sh[lane + 64 * j], b = sc[lane + 64 * j];
        float4 h;
        h.x = v[j].x * rstd * (1.f + b.x) + a.x; h.y = v[j].y * rstd * (1.f + b.y) + a.y;
        h.z = v[j].z * rstd * (1.f + b.z) + a.z; h.w = v[j].w * rstd * (1.f + b.w) + a.w;
        h4_t hh; hh.x = (half_t)h.x; hh.y = (half_t)h.y; hh.z = (half_t)h.z; hh.w = (half_t)h.w;
        *(h4_t*)(H + (lane + 64 * j) * 4) = hh;
        if (hbuf) *(float4*)(hbuf + (lane + 64 * j) * 4) = h;
    }
}
__device__ void phase_norm1(const Params& p, int layer, int bid, int nb) {
    const int wid = threadIdx.x >> 6, lane = threadIdx.x & 63;
    for (int r = bid * 4 + wid; r < M; r += nb * 4) {
        const float4* xr = (const float4*)(wsp<float>(p, WS_XS) + (size_t)r * 1024);
        float4 v[4]; float ss = 0.f;
#pragma unroll
        for (int j = 0; j < 4; ++j) { v[j] = xr[lane + 64 * j]; ss += v[j].x * v[j].x + v[j].y * v[j].y + v[j].z * v[j].z + v[j].w * v[j].w; }
        ss = wave_sum(ss);
        norm_row_store(p, layer, r, 0, v, ss, lane, nullptr);
    }
}

template <bool DUAL, class RowSrc, class Epi>
__device__ __forceinline__ void gemm_tile_simple(const half_t* __restrict__ A, int lda, RowSrc rowsrc, const float* __restrict__ B1, const float* __restrict__ B2, int ldb,
                                                 int K, Epi epi, unsigned char* smem) {
    float (*As)[68] = (float (*)[68])smem;
    float (*Bs)[68] = (float (*)[68])(smem + 16 * 68 * 4);
    float (*Bs2)[68] = (float (*)[68])(smem + 2 * 16 * 68 * 4);
    const int t = threadIdx.x, tx = t & 15, ty = t >> 4;
    const int arow = t >> 2, akq = (t & 3) * 4;
    const int bk = t >> 4, bn4 = (t & 15) * 4;
    const long asrc = rowsrc(arow);
    float acc[4][4], acc2[4][4];
#pragma unroll
    for (int i = 0; i < 4; ++i)
#pragma unroll
        for (int j = 0; j < 4; ++j) { acc[i][j] = 0.f; acc2[i][j] = 0.f; }
    for (int k0 = 0; k0 < K; k0 += 16) {
        h4_t av = {0, 0, 0, 0};
        if (asrc >= 0) av = *(const h4_t*)(A + (size_t)asrc * lda + k0 + akq);
        const float4 bv = *(const float4*)(B1 + (size_t)(k0 + bk) * ldb + bn4);
        float4 bv2 = make_float4(0, 0, 0, 0);
        if (DUAL) bv2 = *(const float4*)(B2 + (size_t)(k0 + bk) * ldb + bn4);
        __syncthreads();
        As[akq + 0][arow] = (float)av.x; As[akq + 1][arow] = (float)av.y; As[akq + 2][arow] = (float)av.z; As[akq + 3][arow] = (float)av.w;
        *(float4*)&Bs[bk][bn4] = bv;
        if (DUAL) *(float4*)&Bs2[bk][bn4] = bv2;
        __syncthreads();
#pragma unroll
        for (int k = 0; k < 16; ++k) {
            const float4 a = *(const float4*)&As[k][ty * 4];
            const float4 b = *(const float4*)&Bs[k][tx * 4];
            const float aa[4] = {a.x, a.y, a.z, a.w}, bb[4] = {b.x, b.y, b.z, b.w};
#pragma unroll
            for (int i = 0; i < 4; ++i)
#pragma unroll
                for (int j = 0; j < 4; ++j) acc[i][j] += aa[i] * bb[j];
            if (DUAL) {
                const float4 b2 = *(const float4*)&Bs2[k][tx * 4];
                const float cc[4] = {b2.x, b2.y, b2.z, b2.w};
#pragma unroll
                for (int i = 0; i < 4; ++i)
#pragma unroll
                    for (int j = 0; j < 4; ++j) acc2[i][j] += aa[i] * cc[j];
            }
        }
    }
#pragma unroll
    for (int i = 0; i < 4; ++i)
#pragma unroll
        for (int j = 0; j < 4; ++j) epi(ty * 4 + i, tx * 4 + j, acc[i][j], acc2[i][j]);
    __syncthreads();
}

template <int MODE>
__device__ void phase_gemm_dense(const Params& p, int layer, const half_t* A, const float* W, int N, int bid, int nb, unsigned char* smem) {
    const int ntn = N / 64, ntiles = (M / 64) * ntn;
    float* P32 = wsp<float>(p, WS_BIG);
    float* XS = wsp<float>(p, WS_XS);
    for (int tile = bid; tile < ntiles; tile += nb) {
        const int tm = tile / ntn, tn = tile % ntn;
        const int m0 = tm * 64, n0 = tn * 64;
        auto rowsrc = [=](int i) -> long { return m0 + i; };
        if (MODE == 0) {
            auto epi = [=](int i, int j, float v, float) { P32[(size_t)(m0 + i) * N + n0 + j] = v; };
            gemm_tile_simple<false>(A, 1024, rowsrc, W + n0, nullptr, N, 1024, epi, smem);
        } else {
            auto epi = [=](int i, int j, float v, float) {
                const int r = m0 + i, c = n0 + j;
                const float g = mods_ptr(p, layer, mods_row(r), 2)[c];
                XS[(size_t)r * 1024 + c] += g * v;
            };
            gemm_tile_simple<false>(A, 1024, rowsrc, W + n0, nullptr, N, 1024, epi, smem);
        }
    }
}

__device__ __forceinline__ float rope64(float v, int lane, int tpos) {
    const int axis = lane >> 5, half = (lane >> 4) & 1, f = lane & 15;
    const float pos = (float)(axis ? (tpos & 63) : (tpos >> 6));
    const float inv = powf(10000.0f, -(float)f / 16.0f);
    const float ang = pos * inv;
    const float cs = cosf(ang), sn = sinf(ang);
    const float other = __shfl_xor(v, 16, 64);
    return half == 0 ? (v * cs - other * sn) : (other * sn + v * cs);
}

__device__ void phase_prep_even(const Params& p, int layer, int bid, int nb, unsigned char* smem) {
    constexpr int TK = 4;
    const int e = layer >> 1;
    float* lin = (float*)smem;
    float* vbuf = lin + TK * 256;
    float* t1 = vbuf + TK * 512;
    const int t = threadIdx.x, wid = t >> 6, lane = t & 63;
    const float* P32 = wsp<float>(p, WS_BIG);
    half_t* Q16 = wsp<half_t>(p, WS_Q16); half_t* K16 = wsp<half_t>(p, WS_K16); half_t* V16 = wsp<half_t>(p, WS_V16);
    float* SR = wsp<float>(p, WS_SR); float* SV = wsp<float>(p, WS_SV); float* SKK = wsp<float>(p, WS_SKK);
    float* SW = wsp<float>(p, WS_SW); float* SKA = wsp<float>(p, WS_SKA); float* SKD = wsp<float>(p, WS_SKD);
    float* G = wsp<float>(p, WS_G); float* VF = wsp<float>(p, WS_VF); float* BONUS = wsp<float>(p, WS_BONUS);
    const float* qgain = p.ev_q_gain + e * 64; const float* kgain = p.ev_k_gain + e * 64;
    const float* mup = p.ev_mu_prev + e * 1792; const float* mun = p.ev_mu_next + e * 1792;
    for (int item = bid; item < M / TK; item += nb) {
        const int r0 = item * TK;
        for (int task = wid; task < 12 * TK; task += 4) {
            const int tok = task / 12, u = task % 12, r = r0 + tok, s = r % SEQA;
            float v = P32[(size_t)r * EVEN_COLS + u * 64 + lane];
            if (u < 10) {
                const float ss = wave_sum(v * v);
                v = v * rsqrtf(ss * (1.f / 64.f) + 1e-6f) * (u < 8 ? qgain[lane] : kgain[lane]);
                if (s >= NCTX) v = rope64(v, lane, s - NCTX);
                if (u < 8) v *= 0.125f;
            }
            if (u < 8) Q16[(size_t)r * 512 + u * 64 + lane] = (half_t)v;
            else if (u < 10) K16[(size_t)r * 128 + (u - 8) * 64 + lane] = (half_t)v;
            else V16[(size_t)r * 128 + (u - 10) * 64 + lane] = (half_t)v;
        }
        float rv[TK][2], kv[TK][2], vv[TK][2];
#pragma unroll
        for (int tok = 0; tok < TK; ++tok) {
            const int r = r0 + tok, s = r % SEQA;
            const bool hp = (s != 0 && s != NCTX), hn = (s != NCTX - 1 && s != SEQA - 1);
            const float* row = P32 + (size_t)r * EVEN_COLS + 768;
            auto sh = [&](int c) -> float {
                const float u = row[c];
                const float pv = hp ? row[c - EVEN_COLS] : 0.f, nv = hn ? row[c + EVEN_COLS] : 0.f;
                return u + mup[c] * (pv - u) + mun[c] * (nv - u);
            };
            const float xl = sh(1536 + t);
            lin[tok * 256 + t] = (t < 64) ? tanhf(xl) : ((t < 128) ? xl : sigmoidf_(xl));
#pragma unroll
            for (int jj = 0; jj < 2; ++jj) {
                const int c = t + 256 * jj;
                rv[tok][jj] = sh(c); kv[tok][jj] = sh(512 + c); vv[tok][jj] = sh(1024 + c);
                vbuf[tok * 512 + c] = vv[tok][jj];
            }
        }
        __syncthreads();
        if (e > 0) {
            {
                const int tok = t >> 5, j = t & 31;
                if (tok < TK) {
                    const float* v1 = p.ev_v1 + (size_t)(e - 1) * 512 * 32 + j;
                    float a = 0.f;
                    for (int c = 0; c < 512; ++c) a += vbuf[tok * 512 + c] * v1[c * 32];
                    t1[tok * 32 + j] = a;
                }
            }
            __syncthreads();
#pragma unroll
            for (int jj = 0; jj < 2; ++jj) {
                const int c = t + 256 * jj;
                const float* v2 = p.ev_v2 + (size_t)(e - 1) * 32 * 512 + c;
                const float v0 = p.ev_v0[(e - 1) * 512 + c];
                float z[TK];
#pragma unroll
                for (int tok = 0; tok < TK; ++tok) z[tok] = v0;
                #pragma unroll 1
                for (int j = 0; j < 32; ++j) { const float w = v2[j * 512];
#pragma unroll
                    for (int tok = 0; tok < TK; ++tok) z[tok] += t1[tok * 32 + j] * w; }
#pragma unroll
                for (int tok = 0; tok < TK; ++tok) { const float vf = VF[(size_t)(r0 + tok) * 512 + c]; vv[tok][jj] = vv[tok][jj] + (vf - vv[tok][jj]) * sigmoidf_(z[tok]); }
            }
        } else {
#pragma unroll
            for (int tok = 0; tok < TK; ++tok)
#pragma unroll
                for (int jj = 0; jj < 2; ++jj) VF[(size_t)(r0 + tok) * 512 + t + 256 * jj] = vv[tok][jj];
        }
        float kk[TK][2];
#pragma unroll
        for (int jj = 0; jj < 2; ++jj) {
            const int c = t + 256 * jj;
            const float kkc = p.ev_k_k[e * 512 + c];
            const float* g2 = p.ev_g2 + (size_t)e * 128 * 512 + c;
            float ag[TK];
#pragma unroll
            for (int tok = 0; tok < TK; ++tok) ag[tok] = 0.f;
            #pragma unroll 1
            for (int k = 0; k < 128; ++k) { const float w = g2[k * 512];
#pragma unroll
                for (int tok = 0; tok < TK; ++tok) ag[tok] += lin[tok * 256 + 128 + k] * w; }
#pragma unroll
            for (int tok = 0; tok < TK; ++tok) {
                const size_t o = (size_t)(r0 + tok) * 512 + c;
                const float kr = kv[tok][jj] * kkc;
                const float n2 = wave_sum(kr * kr);
                kk[tok][jj] = kr / fmaxf(sqrtf(n2), 1e-12f);
                SR[o] = rv[tok][jj]; SV[o] = vv[tok][jj]; SKK[o] = kk[tok][jj]; G[o] = ag[tok];
            }
        }
        float bon[TK][2];
#pragma unroll
        for (int tok = 0; tok < TK; ++tok) { bon[tok][0] = 0.f; bon[tok][1] = 0.f; }
        for (int dr = 0; dr < 2; ++dr) {
#pragma unroll
            for (int jj = 0; jj < 2; ++jj) {
                const int c = t + 256 * jj;
                const float* w2 = p.ev_w2 + ((size_t)(e * 2 + dr) * 64) * 512 + c;
                const float* a2 = p.ev_a2 + ((size_t)(e * 2 + dr) * 64) * 512 + c;
                const float w0 = p.ev_w0[(e * 2 + dr) * 512 + c], a0 = p.ev_a0[(e * 2 + dr) * 512 + c];
                const float kac = p.ev_k_a[e * 512 + c], rkc = p.ev_r_k[e * 512 + c];
                float aw[TK], aa[TK];
#pragma unroll
                for (int tok = 0; tok < TK; ++tok) { aw[tok] = w0; aa[tok] = a0; }
                #pragma unroll 1
                for (int k = 0; k < 64; ++k) { const float ww = w2[k * 512], wa = a2[k * 512];
#pragma unroll
                    for (int tok = 0; tok < TK; ++tok) { aw[tok] += lin[tok * 256 + k] * ww; aa[tok] += lin[tok * 256 + 64 + k] * wa; } }
#pragma unroll
                for (int tok = 0; tok < TK; ++tok) {
                    const size_t o = (size_t)dr * M * 512 + (size_t)(r0 + tok) * 512 + c;
                    const float w = expf(-DECAY_SCALE * sigmoidf_(aw[tok]));
                    const float a = sigmoidf_(aa[tok]);
                    const float kd = kv[tok][jj] * (1.f + (a - 1.f) * kac);
                    SW[o] = w; SKA[o] = kk[tok][jj] * a; SKD[o] = kd;
                    bon[tok][jj] += rv[tok][jj] * kd * rkc;
                }
            }
        }
#pragma unroll
        for (int tok = 0; tok < TK; ++tok)
#pragma unroll
            for (int jj = 0; jj < 2; ++jj) { const float b = wave_sum(bon[tok][jj]); if (lane == 0) BONUS[(size_t)(r0 + tok) * 8 + wid + 4 * jj] = b; }
        __syncthreads();
    }
}

__device__ void phase_prep_odd(const Params& p, int bid, int nb) {
    const int wid = threadIdx.x >> 6, lane = threadIdx.x & 63;
    const float* P32 = wsp<float>(p, WS_BIG);
    half_t* Q16 = wsp<half_t>(p, WS_Q16); half_t* K16 = wsp<half_t>(p, WS_K16); half_t* V16 = wsp<half_t>(p, WS_V16);
    for (int task = bid * 4 + wid; task < M * 48; task += nb * 4) {
        const int r = task / 48, u = task % 48, s = r % SEQA;
        float v = P32[(size_t)r * ODD_COLS + u * 64 + lane];
        if (u < 32 && s >= NCTX) v = rope64(v, lane, s - NCTX);
        if (u < 16) Q16[(size_t)r * 1024 + u * 64 + lane] = (half_t)(v * 0.125f);
        else if (u < 32) K16[(size_t)r * 1024 + (u - 16) * 64 + lane] = (half_t)v;
        else V16[(size_t)r * 1024 + (u - 32) * 64 + lane] = (half_t)v;
    }
}

template <int MODE>
__device__ void phase_attn_simple(const Params& p, int bid, int nb) {
    const int nitems = (MODE == 0) ? 72 * 8 : 72 * 32;
    const half_t* Q16 = wsp<half_t>(p, WS_Q16); const half_t* K16 = wsp<half_t>(p, WS_K16); const half_t* V16 = wsp<half_t>(p, WS_V16);
    for (int item = bid; item < nitems; item += nb) {
        int rbk, h, comp = 0, half = 0;
        if (MODE == 0) { rbk = item >> 3; h = item & 7; } else { rbk = item >> 5; const int rest = item & 31; h = rest >> 2; comp = (rest >> 1) & 1; half = rest & 1; }
        const int r = rbk * 256 + threadIdx.x, b = r / SEQA, s = r - b * SEQA;
        const bool isctx = (rbk % 9) == 0;
        const int nkeys = isctx ? NCTX : SEQA;
        const size_t kbase = (size_t)b * SEQA;
        const int qstride = MODE == 0 ? 512 : 1024, qoff = MODE == 0 ? h * 64 : h * 128 + comp * 64;
        const int kstride = MODE == 0 ? 128 : 1024, koff = MODE == 0 ? (h >> 2) * 64 : h * 128 + comp * 64;
        const int voff = MODE == 0 ? (h >> 2) * 64 : h * 128 + half * 64;
        (void)s;
        float q[64], o[64];
#pragma unroll
        for (int d = 0; d < 64; ++d) { q[d] = (float)Q16[(size_t)r * qstride + qoff + d]; o[d] = 0.f; }
        float m = -INFINITY, l = 0.f;
        for (int k0 = 0; k0 < nkeys; k0 += 4) {
            float sc[4];
#pragma unroll
            for (int j = 0; j < 4; ++j) {
                const half_t* kp = K16 + (kbase + k0 + j) * kstride + koff;
                float a = 0.f;
#pragma unroll
                for (int d = 0; d < 64; ++d) a += q[d] * (float)kp[d];
                sc[j] = a;
            }
            const float tm = fmaxf(fmaxf(sc[0], sc[1]), fmaxf(sc[2], sc[3]));
            const float mn = fmaxf(m, tm);
            const float alpha = expf(m - mn);
            l *= alpha;
#pragma unroll
            for (int d = 0; d < 64; ++d) o[d] *= alpha;
#pragma unroll
            for (int j = 0; j < 4; ++j) {
                const float pj = expf(sc[j] - mn);
                l += pj;
                const half_t* vp = V16 + (kbase + k0 + j) * kstride + voff;
#pragma unroll
                for (int d = 0; d < 64; ++d) o[d] += pj * (float)vp[d];
            }
            m = mn;
        }
        const float inv = 1.f / l;
        if (MODE == 0) {
            half_t* dst = wsp<half_t>(p, WS_MIX16) + (size_t)r * 1024 + h * 64;
#pragma unroll
            for (int d = 0; d < 64; ++d) dst[d] = (half_t)(o[d] * inv);
        } else {
            float* dst = wsp<float>(p, WS_ATT32) + (((size_t)r * 8 + h) * 2 + comp) * 128 + half * 64;
#pragma unroll
            for (int d = 0; d < 64; ++d) dst[d] = o[d] * inv;
        }
    }
}

__device__ void phase_diff_finish(const Params& p, int layer, int bid, int nb) {
    const int o = layer >> 1, wid = threadIdx.x >> 6, lane = threadIdx.x & 63;
    const float linit = 0.8f - 0.6f * expf(-0.3f * (float)layer);
    const float d1 = wave_sum(p.od_lq1[o * 64 + lane] * p.od_lk1[o * 64 + lane]);
    const float d2 = wave_sum(p.od_lq2[o * 64 + lane] * p.od_lk2[o * 64 + lane]);
    const float lam = expf(d1) - expf(d2) + linit;
    const float s0 = p.od_subln[o * 128 + lane], s1 = p.od_subln[o * 128 + 64 + lane];
    const float* ATT = wsp<float>(p, WS_ATT32);
    half_t* MIX = wsp<half_t>(p, WS_MIX16);
    for (int task = bid * 4 + wid; task < M * 8; task += nb * 4) {
        const int r = task >> 3, h = task & 7;
        const float* a = ATT + ((size_t)r * 8 + h) * 256;
        const float o0 = a[lane] - lam * a[128 + lane], o1 = a[64 + lane] - lam * a[192 + lane];
        const float ss = wave_sum(o0 * o0 + o1 * o1) * (1.f / 128.f);
        const float sc = rsqrtf(ss + 1e-5f) * (1.f - linit);
        MIX[(size_t)r * 1024 + h * 128 + lane] = (half_t)(o0 * sc * s0);
        MIX[(size_t)r * 1024 + h * 128 + 64 + lane] = (half_t)(o1 * sc * s1);
    }
}

__device__ void phase_scan(const Params& p, int bid, int nb, unsigned char* smem) {
    constexpr int CH = 32;
    float* lds = (float*)smem;
    float* Lw = lds;
    float* Lv = lds + 5 * CH * 64;
    float* Ly = Lv + CH * 16;
    const int t = threadIdx.x, wid = t >> 6, lane = t & 63, rloc = lane >> 4, kq = lane & 15;
    for (int item = bid; item < 512; item += nb) {
        const int chain = item >> 2, rq = item & 3, dir = chain & 1, bh = chain >> 1, b = bh >> 3, h = bh & 7;
        const size_t rowbase = (size_t)b * SEQA;
        const float* SCN = wsp<float>(p, WS_SR);
        const float* SV = wsp<float>(p, WS_SV);
        float* YS = wsp<float>(p, WS_YSC) + (size_t)dir * M * 512;
        auto tok_of = [=](int i) -> int { return dir == 0 ? i : (i < NCTX ? (NCTX - 1 - i) : (SEQA + NCTX - 1 - i)); };
        float4 pre0, pre1, pre2, pre3, pre4, pre5, pre6, pre7, pre8, pre9, prev;
        pre0 = pre1 = pre2 = pre3 = pre4 = pre5 = pre6 = pre7 = pre8 = pre9 = prev = make_float4(0, 0, 0, 0);
#define SCAN_LD1(cc, j, dst)                                                                                                       \
        {                                                                                                                          \
            const int idx = t + 256 * (j), st = idx / 80, rem = idx % 80, a = rem >> 4, f4 = rem & 15;                              \
            const size_t row = rowbase + tok_of((cc) * CH + st);                                                                   \
            const int plane = a < 3 ? 3 + 2 * a + dir : (a == 3 ? 2 : 0);                                                          \
            dst = *(const float4*)(SCN + ((size_t)plane * M + row) * 512 + h * 64 + f4 * 4);                                       \
        }
#define SCAN_ISSUE(cc)                                                                                                             \
        {                                                                                                                          \
            SCAN_LD1(cc, 0, pre0) SCAN_LD1(cc, 1, pre1) SCAN_LD1(cc, 2, pre2) SCAN_LD1(cc, 3, pre3) SCAN_LD1(cc, 4, pre4)           \
            SCAN_LD1(cc, 5, pre5) SCAN_LD1(cc, 6, pre6) SCAN_LD1(cc, 7, pre7) SCAN_LD1(cc, 8, pre8) SCAN_LD1(cc, 9, pre9)           \
            if (t < 128) { const int st = t >> 2, f4 = t & 3; const size_t row = rowbase + tok_of((cc) * CH + st);                  \
                prev = *(const float4*)(SV + row * 512 + h * 64 + rq * 16 + f4 * 4); }                                              \
        }
#define SCAN_ST1(j, srcv)                                                                                                          \
        {                                                                                                                          \
            const int idx = t + 256 * (j), st = idx / 80, rem = idx % 80, a = rem >> 4, f4 = rem & 15;                              \
            *(float4*)(Lw + a * CH * 64 + st * 64 + f4 * 4) = srcv;                                                                \
        }
#define SCAN_COMMIT()                                                                                                              \
        {                                                                                                                          \
            SCAN_ST1(0, pre0) SCAN_ST1(1, pre1) SCAN_ST1(2, pre2) SCAN_ST1(3, pre3) SCAN_ST1(4, pre4)                               \
            SCAN_ST1(5, pre5) SCAN_ST1(6, pre6) SCAN_ST1(7, pre7) SCAN_ST1(8, pre8) SCAN_ST1(9, pre9)                               \
            if (t < 128) { const int st = t >> 2, f4 = t & 3; *(float4*)(Lv + st * 16 + f4 * 4) = prev; }                          \
        }
        float S0 = 0.f, S1 = 0.f, S2 = 0.f, S3 = 0.f;
        SCAN_ISSUE(0);
        SCAN_COMMIT();
        __syncthreads();
        for (int c = 0; c < SEQA / CH; ++c) {
            if (c + 1 < SEQA / CH) SCAN_ISSUE(c + 1);
#pragma unroll 4
            for (int st = 0; st < CH; ++st) {
                const float4 w4 = *(const float4*)(Lw + 0 * CH * 64 + st * 64 + kq * 4);
                const float4 b4 = *(const float4*)(Lw + 1 * CH * 64 + st * 64 + kq * 4);
                const float4 d4 = *(const float4*)(Lw + 2 * CH * 64 + st * 64 + kq * 4);
                const float4 a4 = *(const float4*)(Lw + 3 * CH * 64 + st * 64 + kq * 4);
                const float4 r4 = *(const float4*)(Lw + 4 * CH * 64 + st * 64 + kq * 4);
                const float vr = Lv[st * 16 + wid * 4 + rloc];
                float pk = S0 * a4.x + S1 * a4.y + S2 * a4.z + S3 * a4.w;
                pk = sum16(pk);
                S0 = S0 * w4.x + (vr * d4.x - pk * b4.x);
                S1 = S1 * w4.y + (vr * d4.y - pk * b4.y);
                S2 = S2 * w4.z + (vr * d4.z - pk * b4.z);
                S3 = S3 * w4.w + (vr * d4.w - pk * b4.w);
                float y = S0 * r4.x + S1 * r4.y + S2 * r4.z + S3 * r4.w;
                y = sum16(y);
                if (kq == 0) Ly[st * 16 + wid * 4 + rloc] = y;
            }
            __syncthreads();
            if (t < 128) {
                const int st = t >> 2, f4 = t & 3; const size_t row = rowbase + tok_of(c * CH + st);
                *(float4*)(YS + row * 512 + h * 64 + rq * 16 + f4 * 4) = *(const float4*)(Ly + st * 16 + f4 * 4);
            }
            if (c + 1 < SEQA / CH) SCAN_COMMIT();
            __syncthreads();
        }
    }
}

__device__ void phase_readout(const Params& p, int layer, int bid, int nb) {
    const int e = layer >> 1, wid = threadIdx.x >> 6, lane = threadIdx.x & 63;
    const float* Y0 = wsp<float>(p, WS_YSC); const float* Y1 = Y0 + (size_t)M * 512;
    const float* SV = wsp<float>(p, WS_SV); const float* G = wsp<float>(p, WS_G); const float* BONUS = wsp<float>(p, WS_BONUS);
    half_t* MIX = wsp<half_t>(p, WS_MIX16);
    for (int task = bid * 4 + wid; task < M * 8; task += nb * 4) {
        const int r = task >> 3, h = task & 7;
        const size_t o = (size_t)r * 512 + h * 64 + lane;
        const float y = Y0[o] + Y1[o];
        const float mu = wave_sum(y) * (1.f / 64.f);
        const float d = y - mu;
        const float var = wave_sum(d * d) * (1.f / 64.f);
        float yn = d * rsqrtf(var + GN_EPS) * p.ev_gn_w[e * 512 + h * 64 + lane] + p.ev_gn_b[e * 512 + h * 64 + lane];
        yn += BONUS[(size_t)r * 8 + h] * SV[o];
        MIX[(size_t)r * 1024 + 512 + h * 64 + lane] = (half_t)(yn * G[o]);
    }
}

__device__ void phase_route(const Params& p, int layer, int bid, int nb, unsigned char* smem) {
    float* hbuf = (float*)smem;
    float* lg = hbuf + 8 * 1024;
    const int t = threadIdx.x, wid = t >> 6, lane = t & 63;
    const bool last = (layer == DEPTH - 1);
    int* cnt = wsp<int>(p, WS_CNT) + layer * 32;
    int* list = wsp<int>(p, WS_LIST);
    float* GATE = wsp<float>(p, WS_GATE); int* ESLOT = wsp<int>(p, WS_ESLOT);
    for (int rg = bid; rg < M / 8; rg += nb) {
        const int r0 = rg * 8;
        if (last && (r0 % SEQA) < NCTX) continue;
#pragma unroll
        for (int q = 0; q < 2; ++q) {
            const int lr = wid * 2 + q, r = r0 + lr;
            const float4* xr = (const float4*)(wsp<float>(p, WS_XS) + (size_t)r * 1024);
            float4 v[4]; float ss = 0.f;
#pragma unroll
            for (int j = 0; j < 4; ++j) { v[j] = xr[lane + 64 * j]; ss += v[j].x * v[j].x + v[j].y * v[j].y + v[j].z * v[j].z + v[j].w * v[j].w; }
            ss = wave_sum(ss);
            norm_row_store(p, layer, r, 3, v, ss, lane, hbuf + lr * 1024);
        }
        __syncthreads();
        {
            const int lr = t >> 5, og = t & 31;
            const float* wrt = p.moe_w_rt + (size_t)layer * 1024 * 32 + og;
            const float* wgp = p.moe_w_grp + (size_t)layer * 1024 * 4 + (og & 3);
            float acc = 0.f, acc2 = 0.f;
            for (int d = 0; d < 1024; ++d) { const float hv = hbuf[lr * 1024 + d]; acc += hv * wrt[d * 32]; acc2 += hv * wgp[d * 4]; }
            lg[lr * 36 + 4 + og] = acc + p.moe_b_rt[layer * 32 + og];
            if (og < 4) lg[lr * 36 + og] = acc2 + p.moe_b_grp[layer * 4 + og];
        }
        __syncthreads();
        if (t < 8) {
            const int r = r0 + t;
            const float* L = lg + t * 36;
            int sel = 0; float mx = L[0];
            for (int g = 1; g < 4; ++g) if (L[g] > mx) { mx = L[g]; sel = g; }
            float z = 0.f;
            for (int g = 0; g < 4; ++g) z += expf(L[g] - mx);
            const float grp_w = 1.f / z;
            const float* E = L + 4 + sel * 8;
            int i1 = 0; float v1 = E[0];
            for (int j = 1; j < 8; ++j) if (E[j] > v1) { v1 = E[j]; i1 = j; }
            int i2 = -1; float v2 = -INFINITY;
            for (int j = 0; j < 8; ++j) if (j != i1 && E[j] > v2) { v2 = E[j]; i2 = j; }
            const float e2 = expf(v2 - v1);
            const float g1 = grp_w / (1.f + e2), g2 = grp_w * e2 / (1.f + e2);
            const int ea = sel * 8 + i1, eb = sel * 8 + i2;
            const int pa = atomicAdd(&cnt[ea], 1);
            const int pb = atomicAdd(&cnt[eb], 1);
            list[(size_t)ea * LISTCAP + pa] = r;
            list[(size_t)eb * LISTCAP + pb] = r;
            GATE[r * 2 + 0] = g1; GATE[r * 2 + 1] = g2;
            ESLOT[r * 2 + 0] = ea * 65536 + pa; ESLOT[r * 2 + 1] = eb * 65536 + pb;
        }
        __syncthreads();
    }
}

template <int TM>
__device__ __forceinline__ void moe_tables(const Params& p, int layer, int* tab  ) {
    if (threadIdx.x == 0) {
        const int* cnt = wsp<int>(p, WS_CNT) + layer * 32;
        int ts = 0;
        for (int e = 0; e < 32; ++e) { const int c = cnt[e]; tab[e] = c; tab[32 + e] = ts; tab[65 + e] = ts * TM; ts += (c + TM - 1) / TM; }
        tab[64] = ts;
    }
    __syncthreads();
}
__device__ void phase_moe1(const Params& p, int layer, int bid, int nb, unsigned char* smem) {
    constexpr int TM = 64;
    int* tab = (int*)(smem + 3 * 16 * 68 * 4);
    moe_tables<TM>(p, layer, tab);
    const int nrb = tab[64], nitems = nrb * 8;
    const half_t* H16 = wsp<half_t>(p, WS_H16);
    half_t* HM = wsp<half_t>(p, WS_HM16);
    const int* list = wsp<int>(p, WS_LIST);
    for (int item = bid; item < nitems; item += nb) {
        const int rb = item >> 3, nt = item & 7;
        int e = 0;
        while (e < 31 && tab[32 + e + 1] <= rb) ++e;
        const int lb = rb - tab[32 + e], cnt = tab[e], orow0 = tab[65 + e] + lb * TM;
        const int* le = list + (size_t)e * LISTCAP;
        auto rowsrc = [=](int i) -> long { const int pos = lb * TM + i; return pos < cnt ? (long)le[pos] : -1L; };
        const float* Wg = p.moe_w_gate + ((size_t)(layer * 32 + e)) * 1024 * 512 + nt * 64;
        const float* Wu = p.moe_w_up + ((size_t)(layer * 32 + e)) * 1024 * 512 + nt * 64;
        auto epi = [=](int i, int j, float g, float u) { HM[(size_t)(orow0 + i) * 512 + nt * 64 + j] = (half_t)(siluf_(g) * u); };
        gemm_tile_simple<true>(H16, 1024, rowsrc, Wg, Wu, 512, 1024, epi, smem);
    }
}
__device__ void phase_moe2(const Params& p, int layer, int bid, int nb, unsigned char* smem) {
    constexpr int TM = 64;
    int* tab = (int*)(smem + 3 * 16 * 68 * 4);
    moe_tables<TM>(p, layer, tab);
    const int nrb = tab[64], nitems = nrb * 16;
    const half_t* HM = wsp<half_t>(p, WS_HM16);
    float* YO = wsp<float>(p, WS_YOUT);
    for (int item = bid; item < nitems; item += nb) {
        const int rb = item >> 4, nt = item & 15;
        int e = 0;
        while (e < 31 && tab[32 + e + 1] <= rb) ++e;
        const int lb = rb - tab[32 + e], orow0 = tab[65 + e] + lb * TM;
        auto rowsrc = [=](int i) -> long { return orow0 + i; };
        const float* Wd = p.moe_w_down + ((size_t)(layer * 32 + e)) * 512 * 1024 + nt * 64;
        auto epi = [=](int i, int j, float v, float) { YO[(size_t)(orow0 + i) * 1024 + nt * 64 + j] = v; };
        gemm_tile_simple<false>(HM, 512, rowsrc, Wd, nullptr, 1024, 512, epi, smem);
    }
}

__device__ void phase_combine(const Params& p, int layer, int bid, int nb, unsigned char* smem) {
    constexpr int TM = 64;
    int* tab = (int*)smem;
    moe_tables<TM>(p, layer, tab);
    const int wid = threadIdx.x >> 6, lane = threadIdx.x & 63;
    const bool last = (layer == DEPTH - 1);
    const float* GATE = wsp<float>(p, WS_GATE); const int* ESLOT = wsp<int>(p, WS_ESLOT);
    const float* YO = wsp<float>(p, WS_YOUT);
    for (int r = bid * 4 + wid; r < M; r += nb * 4) {
        const int b = r / SEQA, s = r - b * SEQA;
        if (last && s < NCTX) continue;
        const int es0 = ESLOT[r * 2], es1 = ESLOT[r * 2 + 1];
        const float g0 = GATE[r * 2], g1 = GATE[r * 2 + 1];
        const size_t s0 = (size_t)(tab[65 + (es0 >> 16)] + (es0 & 65535)), s1 = (size_t)(tab[65 + (es1 >> 16)] + (es1 & 65535));
        float4* xr = (float4*)(wsp<float>(p, WS_XS) + (size_t)r * 1024);
        const float4* y0 = (const float4*)(YO + s0 * 1024); const float4* y1 = (const float4*)(YO + s1 * 1024);
        const float4* m5 = (const float4*)mods_ptr(p, layer, mods_row(r), 5);
        float4 v[4]; float ss = 0.f;
#pragma unroll
        for (int j = 0; j < 4; ++j) {
            const float4 x = xr[lane + 64 * j], a = y0[lane + 64 * j], c = y1[lane + 64 * j], g = m5[lane + 64 * j];
            float4 o;
            o.x = x.x + g.x * (g0 * a.x + g1 * c.x); o.y = x.y + g.y * (g0 * a.y + g1 * c.y);
            o.z = x.z + g.z * (g0 * a.z + g1 * c.z); o.w = x.w + g.w * (g0 * a.w + g1 * c.w);
            v[j] = o; ss += o.x * o.x + o.y * o.y + o.z * o.z + o.w * o.w;
        }
        ss = wave_sum(ss);
        if (!last) {
#pragma unroll
            for (int j = 0; j < 4; ++j) xr[lane + 64 * j] = v[j];
            norm_row_store(p, layer + 1, r, 0, v, ss, lane, nullptr);
        } else {
            const float rstd = rsqrtf(ss * (1.f / 1024.f) + 1e-6f);
            float4* dst = (float4*)(p.out + ((size_t)(b * NLAT + s - NCTX)) * 1024);
            const float4* fg = (const float4*)p.final_gain;
#pragma unroll
            for (int j = 0; j < 4; ++j) { const float4 g = fg[lane + 64 * j]; float4 o; o.x = v[j].x * rstd * g.x; o.y = v[j].y * rstd * g.y; o.z = v[j].z * rstd * g.z; o.w = v[j].w * rstd * g.w; dst[lane + 64 * j] = o; }
        }
    }
}

enum { PH_MODS = 0, PH_COPY, PH_NORM1, PH_GEMM_IN, PH_PREP, PH_ATTN, PH_SCAN, PH_POST, PH_GEMM_OUT, PH_ROUTE, PH_MOE1, PH_MOE2, PH_COMBINE };

template <int PH>
__device__ __forceinline__ void run_phase(const Params& p, int layer, int bid, int nb, unsigned char* smem) {
    const bool even = (layer & 1) == 0;
    const int e = layer >> 1;
    if (PH == PH_MODS) phase_mods(p, bid, nb, smem);
    else if (PH == PH_COPY) phase_copy(p, bid, nb);
    else if (PH == PH_NORM1) phase_norm1(p, layer, bid, nb);
    else if (PH == PH_GEMM_IN) {
        if (even) phase_gemm_dense<0>(p, layer, wsp<half_t>(p, WS_H16), p.ev_w_in + (size_t)e * 1024 * EVEN_COLS, EVEN_COLS, bid, nb, smem);
        else phase_gemm_dense<0>(p, layer, wsp<half_t>(p, WS_H16), p.od_w_in + (size_t)e * 1024 * ODD_COLS, ODD_COLS, bid, nb, smem);
    } else if (PH == PH_PREP) { if (even) phase_prep_even(p, layer, bid, nb, smem); else phase_prep_odd(p, bid, nb); }
    else if (PH == PH_ATTN) { if (even) phase_attn_simple<0>(p, bid, nb); else phase_attn_simple<1>(p, bid, nb); }
    else if (PH == PH_SCAN) { if (even) phase_scan(p, bid, nb, smem); }
    else if (PH == PH_POST) { if (even) phase_readout(p, layer, bid, nb); else phase_diff_finish(p, layer, bid, nb); }
    else if (PH == PH_GEMM_OUT) phase_gemm_dense<1>(p, layer, wsp<half_t>(p, WS_MIX16), (even ? p.ev_w_out : p.od_w_out) + (size_t)e * 1024 * 1024, 1024, bid, nb, smem);
    else if (PH == PH_ROUTE) phase_route(p, layer, bid, nb, smem);
    else if (PH == PH_MOE1) phase_moe1(p, layer, bid, nb, smem);
    else if (PH == PH_MOE2) phase_moe2(p, layer, bid, nb, smem);
    else if (PH == PH_COMBINE) phase_combine(p, layer, bid, nb, smem);
}

template <int PH>
__global__ void __launch_bounds__(NT, 2) k_phase(Params p, int layer) {
    extern __shared__ __attribute__((aligned(16))) unsigned char smem[];
    run_phase<PH>(p, layer, blockIdx.x, gridDim.x, smem);
}

template <int PH>
static void launch_phase(const Params& p, int layer, int grid, hipStream_t stream) {
    static bool attr_set = false;
    if (!attr_set) { (void)hipFuncSetAttribute((const void*)k_phase<PH>, hipFuncAttributeMaxDynamicSharedMemorySize, LDS_BYTES); attr_set = true; }
    hipLaunchKernelGGL(k_phase<PH>, dim3(grid), dim3(NT), LDS_BYTES, stream, p, layer);
}

extern "C" void kernel_launch(void* const* d_in, const int* in_sizes, int n_in, void* d_out, int out_size, void* d_ws, size_t ws_size, hipStream_t stream) {
    if (n_in != 40 || ws_size < WS_END) { fprintf(stderr, "kernel_launch: unexpected inputs (n_in %d, ws %zu, need %zu)\n", n_in, ws_size, (size_t)WS_END); return; }
    Params p{};
    const float** pp = (const float**)&p;
    for (int i = 0; i < 40; ++i) pp[i] = (const float*)d_in[i];
    p.out = (float*)d_out; p.ws = (unsigned char*)d_ws;
    (void)hipMemsetAsync(d_ws, 0, WS_ZERO_BYTES, stream);
    const int grid = 1024;
    launch_phase<PH_MODS>(p, 0, 512, stream);
    launch_phase<PH_COPY>(p, 0, grid, stream);
    launch_phase<PH_NORM1>(p, 0, grid, stream);
    for (int layer = 0; layer < DEPTH; ++layer) {
        launch_phase<PH_GEMM_IN>(p, layer, grid, stream);
        launch_phase<PH_PREP>(p, layer, grid, stream);
        launch_phase<PH_ATTN>(p, layer, grid, stream);
        if ((layer & 1) == 0) launch_phase<PH_SCAN>(p, layer, 512, stream);
        launch_phase<PH_POST>(p, layer, grid, stream);
        launch_phase<PH_GEMM_OUT>(p, layer, grid, stream);
        launch_phase<PH_ROUTE>(p, layer, grid, stream);
        launch_phase<PH_MOE1>(p, layer, grid, stream);
        launch_phase<PH_MOE2>(p, layer, grid, stream);
        launch_phase<PH_COMBINE>(p, layer, grid, stream);
    }
}
```

```cpp
#include <hip/hip_runtime.h>
#include <stdint.h>
#include <stdio.h>

#ifndef ONE_LAUNCH
#define ONE_LAUNCH 1
#endif

typedef _Float16 half_t;
typedef _Float16 h4_t __attribute__((ext_vector_type(4)));
typedef _Float16 h8_t __attribute__((ext_vector_type(8)));

constexpr int D = 1024, NB = 8, NLAT = 2048, NCTX = 256, SEQA = NLAT + NCTX  , M = NB * SEQA  ;
constexpr int DEPTH = 4;
constexpr int EVEN_COLS = 2560, ODD_COLS = 3072;
constexpr int NEXP = 32, EH = 512;
constexpr int LISTCAP = 36864, MAXSLOT = 40960;
constexpr float DECAY_SCALE = 0.60653065971263342f;
constexpr float GN_EPS = 64e-5f;
constexpr int NT = 256;
constexpr int LDS_BYTES = 65536;

constexpr size_t WS_BAR = 0;
constexpr size_t WS_CNT = 16384;
constexpr size_t WS_ZERO_BYTES = 32768;
constexpr size_t WS_MODS = 32768;
constexpr size_t WS_XS = 1u << 20;
constexpr size_t SZ_F32_1024 = (size_t)M * 1024 * 4;
constexpr size_t SZ_H16_1024 = (size_t)M * 1024 * 2;
constexpr size_t SZ_F32_512 = (size_t)M * 512 * 4;
constexpr size_t WS_H16 = WS_XS + SZ_F32_1024;
constexpr size_t WS_BIG = WS_H16 + SZ_H16_1024;
constexpr size_t SZ_BIG = (size_t)M * 3072 * 4;
constexpr size_t WS_Q16 = WS_BIG + SZ_BIG;
constexpr size_t WS_K16 = WS_Q16 + SZ_H16_1024;
constexpr size_t WS_V16 = WS_K16 + SZ_H16_1024;
constexpr size_t WS_MIX16 = WS_V16 + SZ_H16_1024;
constexpr size_t WS_SR = WS_MIX16 + SZ_H16_1024;
constexpr size_t WS_SV = WS_SR + SZ_F32_512;
constexpr size_t WS_SKK = WS_SV + SZ_F32_512;
constexpr size_t WS_SW = WS_SKK + SZ_F32_512;
constexpr size_t WS_SKA = WS_SW + 2 * SZ_F32_512;
constexpr size_t WS_SKD = WS_SKA + 2 * SZ_F32_512;
constexpr size_t WS_G = WS_SKD + 2 * SZ_F32_512;
constexpr size_t WS_VF = WS_G + SZ_F32_512;
constexpr size_t WS_BONUS = WS_VF + SZ_F32_512;
constexpr size_t WS_LIST = WS_BONUS + (size_t)M * 8 * 4;
constexpr size_t WS_GATE = WS_LIST + (size_t)NEXP * LISTCAP * 4;
constexpr size_t WS_ESLOT = WS_GATE + (size_t)M * 2 * 4;
constexpr size_t WS_END = WS_ESLOT + (size_t)M * 2 * 4;
constexpr size_t WS_YSC = WS_BIG;
constexpr size_t WS_ATT32 = WS_BIG;
constexpr size_t WS_HM16 = WS_BIG;
constexpr size_t WS_YOUT = WS_BIG + (size_t)MAXSLOT * 512 * 2;
static_assert(WS_YOUT + (size_t)MAXSLOT * 1024 * 4 <= WS_BIG + SZ_BIG, "BIG region too small");
static_assert(WS_END < (size_t)1000 * 1000 * 1000, "workspace too large");

struct Params {
    const float *x, *c, *ctx, *c_ctx, *mod_w, *mod_b, *ev_w_in, *ev_w_out, *ev_q_gain, *ev_k_gain, *ev_mu_prev, *ev_mu_next, *ev_w0, *ev_w2,
        *ev_a0, *ev_a2, *ev_g2, *ev_k_k, *ev_k_a, *ev_r_k, *ev_gn_w, *ev_gn_b, *ev_v0, *ev_v1, *ev_v2, *od_w_in, *od_w_out, *od_lq1, *od_lk1,
        *od_lq2, *od_lk2, *od_subln, *moe_w_grp, *moe_b_grp, *moe_w_rt, *moe_b_rt, *moe_w_gate, *moe_w_up, *moe_w_down, *final_gain;
    float* out;
    unsigned char* ws;
};

__device__ __forceinline__ float wave_sum(float v) {
#pragma unroll
    for (int m = 32; m >= 1; m >>= 1) v += __shfl_xor(v, m, 64);
    return v;
}
__device__ __forceinline__ float sum16(float v) {
#pragma unroll
    for (int m = 8; m >= 1; m >>= 1) v += __shfl_xor(v, m, 64);
    return v;
}
__device__ __forceinline__ float sigmoidf_(float x) { return 1.f / (1.f + expf(-x)); }
__device__ __forceinline__ float siluf_(float x) { return x / (1.f + expf(-x)); }
__device__ __forceinline__ int mods_row(int r) { const int b = r / SEQA, s = r - b * SEQA; return s < NCTX ? 8 : b; }
__device__ __forceinline__ const float* mods_ptr(const Params& p, int layer, int mr, int chunk) {
    return (const float*)(p.ws + WS_MODS) + ((size_t)(layer * 9 + mr)) * 6144 + chunk * 1024;
}
template <class T> __device__ __forceinline__ T* wsp(const Params& p, size_t off) { return (T*)(p.ws + off); }

__device__ __forceinline__ void phase_mods(const Params& p, int tid, int bid, int nb, unsigned char* smem) {
    float* cond = (float*)smem;
    float* part = cond + 9 * 1024;
    const int t = tid;
    for (int i = t; i < 9 * 1024; i += NT) { const int r = i >> 10, d = i & 1023; const float v = (r < 8) ? p.c[r * 1024 + d] : p.c_ctx[d]; cond[i] = siluf_(v); }
    __syncthreads();
    float* mods = wsp<float>(p, WS_MODS);
    for (int item = bid; item < 512; item += nb) {
        const int layer = item >> 7, col0 = (item & 127) * 48;
        const int cq = t % 12, dg = t / 12;
        if (dg < 16) {
            float acc[9][4];
#pragma unroll
            for (int r = 0; r < 9; ++r)
#pragma unroll
                for (int j = 0; j < 4; ++j) acc[r][j] = 0.f;
            const float* W = p.mod_w + (size_t)layer * 1024 * 6144 + col0 + cq * 4;
            for (int i = 0; i < 64; ++i) {
                const int d = dg * 64 + i;
                const float4 w = *(const float4*)(W + (size_t)d * 6144);
#pragma unroll
                for (int r = 0; r < 9; ++r) { const float cv = cond[r * 1024 + d]; acc[r][0] += cv * w.x; acc[r][1] += cv * w.y; acc[r][2] += cv * w.z; acc[r][3] += cv * w.w; }
            }
#pragma unroll
            for (int r = 0; r < 9; ++r)
#pragma unroll
                for (int j = 0; j < 4; ++j) part[(dg * 9 + r) * 48 + cq * 4 + j] = acc[r][j];
        }
        __syncthreads();
        for (int o = t; o < 9 * 48; o += NT) {
            const int r = o / 48, cc = o % 48;
            float s = p.mod_b[layer * 6144 + col0 + cc];
            for (int g = 0; g < 16; ++g) s += part[(g * 9 + r) * 48 + cc];
            mods[((size_t)(layer * 9 + r)) * 6144 + col0 + cc] = s;
        }
        __syncthreads();
    }
}

__device__ __forceinline__ void phase_copy(const Params& p, int tid, int bid, int nb) {
    float4* XS = wsp<float4>(p, WS_XS);
    for (size_t i = (size_t)bid * NT + tid; i < (size_t)M * 256; i += (size_t)nb * NT) {
        const int r = (int)(i >> 8), c4 = (int)(i & 255);
        const int b = r / SEQA, s = r - b * SEQA;
        const float4* src = (s < NCTX) ? (const float4*)(p.ctx + ((size_t)(b * NCTX + s)) * 1024) : (const float4*)(p.x + ((size_t)(b * NLAT + s - NCTX)) * 1024);
        XS[i] = src[c4];
    }
}

__device__ __forceinline__ void norm_row_store(const Params& p, int layer, int r, int chunk_shift, const float4 (&v)[4], float ss, int lane, float* hbuf  ) {
    const float rstd = rsqrtf(ss * (1.f / 1024.f) + 1e-6f);
    const int mr = mods_row(r);
    const float4* sh = (const float4*)mods_ptr(p, layer, mr, chunk_shift);
    const float4* sc = (const float4*)mods_ptr(p, layer, mr, chunk_shift + 1);
    half_t* H = wsp<half_t>(p, WS_H16) + (size_t)r * 1024;
#pragma unroll
    for (int j = 0; j < 4; ++j) {
        const float4 a = sh[lane + 64 * j], b = sc[lane + 64 * j];
        float4 h;
        h.x = v[j].x * rstd * (1.f + b.x) + a.x; h.y = v[j].y * rstd * (1.f + b.y) + a.y;
        h.z = v[j].z * rstd * (1.f + b.z) + a.z; h.w = v[j].w * rstd * (1.f + b.w) + a.w;
        h4_t hh; hh.x = (half_t)h.x; hh.y = (half_t)h.y; hh.z = (half_t)h.z; hh.w = (half_t)h.w;
        *(h4_t*)(H + (lane + 64 * j) * 4) = hh;
        if (hbuf) *(float4*)(hbuf + (lane + 64 * j) * 4) = h;
    }
}
__device__ __forceinline__ void phase_norm1(const Params& p, int tid, int layer, int bid, int nb) {
    const int wid = tid >> 6, lane = tid & 63;
    for (int r = bid * 4 + wid; r < M; r += nb * 4) {
        const float4* xr = (const float4*)(wsp<float>(p, WS_XS) + (size_t)r * 1024);
        float4 v[4]; float ss = 0.f;
#pragma unroll
        for (int j = 0; j < 4; ++j) { v[j] = xr[lane + 64 * j]; ss += v[j].x * v[j].x + v[j].y * v[j].y + v[j].z * v[j].z + v[j].w * v[j].w; }
        ss = wave_sum(ss);
        norm_row_store(p, layer, r, 0, v, ss, lane, nullptr);
    }
}

template <bool DUAL, class RowSrc, class Epi>
__device__ __forceinline__ void gemm_tile_simple(const half_t* __restrict__ A, int lda, RowSrc rowsrc, const float* __restrict__ B1, const float* __restrict__ B2, int ldb,
                                                 int K, Epi epi, unsigned char* smem, int tid) {
    float (*As)[68] = (float (*)[68])smem;
    float (*Bs)[68] = (float (*)[68])(smem + 16 * 68 * 4);
    float (*Bs2)[68] = (float (*)[68])(smem + 2 * 16 * 68 * 4);
    const int t = tid, tx = t & 15, ty = t >> 4;
    const int arow = t >> 2, akq = (t & 3) * 4;
    const int bk = t >> 4, bn4 = (t & 15) * 4;
    const long asrc = rowsrc(arow);
    float acc[4][4], acc2[4][4];
#pragma unroll
    for (int i = 0; i < 4; ++i)
#pragma unroll
        for (int j = 0; j < 4; ++j) { acc[i][j] = 0.f; acc2[i][j] = 0.f; }
    for (int k0 = 0; k0 < K; k0 += 16) {
        h4_t av = {0, 0, 0, 0};
        if (asrc >= 0) av = *(const h4_t*)(A + (size_t)asrc * lda + k0 + akq);
        const float4 bv = *(const float4*)(B1 + (size_t)(k0 + bk) * ldb + bn4);
        float4 bv2 = make_float4(0, 0, 0, 0);
        if (DUAL) bv2 = *(const float4*)(B2 + (size_t)(k0 + bk) * ldb + bn4);
        __syncthreads();
        As[akq + 0][arow] = (float)av.x; As[akq + 1][arow] = (float)av.y; As[akq + 2][arow] = (float)av.z; As[akq + 3][arow] = (float)av.w;
        *(float4*)&Bs[bk][bn4] = bv;
        if (DUAL) *(float4*)&Bs2[bk][bn4] = bv2;
        __syncthreads();
#pragma unroll
        for (int k = 0; k < 16; ++k) {
            const float4 a = *(const float4*)&As[k][ty * 4];
            const float4 b = *(const float4*)&Bs[k][tx * 4];
            const float aa[4] = {a.x, a.y, a.z, a.w}, bb[4] = {b.x, b.y, b.z, b.w};
#pragma unroll
            for (int i = 0; i < 4; ++i)
#pragma unroll
                for (int j = 0; j < 4; ++j) acc[i][j] += aa[i] * bb[j];
            if (DUAL) {
                const float4 b2 = *(const float4*)&Bs2[k][tx * 4];
                const float cc[4] = {b2.x, b2.y, b2.z, b2.w};
#pragma unroll
                for (int i = 0; i < 4; ++i)
#pragma unroll
                    for (int j = 0; j < 4; ++j) acc2[i][j] += aa[i] * cc[j];
            }
        }
    }
#pragma unroll
    for (int i = 0; i < 4; ++i)
#pragma unroll
        for (int j = 0; j < 4; ++j) epi(ty * 4 + i, tx * 4 + j, acc[i][j], acc2[i][j]);
    __syncthreads();
}

template <int MODE>
__device__ __forceinline__ void phase_gemm_dense(const Params& p, int tid, int layer, const half_t* A, const float* W, int N, int bid, int nb, unsigned char* smem) {
    const int ntn = N / 64, ntiles = (M / 64) * ntn;
    float* P32 = wsp<float>(p, WS_BIG);
    float* XS = wsp<float>(p, WS_XS);
    for (int tile = bid; tile < ntiles; tile += nb) {
        const int tm = tile / ntn, tn = tile % ntn;
        const int m0 = tm * 64, n0 = tn * 64;
        auto rowsrc = [=](int i) -> long { return m0 + i; };
        if (MODE == 0) {
            auto epi = [=](int i, int j, float v, float) { P32[(size_t)(m0 + i) * N + n0 + j] = v; };
            gemm_tile_simple<false>(A, 1024, rowsrc, W + n0, nullptr, N, 1024, epi, smem, tid);
        } else {
            auto epi = [=](int i, int j, float v, float) {
                const int r = m0 + i, c = n0 + j;
                const float g = mods_ptr(p, layer, mods_row(r), 2)[c];
                XS[(size_t)r * 1024 + c] += g * v;
            };
            gemm_tile_simple<false>(A, 1024, rowsrc, W + n0, nullptr, N, 1024, epi, smem, tid);
        }
    }
}

__device__ __forceinline__ float rope64(float v, int lane, int tpos) {
    const int axis = lane >> 5, half = (lane >> 4) & 1, f = lane & 15;
    const float pos = (float)(axis ? (tpos & 63) : (tpos >> 6));
    const float inv = powf(10000.0f, -(float)f / 16.0f);
    const float ang = pos * inv;
    const float cs = cosf(ang), sn = sinf(ang);
    const float other = __shfl_xor(v, 16, 64);
    return half == 0 ? (v * cs - other * sn) : (other * sn + v * cs);
}

__device__ __forceinline__ void phase_prep_even(const Params& p, int tid, int layer, int bid, int nb, unsigned char* smem) {
    constexpr int TK = 4;
    const int e = layer >> 1;
    float* lin = (float*)smem;
    float* vbuf = lin + TK * 256;
    float* t1 = vbuf + TK * 512;
    const int t = tid, wid = t >> 6, lane = t & 63;
    const float* P32 = wsp<float>(p, WS_BIG);
    half_t* Q16 = wsp<half_t>(p, WS_Q16); half_t* K16 = wsp<half_t>(p, WS_K16); half_t* V16 = wsp<half_t>(p, WS_V16);
    float* SR = wsp<float>(p, WS_SR); float* SV = wsp<float>(p, WS_SV); float* SKK = wsp<float>(p, WS_SKK);
    float* SW = wsp<float>(p, WS_SW); float* SKA = wsp<float>(p, WS_SKA); float* SKD = wsp<float>(p, WS_SKD);
    float* G = wsp<float>(p, WS_G); float* VF = wsp<float>(p, WS_VF); float* BONUS = wsp<float>(p, WS_BONUS);
    const float* qgain = p.ev_q_gain + e * 64; const float* kgain = p.ev_k_gain + e * 64;
    const float* mup = p.ev_mu_prev + e * 1792; const float* mun = p.ev_mu_next + e * 1792;
    for (int item = bid; item < M / TK; item += nb) {
        const int r0 = item * TK;
        for (int task = wid; task < 12 * TK; task += 4) {
            const int tok = task / 12, u = task % 12, r = r0 + tok, s = r % SEQA;
            float v = P32[(size_t)r * EVEN_COLS + u * 64 + lane];
            if (u < 10) {
                const float ss = wave_sum(v * v);
                v = v * rsqrtf(ss * (1.f / 64.f) + 1e-6f) * (u < 8 ? qgain[lane] : kgain[lane]);
                if (s >= NCTX) v = rope64(v, lane, s - NCTX);
                if (u < 8) v *= 0.125f;
            }
            if (u < 8) Q16[(size_t)r * 512 + u * 64 + lane] = (half_t)v;
            else if (u < 10) K16[(size_t)r * 128 + (u - 8) * 64 + lane] = (half_t)v;
            else V16[(size_t)r * 128 + (u - 10) * 64 + lane] = (half_t)v;
        }
        float rv[TK][2], kv[TK][2], vv[TK][2];
#pragma unroll
        for (int tok = 0; tok < TK; ++tok) {
            const int r = r0 + tok, s = r % SEQA;
            const bool hp = (s != 0 && s != NCTX), hn = (s != NCTX - 1 && s != SEQA - 1);
            const float* row = P32 + (size_t)r * EVEN_COLS + 768;
            auto sh = [&](int c) -> float {
                const float u = row[c];
                const float pv = hp ? row[c - EVEN_COLS] : 0.f, nv = hn ? row[c + EVEN_COLS] : 0.f;
                return u + mup[c] * (pv - u) + mun[c] * (nv - u);
            };
            const float xl = sh(1536 + t);
            lin[tok * 256 + t] = (t < 64) ? tanhf(xl) : ((t < 128) ? xl : sigmoidf_(xl));
#pragma unroll
            for (int jj = 0; jj < 2; ++jj) {
                const int c = t + 256 * jj;
                rv[tok][jj] = sh(c); kv[tok][jj] = sh(512 + c); vv[tok][jj] = sh(1024 + c);
                vbuf[tok * 512 + c] = vv[tok][jj];
            }
        }
        __syncthreads();
        if (e > 0) {
            {
                const int tok = t >> 5, j = t & 31;
                if (tok < TK) {
                    const float* v1 = p.ev_v1 + (size_t)(e - 1) * 512 * 32 + j;
                    float a = 0.f;
                    for (int c = 0; c < 512; ++c) a += vbuf[tok * 512 + c] * v1[c * 32];
                    t1[tok * 32 + j] = a;
                }
            }
            __syncthreads();
#pragma unroll
            for (int jj = 0; jj < 2; ++jj) {
                const int c = t + 256 * jj;
                const float* v2 = p.ev_v2 + (size_t)(e - 1) * 32 * 512 + c;
                const float v0 = p.ev_v0[(e - 1) * 512 + c];
                float z[TK];
#pragma unroll
                for (int tok = 0; tok < TK; ++tok) z[tok] = v0;
                #pragma unroll 1
                for (int j = 0; j < 32; ++j) { const float w = v2[j * 512];
#pragma unroll
                    for (int tok = 0; tok < TK; ++tok) z[tok] += t1[tok * 32 + j] * w; }
#pragma unroll
                for (int tok = 0; tok < TK; ++tok) { const float vf = VF[(size_t)(r0 + tok) * 512 + c]; vv[tok][jj] = vv[tok][jj] + (vf - vv[tok][jj]) * sigmoidf_(z[tok]); }
            }
        } else {
#pragma unroll
            for (int tok = 0; tok < TK; ++tok)
#pragma unroll
                for (int jj = 0; jj < 2; ++jj) VF[(size_t)(r0 + tok) * 512 + t + 256 * jj] = vv[tok][jj];
        }
        float kk[TK][2];
#pragma unroll
        for (int jj = 0; jj < 2; ++jj) {
            const int c = t + 256 * jj;
            const float kkc = p.ev_k_k[e * 512 + c];
            const float* g2 = p.ev_g2 + (size_t)e * 128 * 512 + c;
            float ag[TK];
#pragma unroll
            for (int tok = 0; tok < TK; ++tok) ag[tok] = 0.f;
            #pragma unroll 1
            for (int k = 0; k < 128; ++k) { const float w = g2[k * 512];
#pragma unroll
                for (int tok = 0; tok < TK; ++tok) ag[tok] += lin[tok * 256 + 128 + k] * w; }
#pragma unroll
            for (int tok = 0; tok < TK; ++tok) {
                const size_t o = (size_t)(r0 + tok) * 512 + c;
                const float kr = kv[tok][jj] * kkc;
                const float n2 = wave_sum(kr * kr);
                kk[tok][jj] = kr / fmaxf(sqrtf(n2), 1e-12f);
                SR[o] = rv[tok][jj]; SV[o] = vv[tok][jj]; SKK[o] = kk[tok][jj]; G[o] = ag[tok];
            }
        }
        float bon[TK][2];
#pragma unroll
        for (int tok = 0; tok < TK; ++tok) { bon[tok][0] = 0.f; bon[tok][1] = 0.f; }
        for (int dr = 0; dr < 2; ++dr) {
#pragma unroll
            for (int jj = 0; jj < 2; ++jj) {
                const int c = t + 256 * jj;
                const float* w2 = p.ev_w2 + ((size_t)(e * 2 + dr) * 64) * 512 + c;
                const float* a2 = p.ev_a2 + ((size_t)(e * 2 + dr) * 64) * 512 + c;
                const float w0 = p.ev_w0[(e * 2 + dr) * 512 + c], a0 = p.ev_a0[(e * 2 + dr) * 512 + c];
                const float kac = p.ev_k_a[e * 512 + c], rkc = p.ev_r_k[e * 512 + c];
                float aw[TK], aa[TK];
#pragma unroll
                for (int tok = 0; tok < TK; ++tok) { aw[tok] = w0; aa[tok] = a0; }
                #pragma unroll 1
                for (int k = 0; k < 64; ++k) { const float ww = w2[k * 512], wa = a2[k * 512];
#pragma unroll
                    for (int tok = 0; tok < TK; ++tok) { aw[tok] += lin[tok * 256 + k] * ww; aa[tok] += lin[tok * 256 + 64 + k] * wa; } }
#pragma unroll
                for (int tok = 0; tok < TK; ++tok) {
                    const size_t o = (size_t)dr * M * 512 + (size_t)(r0 + tok) * 512 + c;
                    const float w = expf(-DECAY_SCALE * sigmoidf_(aw[tok]));
                    const float a = sigmoidf_(aa[tok]);
                    const float kd = kv[tok][jj] * (1.f + (a - 1.f) * kac);
                    SW[o] = w; SKA[o] = kk[tok][jj] * a; SKD[o] = kd;
                    bon[tok][jj] += rv[tok][jj] * kd * rkc;
                }
            }
        }
#pragma unroll
        for (int tok = 0; tok < TK; ++tok)
#pragma unroll
            for (int jj = 0; jj < 2; ++jj) { const float b = wave_sum(bon[tok][jj]); if (lane == 0) BONUS[(size_t)(r0 + tok) * 8 + wid + 4 * jj] = b; }
        __syncthreads();
    }
}

__device__ __forceinline__ void phase_prep_odd(const Params& p, int tid, int bid, int nb) {
    const int wid = tid >> 6, lane = tid & 63;
    const float* P32 = wsp<float>(p, WS_BIG);
    half_t* Q16 = wsp<half_t>(p, WS_Q16); half_t* K16 = wsp<half_t>(p, WS_K16); half_t* V16 = wsp<half_t>(p, WS_V16);
    for (int task = bid * 4 + wid; task < M * 48; task += nb * 4) {
        const int r = task / 48, u = task % 48, s = r % SEQA;
        float v = P32[(size_t)r * ODD_COLS + u * 64 + lane];
        if (u < 32 && s >= NCTX) v = rope64(v, lane, s - NCTX);
        if (u < 16) Q16[(size_t)r * 1024 + u * 64 + lane] = (half_t)(v * 0.125f);
        else if (u < 32) K16[(size_t)r * 1024 + (u - 16) * 64 + lane] = (half_t)v;
        else V16[(size_t)r * 1024 + (u - 32) * 64 + lane] = (half_t)v;
    }
}

template <int MODE>
__device__ __forceinline__ void phase_attn_simple(const Params& p, int tid, int bid, int nb) {
    const int nitems = (MODE == 0) ? 72 * 8 : 72 * 32;
    const half_t* Q16 = wsp<half_t>(p, WS_Q16); const half_t* K16 = wsp<half_t>(p, WS_K16); const half_t* V16 = wsp<half_t>(p, WS_V16);
    for (int item = bid; item < nitems; item += nb) {
        int rbk, h, comp = 0, half = 0;
        if (MODE == 0) { rbk = item >> 3; h = item & 7; } else { rbk = item >> 5; const int rest = item & 31; h = rest >> 2; comp = (rest >> 1) & 1; half = rest & 1; }
        const int r = rbk * 256 + tid, b = r / SEQA, s = r - b * SEQA;
        const bool isctx = (rbk % 9) == 0;
        const int nkeys = isctx ? NCTX : SEQA;
        const size_t kbase = (size_t)b * SEQA;
        const int qstride = MODE == 0 ? 512 : 1024, qoff = MODE == 0 ? h * 64 : h * 128 + comp * 64;
        const int kstride = MODE == 0 ? 128 : 1024, koff = MODE == 0 ? (h >> 2) * 64 : h * 128 + comp * 64;
        const int voff = MODE == 0 ? (h >> 2) * 64 : h * 128 + half * 64;
        (void)s;
        float q[64], o[64];
#pragma unroll
        for (int d = 0; d < 64; ++d) { q[d] = (float)Q16[(size_t)r * qstride + qoff + d]; o[d] = 0.f; }
        float m = -INFINITY, l = 0.f;
        for (int k0 = 0; k0 < nkeys; k0 += 4) {
            float sc[4];
#pragma unroll
            for (int j = 0; j < 4; ++j) {
                const half_t* kp = K16 + (kbase + k0 + j) * kstride + koff;
                float a = 0.f;
#pragma unroll
                for (int d = 0; d < 64; ++d) a += q[d] * (float)kp[d];
                sc[j] = a;
            }
            const float tm = fmaxf(fmaxf(sc[0], sc[1]), fmaxf(sc[2], sc[3]));
            const float mn = fmaxf(m, tm);
            const float alpha = expf(m - mn);
            l *= alpha;
#pragma unroll
            for (int d = 0; d < 64; ++d) o[d] *= alpha;
#pragma unroll
            for (int j = 0; j < 4; ++j) {
                const float pj = expf(sc[j] - mn);
                l += pj;
                const half_t* vp = V16 + (kbase + k0 + j) * kstride + voff;
#pragma unroll
                for (int d = 0; d < 64; ++d) o[d] += pj * (float)vp[d];
            }
            m = mn;
        }
        const float inv = 1.f / l;
        if (MODE == 0) {
            half_t* dst = wsp<half_t>(p, WS_MIX16) + (size_t)r * 1024 + h * 64;
#pragma unroll
            for (int d = 0; d < 64; ++d) dst[d] = (half_t)(o[d] * inv);
        } else {
            float* dst = wsp<float>(p, WS_ATT32) + (((size_t)r * 8 + h) * 2 + comp) * 128 + half * 64;
#pragma unroll
            for (int d = 0; d < 64; ++d) dst[d] = o[d] * inv;
        }
    }
}

__device__ __forceinline__ void phase_diff_finish(const Params& p, int tid, int layer, int bid, int nb) {
    const int o = layer >> 1, wid = tid >> 6, lane = tid & 63;
    const float linit = 0.8f - 0.6f * expf(-0.3f * (float)layer);
    const float d1 = wave_sum(p.od_lq1[o * 64 + lane] * p.od_lk1[o * 64 + lane]);
    const float d2 = wave_sum(p.od_lq2[o * 64 + lane] * p.od_lk2[o * 64 + lane]);
    const float lam = expf(d1) - expf(d2) + linit;
    const float s0 = p.od_subln[o * 128 + lane], s1 = p.od_subln[o * 128 + 64 + lane];
    const float* ATT = wsp<float>(p, WS_ATT32);
    half_t* MIX = wsp<half_t>(p, WS_MIX16);
    for (int task = bid * 4 + wid; task < M * 8; task += nb * 4) {
        const int r = task >> 3, h = task & 7;
        const float* a = ATT + ((size_t)r * 8 + h) * 256;
        const float o0 = a[lane] - lam * a[128 + lane], o1 = a[64 + lane] - lam * a[192 + lane];
        const float ss = wave_sum(o0 * o0 + o1 * o1) * (1.f / 128.f);
        const float sc = rsqrtf(ss + 1e-5f) * (1.f - linit);
        MIX[(size_t)r * 1024 + h * 128 + lane] = (half_t)(o0 * sc * s0);
        MIX[(size_t)r * 1024 + h * 128 + 64 + lane] = (half_t)(o1 * sc * s1);
    }
}

__device__ __forceinline__ void phase_scan(const Params& p, int tid, int bid, int nb, unsigned char* smem) {
    constexpr int CH = 32;
    float* lds = (float*)smem;
    float* Lw = lds;
    float* Lv = lds + 5 * CH * 64;
    float* Ly = Lv + CH * 16;
    const int t = tid, wid = t >> 6, lane = t & 63, rloc = lane >> 4, kq = lane & 15;
    for (int item = bid; item < 512; item += nb) {
        const int chain = item >> 2, rq = item & 3, dir = chain & 1, bh = chain >> 1, b = bh >> 3, h = bh & 7;
        const size_t rowbase = (size_t)b * SEQA;
        const float* SCN = wsp<float>(p, WS_SR);
        const float* SV = wsp<float>(p, WS_SV);
        float* YS = wsp<float>(p, WS_YSC) + (size_t)dir * M * 512;
        auto tok_of = [=](int i) -> int { return dir == 0 ? i : (i < NCTX ? (NCTX - 1 - i) : (SEQA + NCTX - 1 - i)); };
        float4 pre0, pre1, pre2, pre3, pre4, pre5, pre6, pre7, pre8, pre9, prev;
        pre0 = pre1 = pre2 = pre3 = pre4 = pre5 = pre6 = pre7 = pre8 = pre9 = prev = make_float4(0, 0, 0, 0);
#define SCAN_LD1(cc, j, dst)                                                                                                       \
        {                                                                                                                          \
            const int idx = t + 256 * (j), st = idx / 80, rem = idx % 80, a = rem >> 4, f4 = rem & 15;                              \
            const size_t row = rowbase + tok_of((cc) * CH + st);                                                                   \
            const int plane = a < 3 ? 3 + 2 * a + dir : (a == 3 ? 2 : 0);                                                          \
            dst = *(const float4*)(SCN + ((size_t)plane * M + row) * 512 + h * 64 + f4 * 4);                                       \
        }
#define SCAN_ISSUE(cc)                                                                                                             \
        {                                                                                                                          \
            SCAN_LD1(cc, 0, pre0) SCAN_LD1(cc, 1, pre1) SCAN_LD1(cc, 2, pre2) SCAN_LD1(cc, 3, pre3) SCAN_LD1(cc, 4, pre4)           \
            SCAN_LD1(cc, 5, pre5) SCAN_LD1(cc, 6, pre6) SCAN_LD1(cc, 7, pre7) SCAN_LD1(cc, 8, pre8) SCAN_LD1(cc, 9, pre9)           \
            if (t < 128) { const int st = t >> 2, f4 = t & 3; const size_t row = rowbase + tok_of((cc) * CH + st);                  \
                prev = *(const float4*)(SV + row * 512 + h * 64 + rq * 16 + f4 * 4); }                                              \
        }
#define SCAN_ST1(j, srcv)                                                                                                          \
        {                                                                                                                          \
            const int idx = t + 256 * (j), st = idx / 80, rem = idx % 80, a = rem >> 4, f4 = rem & 15;                              \
            *(float4*)(Lw + a * CH * 64 + st * 64 + f4 * 4) = srcv;                                                                \
        }
#define SCAN_COMMIT()                                                                                                              \
        {                                                                                                                          \
            SCAN_ST1(0, pre0) SCAN_ST1(1, pre1) SCAN_ST1(2, pre2) SCAN_ST1(3, pre3) SCAN_ST1(4, pre4)                               \
            SCAN_ST1(5, pre5) SCAN_ST1(6, pre6) SCAN_ST1(7, pre7) SCAN_ST1(8, pre8) SCAN_ST1(9, pre9)                               \
            if (t < 128) { const int st = t >> 2, f4 = t & 3; *(float4*)(Lv + st * 16 + f4 * 4) = prev; }                          \
        }
        float S0 = 0.f, S1 = 0.f, S2 = 0.f, S3 = 0.f;
        SCAN_ISSUE(0);
        SCAN_COMMIT();
        __syncthreads();
        for (int c = 0; c < SEQA / CH; ++c) {
            if (c + 1 < SEQA / CH) SCAN_ISSUE(c + 1);
#pragma unroll 4
            for (int st = 0; st < CH; ++st) {
                const float4 w4 = *(const float4*)(Lw + 0 * CH * 64 + st * 64 + kq * 4);
                const float4 b4 = *(const float4*)(Lw + 1 * CH * 64 + st * 64 + kq * 4);
                const float4 d4 = *(const float4*)(Lw + 2 * CH * 64 + st * 64 + kq * 4);
                const float4 a4 = *(const float4*)(Lw + 3 * CH * 64 + st * 64 + kq * 4);
                const float4 r4 = *(const float4*)(Lw + 4 * CH * 64 + st * 64 + kq * 4);
                const float vr = Lv[st * 16 + wid * 4 + rloc];
                float pk = S0 * a4.x + S1 * a4.y + S2 * a4.z + S3 * a4.w;
                pk = sum16(pk);
                S0 = S0 * w4.x + (vr * d4.x - pk * b4.x);
                S1 = S1 * w4.y + (vr * d4.y - pk * b4.y);
                S2 = S2 * w4.z + (vr * d4.z - pk * b4.z);
                S3 = S3 * w4.w + (vr * d4.w - pk * b4.w);
                float y = S0 * r4.x + S1 * r4.y + S2 * r4.z + S3 * r4.w;
                y = sum16(y);
                if (kq == 0) Ly[st * 16 + wid * 4 + rloc] = y;
            }
            __syncthreads();
            if (t < 128) {
                const int st = t >> 2, f4 = t & 3; const size_t row = rowbase + tok_of(c * CH + st);
                *(float4*)(YS + row * 512 + h * 64 + rq * 16 + f4 * 4) = *(const float4*)(Ly + st * 16 + f4 * 4);
            }
            if (c + 1 < SEQA / CH) SCAN_COMMIT();
            __syncthreads();
        }
    }
}

__device__ __forceinline__ void phase_readout(const Params& p, int tid, int layer, int bid, int nb) {
    const int e = layer >> 1, wid = tid >> 6, lane = tid & 63;
    const float* Y0 = wsp<float>(p, WS_YSC); const float* Y1 = Y0 + (size_t)M * 512;
    const float* SV = wsp<float>(p, WS_SV); const float* G = wsp<float>(p, WS_G); const float* BONUS = wsp<float>(p, WS_BONUS);
    half_t* MIX = wsp<half_t>(p, WS_MIX16);
    for (int task = bid * 4 + wid; task < M * 8; task += nb * 4) {
        const int r = task >> 3, h = task & 7;
        const size_t o = (size_t)r * 512 + h * 64 + lane;
        const float y = Y0[o] + Y1[o];
        const float mu = wave_sum(y) * (1.f / 64.f);
        const float d = y - mu;
        const float var = wave_sum(d * d) * (1.f / 64.f);
        float yn = d * rsqrtf(var + GN_EPS) * p.ev_gn_w[e * 512 + h * 64 + lane] + p.ev_gn_b[e * 512 + h * 64 + lane];
        yn += BONUS[(size_t)r * 8 + h] * SV[o];
        MIX[(size_t)r * 1024 + 512 + h * 64 + lane] = (half_t)(yn * G[o]);
    }
}

__device__ __forceinline__ void phase_route(const Params& p, int tid, int layer, int bid, int nb, unsigned char* smem) {
    float* hbuf = (float*)smem;
    float* lg = hbuf + 8 * 1024;
    const int t = tid, wid = t >> 6, lane = t & 63;
    const bool last = (layer == DEPTH - 1);
    int* cnt = wsp<int>(p, WS_CNT) + layer * 32;
    int* list = wsp<int>(p, WS_LIST);
    float* GATE = wsp<float>(p, WS_GATE); int* ESLOT = wsp<int>(p, WS_ESLOT);
    for (int rg = bid; rg < M / 8; rg += nb) {
        const int r0 = rg * 8;
        if (last && (r0 % SEQA) < NCTX) continue;
#pragma unroll
        for (int q = 0; q < 2; ++q) {
            const int lr = wid * 2 + q, r = r0 + lr;
            const float4* xr = (const float4*)(wsp<float>(p, WS_XS) + (size_t)r * 1024);
            float4 v[4]; float ss = 0.f;
#pragma unroll
            for (int j = 0; j < 4; ++j) { v[j] = xr[lane + 64 * j]; ss += v[j].x * v[j].x + v[j].y * v[j].y + v[j].z * v[j].z + v[j].w * v[j].w; }
            ss = wave_sum(ss);
            norm_row_store(p, layer, r, 3, v, ss, lane, hbuf + lr * 1024);
        }
        __syncthreads();
        {
            const int lr = t >> 5, og = t & 31;
            const float* wrt = p.moe_w_rt + (size_t)layer * 1024 * 32 + og;
            const float* wgp = p.moe_w_grp + (size_t)layer * 1024 * 4 + (og & 3);
            float acc = 0.f, acc2 = 0.f;
            for (int d = 0; d < 1024; ++d) { const float hv = hbuf[lr * 1024 + d]; acc += hv * wrt[d * 32]; acc2 += hv * wgp[d * 4]; }
            lg[lr * 36 + 4 + og] = acc + p.moe_b_rt[layer * 32 + og];
            if (og < 4) lg[lr * 36 + og] = acc2 + p.moe_b_grp[layer * 4 + og];
        }
        __syncthreads();
        if (t < 8) {
            const int r = r0 + t;
            const float* L = lg + t * 36;
            int sel = 0; float mx = L[0];
            for (int g = 1; g < 4; ++g) if (L[g] > mx) { mx = L[g]; sel = g; }
            float z = 0.f;
            for (int g = 0; g < 4; ++g) z += expf(L[g] - mx);
            const float grp_w = 1.f / z;
            const float* E = L + 4 + sel * 8;
            int i1 = 0; float v1 = E[0];
            for (int j = 1; j < 8; ++j) if (E[j] > v1) { v1 = E[j]; i1 = j; }
            int i2 = -1; float v2 = -INFINITY;
            for (int j = 0; j < 8; ++j) if (j != i1 && E[j] > v2) { v2 = E[j]; i2 = j; }
            const float e2 = expf(v2 - v1);
            const float g1 = grp_w / (1.f + e2), g2 = grp_w * e2 / (1.f + e2);
            const int ea = sel * 8 + i1, eb = sel * 8 + i2;
            const int pa = atomicAdd(&cnt[ea], 1);
            const int pb = atomicAdd(&cnt[eb], 1);
            list[(size_t)ea * LISTCAP + pa] = r;
            list[(size_t)eb * LISTCAP + pb] = r;
            GATE[r * 2 + 0] = g1; GATE[r * 2 + 1] = g2;
            ESLOT[r * 2 + 0] = ea * 65536 + pa; ESLOT[r * 2 + 1] = eb * 65536 + pb;
        }
        __syncthreads();
    }
}

template <int TM>
__device__ __forceinline__ void moe_tables(const Params& p, int tid, int layer, int* tab  ) {
    if (tid == 0) {
        const int* cnt = wsp<int>(p, WS_CNT) + layer * 32;
        int ts = 0;
        for (int e = 0; e < 32; ++e) { const int c = cnt[e]; tab[e] = c; tab[32 + e] = ts; tab[65 + e] = ts * TM; ts += (c + TM - 1) / TM; }
        tab[64] = ts;
    }
    __syncthreads();
}
__device__ __forceinline__ void phase_moe1(const Params& p, int tid, int layer, int bid, int nb, unsigned char* smem) {
    constexpr int TM = 64;
    int* tab = (int*)(smem + 3 * 16 * 68 * 4);
    moe_tables<TM>(p, tid, layer, tab);
    const int nrb = tab[64], nitems = nrb * 8;
    const half_t* H16 = wsp<half_t>(p, WS_H16);
    half_t* HM = wsp<half_t>(p, WS_HM16);
    const int* list = wsp<int>(p, WS_LIST);
    for (int item = bid; item < nitems; item += nb) {
        const int rb = item >> 3, nt = item & 7;
        int e = 0;
        while (e < 31 && tab[32 + e + 1] <= rb) ++e;
        const int lb = rb - tab[32 + e], cnt = tab[e], orow0 = tab[65 + e] + lb * TM;
        const int* le = list + (size_t)e * LISTCAP;
        auto rowsrc = [=](int i) -> long { const int pos = lb * TM + i; return pos < cnt ? (long)le[pos] : -1L; };
        const float* Wg = p.moe_w_gate + ((size_t)(layer * 32 + e)) * 1024 * 512 + nt * 64;
        const float* Wu = p.moe_w_up + ((size_t)(layer * 32 + e)) * 1024 * 512 + nt * 64;
        auto epi = [=](int i, int j, float g, float u) { HM[(size_t)(orow0 + i) * 512 + nt * 64 + j] = (half_t)(siluf_(g) * u); };
        gemm_tile_simple<true>(H16, 1024, rowsrc, Wg, Wu, 512, 1024, epi, smem, tid);
    }
}
__device__ __forceinline__ void phase_moe2(const Params& p, int tid, int layer, int bid, int nb, unsigned char* smem) {
    constexpr int TM = 64;
    int* tab = (int*)(smem + 3 * 16 * 68 * 4);
    moe_tables<TM>(p, tid, layer, tab);
    const int nrb = tab[64], nitems = nrb * 16;
    const half_t* HM = wsp<half_t>(p, WS_HM16);
    float* YO = wsp<float>(p, WS_YOUT);
    for (int item = bid; item < nitems; item += nb) {
        const int rb = item >> 4, nt = item & 15;
        int e = 0;
        while (e < 31 && tab[32 + e + 1] <= rb) ++e;
        const int lb = rb - tab[32 + e], orow0 = tab[65 + e] + lb * TM;
        auto rowsrc = [=](int i) -> long { return orow0 + i; };
        const float* Wd = p.moe_w_down + ((size_t)(layer * 32 + e)) * 512 * 1024 + nt * 64;
        auto epi = [=](int i, int j, float v, float) { YO[(size_t)(orow0 + i) * 1024 + nt * 64 + j] = v; };
        gemm_tile_simple<false>(HM, 512, rowsrc, Wd, nullptr, 1024, 512, epi, smem, tid);
    }
}

__device__ __forceinline__ void phase_combine(const Params& p, int tid, int layer, int bid, int nb, unsigned char* smem) {
    constexpr int TM = 64;
    int* tab = (int*)smem;
    moe_tables<TM>(p, tid, layer, tab);
    const int wid = tid >> 6, lane = tid & 63;
    const bool last = (layer == DEPTH - 1);
    const float* GATE = wsp<float>(p, WS_GATE); const int* ESLOT = wsp<int>(p, WS_ESLOT);
    const float* YO = wsp<float>(p, WS_YOUT);
    for (int r = bid * 4 + wid; r < M; r += nb * 4) {
        const int b = r / SEQA, s = r - b * SEQA;
        if (last && s < NCTX) continue;
        const int es0 = ESLOT[r * 2], es1 = ESLOT[r * 2 + 1];
        const float g0 = GATE[r * 2], g1 = GATE[r * 2 + 1];
        const size_t s0 = (size_t)(tab[65 + (es0 >> 16)] + (es0 & 65535)), s1 = (size_t)(tab[65 + (es1 >> 16)] + (es1 & 65535));
        float4* xr = (float4*)(wsp<float>(p, WS_XS) + (size_t)r * 1024);
        const float4* y0 = (const float4*)(YO + s0 * 1024); const float4* y1 = (const float4*)(YO + s1 * 1024);
        const float4* m5 = (const float4*)mods_ptr(p, layer, mods_row(r), 5);
        float4 v[4]; float ss = 0.f;
#pragma unroll
        for (int j = 0; j < 4; ++j) {
            const float4 x = xr[lane + 64 * j], a = y0[lane + 64 * j], c = y1[lane + 64 * j], g = m5[lane + 64 * j];
            float4 o;
            o.x = x.x + g.x * (g0 * a.x + g1 * c.x); o.y = x.y + g.y * (g0 * a.y + g1 * c.y);
            o.z = x.z + g.z * (g0 * a.z + g1 * c.z); o.w = x.w + g.w * (g0 * a.w + g1 * c.w);
            v[j] = o; ss += o.x * o.x + o.y * o.y + o.z * o.z + o.w * o.w;
        }
        ss = wave_sum(ss);
        if (!last) {
#pragma unroll
            for (int j = 0; j < 4; ++j) xr[lane + 64 * j] = v[j];
            norm_row_store(p, layer + 1, r, 0, v, ss, lane, nullptr);
        } else {
            const float rstd = rsqrtf(ss * (1.f / 1024.f) + 1e-6f);
            float4* dst = (float4*)(p.out + ((size_t)(b * NLAT + s - NCTX)) * 1024);
            const float4* fg = (const float4*)p.final_gain;
#pragma unroll
            for (int j = 0; j < 4; ++j) { const float4 g = fg[lane + 64 * j]; float4 o; o.x = v[j].x * rstd * g.x; o.y = v[j].y * rstd * g.y; o.z = v[j].z * rstd * g.z; o.w = v[j].w * rstd * g.w; dst[lane + 64 * j] = o; }
        }
    }
}


#define XB_TMO      128
#define XB_XCNT(j)  (256  + 64 * (j))
#define XB_XSUB(j)  (1280 + 64 * (j))
#define XB_XGEN(j)  (2304 + 64 * (j))
#define XB_TOP      3328
#define XB_TOPGEN   3392
#define XCD_BAR_WORDS 3456
#define XB_SPIN_CAP (1u << 22)
#define LAS __attribute__((address_space(3)))

__device__ __forceinline__ unsigned xb_ld(unsigned* p)              { return __hip_atomic_load(p, __ATOMIC_RELAXED, __HIP_MEMORY_SCOPE_AGENT); }
__device__ __forceinline__ unsigned xb_add(unsigned* p, unsigned v) { return __hip_atomic_fetch_add(p, v, __ATOMIC_RELAXED, __HIP_MEMORY_SCOPE_AGENT); }
__device__ __forceinline__ unsigned xb_xcc_id() { return (unsigned)__builtin_amdgcn_s_getreg((3 << 11) | 20) & 0xFu; }
#define XB_SPIN(cond, bar) do { unsigned _sp = 0; while (cond) { __builtin_amdgcn_s_sleep(1); \
    if ((++_sp & 255u) == 0u) { if (xb_ld(&(bar)[XB_TMO])) break; if (_sp > XB_SPIN_CAP) { atomicAdd(&(bar)[XB_TMO], 1u); break; } } } } while (0)

struct XcdBarrier {
    unsigned* bar; unsigned x;
    volatile LAS unsigned* st;
};
__device__ __forceinline__ XcdBarrier xcd_barrier_post(unsigned* bar, volatile LAS unsigned* st) {
    XcdBarrier b; b.bar = bar; b.x = xb_xcc_id(); b.st = st;
    if (threadIdx.x == 0) (void)xb_add(&bar[XB_XCNT(b.x)], 1u);
    return b;
}
__device__ __forceinline__ void xcd_barrier_complete(unsigned* bar, unsigned x, unsigned& nloc, unsigned& nx) {
    const unsigned G = gridDim.x * gridDim.y * gridDim.z;
    unsigned sum, cnt, mine, sp = 0u;
    for (;;) {
        sum = 0u; cnt = 0u; mine = 0u;
#pragma unroll
        for (unsigned j = 0; j < 16; ++j) { const unsigned c = xb_ld(&bar[XB_XCNT(j)]); sum += c; cnt += (c > 0u) ? 1u : 0u; mine = (j == x) ? c : mine; }
        if (sum == G) break;
        __builtin_amdgcn_s_sleep(1);
        if ((++sp & 255u) == 0u) { if (xb_ld(&bar[XB_TMO])) break; if (sp > XB_SPIN_CAP) { atomicAdd(&bar[XB_TMO], 1u); break; } }
    }
    nloc = mine > 0u ? mine : 1u; nx = cnt > 0u ? cnt : 1u;
}
__device__ __forceinline__ void xcd_barrier(const XcdBarrier& b) {
    asm volatile("s_waitcnt vmcnt(0)" ::: "memory");
    __syncthreads();
    if (threadIdx.x == 0) {
        unsigned* bar = b.bar;
        __builtin_amdgcn_s_waitcnt(0);
        unsigned nloc = b.st[0], nx = b.st[1];
        if (nloc == 0u) { xcd_barrier_complete(bar, b.x, nloc, nx); b.st[0] = nloc; b.st[1] = nx; }
        const unsigned old = xb_add(&bar[XB_XSUB(b.x)], 1u);
        const unsigned gen = old / nloc;
        if (old + 1u == (gen + 1u) * nloc) {
            __builtin_amdgcn_fence(__ATOMIC_RELEASE, "agent");
            asm volatile("s_waitcnt vmcnt(0)" ::: "memory");
            const unsigned og = xb_add(&bar[XB_TOP], 1u);
            const unsigned tg = og / nx;
            if (og + 1u == (tg + 1u) * nx) xb_add(&bar[XB_TOPGEN], 1u);
            else XB_SPIN(xb_ld(&bar[XB_TOPGEN]) == tg, bar);
            __builtin_amdgcn_fence(__ATOMIC_ACQUIRE, "agent");
            xb_add(&bar[XB_XGEN(b.x)], 1u);
            asm volatile("s_waitcnt vmcnt(0)" ::: "memory");
        } else {
            XB_SPIN(xb_ld(&bar[XB_XGEN(b.x)]) == gen, bar);
            __builtin_amdgcn_fence(__ATOMIC_ACQUIRE, "agent");
            asm volatile("s_waitcnt vmcnt(0)" ::: "memory");
        }
    }
    __syncthreads();
}

enum { PH_MODS = 0, PH_COPY, PH_NORM1, PH_GEMM_IN, PH_PREP, PH_ATTN, PH_SCAN, PH_POST, PH_GEMM_OUT, PH_ROUTE, PH_MOE1, PH_MOE2, PH_COMBINE };

template <int PH>
__device__ __forceinline__ void run_phase(const Params& p, int tid, int layer, int bid, int nb, unsigned char* smem) {
    const bool even = (layer & 1) == 0;
    const int e = layer >> 1;
    if (PH == PH_MODS) phase_mods(p, tid, bid, nb, smem);
    else if (PH == PH_COPY) phase_copy(p, tid, bid, nb);
    else if (PH == PH_NORM1) phase_norm1(p, tid, layer, bid, nb);
    else if (PH == PH_GEMM_IN) {
        if (even) phase_gemm_dense<0>(p, tid, layer, wsp<half_t>(p, WS_H16), p.ev_w_in + (size_t)e * 1024 * EVEN_COLS, EVEN_COLS, bid, nb, smem);
        else phase_gemm_dense<0>(p, tid, layer, wsp<half_t>(p, WS_H16), p.od_w_in + (size_t)e * 1024 * ODD_COLS, ODD_COLS, bid, nb, smem);
    } else if (PH == PH_PREP) { if (even) phase_prep_even(p, tid, layer, bid, nb, smem); else phase_prep_odd(p, tid, bid, nb); }
    else if (PH == PH_ATTN) { if (even) phase_attn_simple<0>(p, tid, bid, nb); else phase_attn_simple<1>(p, tid, bid, nb); }
    else if (PH == PH_SCAN) { if (even) phase_scan(p, tid, bid, nb, smem); }
    else if (PH == PH_POST) { if (even) phase_readout(p, tid, layer, bid, nb); else phase_diff_finish(p, tid, layer, bid, nb); }
    else if (PH == PH_GEMM_OUT) phase_gemm_dense<1>(p, tid, layer, wsp<half_t>(p, WS_MIX16), (even ? p.ev_w_out : p.od_w_out) + (size_t)e * 1024 * 1024, 1024, bid, nb, smem);
    else if (PH == PH_ROUTE) phase_route(p, tid, layer, bid, nb, smem);
    else if (PH == PH_MOE1) phase_moe1(p, tid, layer, bid, nb, smem);
    else if (PH == PH_MOE2) phase_moe2(p, tid, layer, bid, nb, smem);
    else if (PH == PH_COMBINE) phase_combine(p, tid, layer, bid, nb, smem);
}

template <int PH>
__global__ void __launch_bounds__(NT, 2) k_phase(Params p, int layer) {
    extern __shared__ __attribute__((aligned(16))) unsigned char smem[];
    run_phase<PH>(p, threadIdx.x, layer, blockIdx.x, gridDim.x, smem);
}

constexpr int NPTR = 42;
constexpr int MEGA_LDS = LDS_BYTES + 16 + NPTR * 8;
static_assert(sizeof(Params) == NPTR * 8, "Params must be 42 pointers");
__device__ __forceinline__ Params load_params(const unsigned char* tab) {
    const LAS unsigned* t = (const LAS unsigned*)tab;
    Params q;
    unsigned long long v[NPTR];
#pragma unroll
    for (int i = 0; i < NPTR; ++i) {
        const unsigned lo = __builtin_amdgcn_readfirstlane(t[2 * i]), hi = __builtin_amdgcn_readfirstlane(t[2 * i + 1]);
        v[i] = ((unsigned long long)hi << 32) | lo;
    }
    __builtin_memcpy(&q, v, sizeof(Params));
    return q;
}
#define RUN(PH, layer) { const Params q = load_params(smem + LDS_BYTES + 16); int tid_ = threadIdx.x; asm volatile("" : "+v"(tid_)); int bid_ = bid; asm volatile("" : "+s"(bid_)); run_phase<PH>(q, tid_, layer, bid_, nb, smem); }
__global__ void __launch_bounds__(NT, 2) k_mega(Params p) {
    extern __shared__ __attribute__((aligned(16))) unsigned char smem[];
    const int bid = blockIdx.x, nb = gridDim.x;
    if (threadIdx.x == 0) *(uint4*)(smem + LDS_BYTES) = make_uint4(0u, 0u, 0u, 0u);
    {
        unsigned long long v[NPTR];
        __builtin_memcpy(v, &p, sizeof(Params));
        unsigned long long* tab = (unsigned long long*)(smem + LDS_BYTES + 16);
        if (threadIdx.x == 0) {
#pragma unroll
            for (int i = 0; i < NPTR; ++i) tab[i] = v[i];
        }
    }
    unsigned* barw = (unsigned*)(p.ws + WS_BAR);
    __syncthreads();
    XcdBarrier bar = xcd_barrier_post(barw, (volatile LAS unsigned*)(smem + LDS_BYTES));
    RUN(PH_MODS, 0);
    RUN(PH_COPY, 0);
    xcd_barrier(bar);
    RUN(PH_NORM1, 0);
    xcd_barrier(bar);
#pragma unroll 1
    for (int layer = 0; layer < DEPTH; ++layer) {
        RUN(PH_GEMM_IN, layer);
        xcd_barrier(bar);
        RUN(PH_PREP, layer);
        xcd_barrier(bar);
        RUN(PH_ATTN, layer);
        RUN(PH_SCAN, layer);
        xcd_barrier(bar);
        RUN(PH_POST, layer);
        xcd_barrier(bar);
        RUN(PH_GEMM_OUT, layer);
        xcd_barrier(bar);
        RUN(PH_ROUTE, layer);
        xcd_barrier(bar);
        RUN(PH_MOE1, layer);
        xcd_barrier(bar);
        RUN(PH_MOE2, layer);
        xcd_barrier(bar);
        RUN(PH_COMBINE, layer);
        if (layer + 1 < DEPTH) xcd_barrier(bar);
    }
}

template <int PH>
static void launch_phase(const Params& p, int layer, int grid, hipStream_t stream) {
    static bool attr_set = false;
    if (!attr_set) { (void)hipFuncSetAttribute((const void*)k_phase<PH>, hipFuncAttributeMaxDynamicSharedMemorySize, LDS_BYTES); attr_set = true; }
    hipLaunchKernelGGL(k_phase<PH>, dim3(grid), dim3(NT), LDS_BYTES, stream, p, layer);
}

extern "C" void kernel_launch(void* const* d_in, const int* in_sizes, int n_in, void* d_out, int out_size, void* d_ws, size_t ws_size, hipStream_t stream) {
    if (n_in != 40 || ws_size < WS_END) { fprintf(stderr, "kernel_launch: unexpected inputs (n_in %d, ws %zu, need %zu)\n", n_in, ws_size, (size_t)WS_END); return; }
    Params p{};
    const float** pp = (const float**)&p;
    for (int i = 0; i < 40; ++i) pp[i] = (const float*)d_in[i];
    p.out = (float*)d_out; p.ws = (unsigned char*)d_ws;
    (void)hipMemsetAsync(d_ws, 0, WS_ZERO_BYTES, stream);
#if ONE_LAUNCH
    static int grid = 0;
    if (grid == 0) {
        int dev = 0, cus = 0, per_cu = 0;
        (void)hipGetDevice(&dev);
        (void)hipDeviceGetAttribute(&cus, hipDeviceAttributeMultiprocessorCount, dev);
        (void)hipFuncSetAttribute((const void*)k_mega, hipFuncAttributeMaxDynamicSharedMemorySize, MEGA_LDS);
        if (hipOccupancyMaxActiveBlocksPerMultiprocessor(&per_cu, (const void*)k_mega, NT, MEGA_LDS) != hipSuccess || per_cu < 1) per_cu = 1;
        (void)hipGetLastError();
        if (cus <= 0) cus = 256;
        grid = cus * (per_cu < 2 ? per_cu : 2);
    }
    hipLaunchKernelGGL(k_mega, dim3(grid), dim3(NT), MEGA_LDS, stream, p);
#else
    const int grid = 1024;
    launch_phase<PH_MODS>(p, 0, 512, stream);
    launch_phase<PH_COPY>(p, 0, grid, stream);
    launch_phase<PH_NORM1>(p, 0, grid, stream);
    for (int layer = 0; layer < DEPTH; ++layer) {
        launch_phase<PH_GEMM_IN>(p, layer, grid, stream);
        launch_phase<PH_PREP>(p, layer, grid, stream);
        launch_phase<PH_ATTN>(p, layer, grid, stream);
        if ((layer & 1) == 0) launch_phase<PH_SCAN>(p, layer, 512, stream);
        launch_phase<PH_POST>(p, layer, grid, stream);
        launch_phase<PH_GEMM_OUT>(p, layer, grid, stream);
        launch_phase<PH_ROUTE>(p, layer, grid, stream);
        launch_phase<PH_MOE1>(p, layer, grid, stream);
        launch_phase<PH_MOE2>(p, layer, grid, stream);
        launch_phase<PH_COMBINE>(p, layer, grid, stream);
    }
#endif
}
```

```cpp
#include <hip/hip_runtime.h>
#include <stdint.h>
#include <stdio.h>

#ifndef USE_MFMA_ATTN
#define USE_MFMA_ATTN 1
#endif
#ifndef USE_MFMA_GEMM
#define USE_MFMA_GEMM 1
#endif
#ifndef ONE_LAUNCH
#define ONE_LAUNCH 1
#endif

#define LAS __attribute__((address_space(3)))
typedef _Float16 half_t;
typedef _Float16 h4_t __attribute__((ext_vector_type(4)));
typedef _Float16 h8_t __attribute__((ext_vector_type(8)));

constexpr int D = 1024, NB = 8, NLAT = 2048, NCTX = 256, SEQA = NLAT + NCTX  , M = NB * SEQA  ;
constexpr int DEPTH = 4;
constexpr int EVEN_COLS = 2560, ODD_COLS = 3072;
constexpr int NEXP = 32, EH = 512;
constexpr int LISTCAP = 36864, MAXSLOT = 40960;
constexpr float DECAY_SCALE = 0.60653065971263342f;
constexpr float GN_EPS = 64e-5f;
constexpr float QSCALE = 0.125f * 1.4426950408889634f;
constexpr int NT = 256;
constexpr int LDS_BYTES = 65536;

constexpr size_t WS_BAR = 0;
constexpr size_t WS_CNT = 16384;
constexpr size_t WS_ZERO_BYTES = 32768;
constexpr size_t WS_MODS = 32768;
constexpr size_t WS_XS = 1u << 20;
constexpr size_t SZ_F32_1024 = (size_t)M * 1024 * 4;
constexpr size_t SZ_H16_1024 = (size_t)M * 1024 * 2;
constexpr size_t SZ_F32_512 = (size_t)M * 512 * 4;
constexpr size_t WS_H16 = WS_XS + SZ_F32_1024;
constexpr size_t WS_BIG = WS_H16 + SZ_H16_1024;
constexpr size_t SZ_BIG = (size_t)M * 3072 * 4;
constexpr size_t WS_Q16 = WS_BIG + SZ_BIG;
constexpr size_t WS_K16 = WS_Q16 + SZ_H16_1024;
constexpr size_t WS_V16 = WS_K16 + SZ_H16_1024;
constexpr size_t WS_MIX16 = WS_V16 + SZ_H16_1024;
constexpr size_t WS_SR = WS_MIX16 + SZ_H16_1024;
constexpr size_t WS_SV = WS_SR + SZ_F32_512;
constexpr size_t WS_SKK = WS_SV + SZ_F32_512;
constexpr size_t WS_SW = WS_SKK + SZ_F32_512;
constexpr size_t WS_SKA = WS_SW + 2 * SZ_F32_512;
constexpr size_t WS_SKD = WS_SKA + 2 * SZ_F32_512;
constexpr size_t WS_G = WS_SKD + 2 * SZ_F32_512;
constexpr size_t WS_VF = WS_G + SZ_F32_512;
constexpr size_t WS_BONUS = WS_VF + SZ_F32_512;
constexpr size_t WS_LIST = WS_BONUS + (size_t)M * 8 * 4;
constexpr size_t WS_GATE = WS_LIST + (size_t)NEXP * LISTCAP * 4;
constexpr size_t WS_ESLOT = WS_GATE + (size_t)M * 2 * 4;
constexpr size_t WS_END = WS_ESLOT + (size_t)M * 2 * 4;
constexpr size_t WS_YSC = WS_BIG;
constexpr size_t WS_ATT32 = WS_BIG;
constexpr size_t WS_HM16 = WS_BIG;
constexpr size_t WS_YOUT = WS_BIG + (size_t)MAXSLOT * 512 * 2;
static_assert(WS_YOUT + (size_t)MAXSLOT * 1024 * 4 <= WS_BIG + SZ_BIG, "BIG region too small");
static_assert(WS_END < (size_t)1000 * 1000 * 1000, "workspace too large");

struct Params {
    const float *x, *c, *ctx, *c_ctx, *mod_w, *mod_b, *ev_w_in, *ev_w_out, *ev_q_gain, *ev_k_gain, *ev_mu_prev, *ev_mu_next, *ev_w0, *ev_w2,
        *ev_a0, *ev_a2, *ev_g2, *ev_k_k, *ev_k_a, *ev_r_k, *ev_gn_w, *ev_gn_b, *ev_v0, *ev_v1, *ev_v2, *od_w_in, *od_w_out, *od_lq1, *od_lk1,
        *od_lq2, *od_lk2, *od_subln, *moe_w_grp, *moe_b_grp, *moe_w_rt, *moe_b_rt, *moe_w_gate, *moe_w_up, *moe_w_down, *final_gain;
    float* out;
    unsigned char* ws;
};

__device__ __forceinline__ float wave_sum(float v) {
#pragma unroll
    for (int m = 32; m >= 1; m >>= 1) v += __shfl_xor(v, m, 64);
    return v;
}
__device__ __forceinline__ float sum16(float v) {
#pragma unroll
    for (int m = 8; m >= 1; m >>= 1) v += __shfl_xor(v, m, 64);
    return v;
}
__device__ __forceinline__ float sigmoidf_(float x) { return 1.f / (1.f + expf(-x)); }
__device__ __forceinline__ float siluf_(float x) { return x / (1.f + expf(-x)); }
__device__ __forceinline__ int mods_row(int r) { const int b = r / SEQA, s = r - b * SEQA; return s < NCTX ? 8 : b; }
__device__ __forceinline__ const float* mods_ptr(const Params& p, int layer, int mr, int chunk) {
    return (const float*)(p.ws + WS_MODS) + ((size_t)(layer * 9 + mr)) * 6144 + chunk * 1024;
}
template <class T> __device__ __forceinline__ T* wsp(const Params& p, size_t off) { return (T*)(p.ws + off); }

__device__ __forceinline__ void phase_mods(const Params& p, int tid, int bid, int nb, unsigned char* smem) {
    float* cond = (float*)smem;
    float* part = cond + 9 * 1024;
    const int t = tid;
    for (int i = t; i < 9 * 1024; i += NT) { const int r = i >> 10, d = i & 1023; const float v = (r < 8) ? p.c[r * 1024 + d] : p.c_ctx[d]; cond[i] = siluf_(v); }
    __syncthreads();
    float* mods = wsp<float>(p, WS_MODS);
    for (int item = bid; item < 512; item += nb) {
        const int layer = item >> 7, col0 = (item & 127) * 48;
        const int cq = t % 12, dg = t / 12;
        if (dg < 16) {
            float acc[9][4];
#pragma unroll
            for (int r = 0; r < 9; ++r)
#pragma unroll
                for (int j = 0; j < 4; ++j) acc[r][j] = 0.f;
            const float* W = p.mod_w + (size_t)layer * 1024 * 6144 + col0 + cq * 4;
            for (int i = 0; i < 64; ++i) {
                const int d = dg * 64 + i;
                const float4 w = *(const float4*)(W + (size_t)d * 6144);
#pragma unroll
                for (int r = 0; r < 9; ++r) { const float cv = cond[r * 1024 + d]; acc[r][0] += cv * w.x; acc[r][1] += cv * w.y; acc[r][2] += cv * w.z; acc[r][3] += cv * w.w; }
            }
#pragma unroll
            for (int r = 0; r < 9; ++r)
#pragma unroll
                for (int j = 0; j < 4; ++j) part[(dg * 9 + r) * 48 + cq * 4 + j] = acc[r][j];
        }
        __syncthreads();
        for (int o = t; o < 9 * 48; o += NT) {
            const int r = o / 48, cc = o % 48;
            float s = p.mod_b[layer * 6144 + col0 + cc];
            for (int g = 0; g < 16; ++g) s += part[(g * 9 + r) * 48 + cc];
            mods[((size_t)(layer * 9 + r)) * 6144 + col0 + cc] = s;
        }
        __syncthreads();
    }
}

__device__ __forceinline__ void phase_copy(const Params& p, int tid, int bid, int nb) {
    float4* XS = wsp<float4>(p, WS_XS);
    for (size_t i = (size_t)bid * NT + tid; i < (size_t)M * 256; i += (size_t)nb * NT) {
        const int r = (int)(i >> 8), c4 = (int)(i & 255);
        const int b = r / SEQA, s = r - b * SEQA;
        const float4* src = (s < NCTX) ? (const float4*)(p.ctx + ((size_t)(b * NCTX + s)) * 1024) : (const float4*)(p.x + ((size_t)(b * NLAT + s - NCTX)) * 1024);
        XS[i] = src[c4];
    }
}

__device__ __forceinline__ void norm_row_store(const Params& p, int layer, int r, int chunk_shift, const float4 (&v)[4], float ss, int lane, float* hbuf  ) {
    const float rstd = rsqrtf(ss * (1.f / 1024.f) + 1e-6f);
    const int mr = mods_row(r);
    const float4* sh = (const float4*)mods_ptr(p, layer, mr, chunk_shift);
    const float4* sc = (const float4*)mods_ptr(p, layer, mr, chunk_shift + 1);
    half_t* H = wsp<half_t>(p, WS_H16) + (size_t)r * 1024;
#pragma unroll
    for (int j = 0; j < 4; ++j) {
        const float4 a = sh[lane + 64 * j], b = sc[lane + 64 * j];
        float4 h;
        h.x = v[j].x * rstd * (1.f + b.x) + a.x; h.y = v[j].y * rstd * (1.f + b.y) + a.y;
        h.z = v[j].z * rstd * (1.f + b.z) + a.z; h.w = v[j].w * rstd * (1.f + b.w) + a.w;
        h4_t hh; hh.x = (half_t)h.x; hh.y = (half_t)h.y; hh.z = (half_t)h.z; hh.w = (half_t)h.w;
        *(h4_t*)(H + (lane + 64 * j) * 4) = hh;
        if (hbuf) *(float4*)(hbuf + (lane + 64 * j) * 4) = h;
    }
}
__device__ __forceinline__ void phase_norm1(const Params& p, int tid, int layer, int bid, int nb) {
    const int wid = tid >> 6, lane = tid & 63;
    for (int r = bid * 4 + wid; r < M; r += nb * 4) {
        const float4* xr = (const float4*)(wsp<float>(p, WS_XS) + (size_t)r * 1024);
        float4 v[4]; float ss = 0.f;
#pragma unroll
        for (int j = 0; j < 4; ++j) { v[j] = xr[lane + 64 * j]; ss += v[j].x * v[j].x + v[j].y * v[j].y + v[j].z * v[j].z + v[j].w * v[j].w; }
        ss = wave_sum(ss);
        norm_row_store(p, layer, r, 0, v, ss, lane, nullptr);
    }
}

template <bool DUAL, class RowSrc, class Epi>
__device__ __forceinline__ void gemm_tile_simple(const half_t* __restrict__ A, int lda, RowSrc rowsrc, const float* __restrict__ B1, const float* __restrict__ B2, int ldb,
                                                 int K, Epi epi, unsigned char* smem, int tid) {
    float (*As)[68] = (float (*)[68])smem;
    float (*Bs)[68] = (float (*)[68])(smem + 16 * 68 * 4);
    float (*Bs2)[68] = (float (*)[68])(smem + 2 * 16 * 68 * 4);
    const int t = tid, tx = t & 15, ty = t >> 4;
    const int arow = t >> 2, akq = (t & 3) * 4;
    const int bk = t >> 4, bn4 = (t & 15) * 4;
    const long asrc = rowsrc(arow);
    float acc[4][4], acc2[4][4];
#pragma unroll
    for (int i = 0; i < 4; ++i)
#pragma unroll
        for (int j = 0; j < 4; ++j) { acc[i][j] = 0.f; acc2[i][j] = 0.f; }
    for (int k0 = 0; k0 < K; k0 += 16) {
        h4_t av = {0, 0, 0, 0};
        if (asrc >= 0) av = *(const h4_t*)(A + (size_t)asrc * lda + k0 + akq);
        const float4 bv = *(const float4*)(B1 + (size_t)(k0 + bk) * ldb + bn4);
        float4 bv2 = make_float4(0, 0, 0, 0);
        if (DUAL) bv2 = *(const float4*)(B2 + (size_t)(k0 + bk) * ldb + bn4);
        __syncthreads();
        As[akq + 0][arow] = (float)av.x; As[akq + 1][arow] = (float)av.y; As[akq + 2][arow] = (float)av.z; As[akq + 3][arow] = (float)av.w;
        *(float4*)&Bs[bk][bn4] = bv;
        if (DUAL) *(float4*)&Bs2[bk][bn4] = bv2;
        __syncthreads();
#pragma unroll
        for (int k = 0; k < 16; ++k) {
            const float4 a = *(const float4*)&As[k][ty * 4];
            const float4 b = *(const float4*)&Bs[k][tx * 4];
            const float aa[4] = {a.x, a.y, a.z, a.w}, bb[4] = {b.x, b.y, b.z, b.w};
#pragma unroll
            for (int i = 0; i < 4; ++i)
#pragma unroll
                for (int j = 0; j < 4; ++j) acc[i][j] += aa[i] * bb[j];
            if (DUAL) {
                const float4 b2 = *(const float4*)&Bs2[k][tx * 4];
                const float cc[4] = {b2.x, b2.y, b2.z, b2.w};
#pragma unroll
                for (int i = 0; i < 4; ++i)
#pragma unroll
                    for (int j = 0; j < 4; ++j) acc2[i][j] += aa[i] * cc[j];
            }
        }
    }
#pragma unroll
    for (int i = 0; i < 4; ++i)
#pragma unroll
        for (int j = 0; j < 4; ++j) epi(ty * 4 + i, tx * 4 + j, acc[i][j], acc2[i][j]);
    __syncthreads();
}

typedef float f32x16_t __attribute__((ext_vector_type(16)));
typedef short s16x4_t __attribute__((__vector_size__(8)));
typedef short s16x8_t __attribute__((ext_vector_type(8)));
constexpr int GA_CS = 2064, GB_RS = 320, G_SA_BYTES = 8 * GA_CS, G_SB_BYTES = 64 * GB_RS, G_LDS_BYTES = G_SA_BYTES + G_SB_BYTES;
template <bool DUAL, class RowSrc, class BSrc, class Epi>
__device__ __forceinline__ void gemm_tile_mfma(const half_t* __restrict__ A, int lda, RowSrc rowsrc, BSrc bsrc, int K, Epi epi, unsigned char* smem, int tid) {
    unsigned char* sA = smem;
    unsigned char* sB = smem + G_SA_BYTES;
    const int lane = tid & 63, wid = tid >> 6, wm = wid >> 1, wn = wid & 1;
    long rs[4];
#pragma unroll
    for (int j = 0; j < 4; ++j) rs[j] = rowsrc((tid + 256 * j) >> 3);
    const int akc = tid & 7;
    h8_t ra[4]; float4 rb[8];
    f32x16_t acc[2][2];
#pragma unroll
    for (int i = 0; i < 2; ++i)
#pragma unroll
        for (int j = 0; j < 2; ++j)
#pragma unroll
            for (int r = 0; r < 16; ++r) acc[i][j][r] = 0.f;
    const int nkt = K >> 6;
#define GEMM_LOAD(kt)                                                                                                   \
    {                                                                                                                   \
        _Pragma("unroll") for (int j = 0; j < 4; ++j) {                                                                 \
            h8_t z = {0, 0, 0, 0, 0, 0, 0, 0};                                                                          \
            ra[j] = rs[j] >= 0 ? *(const h8_t*)(A + (size_t)rs[j] * lda + (kt) * 64 + akc * 8) : z;                      \
        }                                                                                                               \
        _Pragma("unroll") for (int j = 0; j < 8; ++j) {                                                                 \
            const int i_ = tid + 256 * j;                                                                               \
            rb[j] = *(const float4*)bsrc((kt) * 64 + (i_ >> 5), (i_ & 31) * 4);                                          \
        }                                                                                                               \
    }
    GEMM_LOAD(0);
    for (int kt = 0; kt < nkt; ++kt) {
        __syncthreads();
#pragma unroll
        for (int j = 0; j < 4; ++j) { const int i_ = tid + 256 * j; *(h8_t*)(sA + (i_ & 7) * GA_CS + (i_ >> 3) * 16) = ra[j]; }
#pragma unroll
        for (int j = 0; j < 8; ++j) {
            const int i_ = tid + 256 * j;
            h4_t hv; hv.x = (half_t)rb[j].x; hv.y = (half_t)rb[j].y; hv.z = (half_t)rb[j].z; hv.w = (half_t)rb[j].w;
            *(h4_t*)(sB + (i_ >> 5) * GB_RS + (i_ & 31) * 8) = hv;
        }
        __syncthreads();
        if (kt + 1 < nkt) GEMM_LOAD(kt + 1);
#pragma unroll
        for (int ks = 0; ks < 4; ++ks) {
            h8_t af[2], bf[2];
#pragma unroll
            for (int i = 0; i < 2; ++i) af[i] = *(const h8_t*)(sA + (2 * ks + (lane >> 5)) * GA_CS + (wm * 64 + i * 32 + (lane & 31)) * 16);
#pragma unroll
            for (int j = 0; j < 2; ++j) {
                const int row0 = 16 * ks + 8 * (lane >> 5) + ((lane & 15) >> 2);
                const int col = wn * 64 + j * 32 + 16 * ((lane >> 4) & 1) + 4 * (lane & 3);
                const s16x4_t lo = __builtin_amdgcn_ds_read_tr16_b64_v4i16((LAS s16x4_t*)(sB + row0 * GB_RS + col * 2));
                const s16x4_t hi = __builtin_amdgcn_ds_read_tr16_b64_v4i16((LAS s16x4_t*)(sB + (row0 + 4) * GB_RS + col * 2));
                s16x8_t b8; b8[0] = lo[0]; b8[1] = lo[1]; b8[2] = lo[2]; b8[3] = lo[3]; b8[4] = hi[0]; b8[5] = hi[1]; b8[6] = hi[2]; b8[7] = hi[3];
                bf[j] = __builtin_bit_cast(h8_t, b8);
            }
#pragma unroll
            for (int i = 0; i < 2; ++i)
#pragma unroll
                for (int j = 0; j < 2; ++j) acc[i][j] = __builtin_amdgcn_mfma_f32_32x32x16_f16(af[i], bf[j], acc[i][j], 0, 0, 0);
        }
    }
#undef GEMM_LOAD
#pragma unroll
    for (int i = 0; i < 2; ++i)
#pragma unroll
        for (int r = 0; r < 16; ++r) {
            const int lr = wm * 64 + i * 32 + (r & 3) + 8 * (r >> 2) + 4 * (lane >> 5);
            if (DUAL) epi(lr, wn * 32 + (lane & 31), acc[i][0][r], acc[i][1][r]);
            else { epi(lr, wn * 64 + (lane & 31), acc[i][0][r], 0.f); epi(lr, wn * 64 + 32 + (lane & 31), acc[i][1][r], 0.f); }
        }
    __syncthreads();
}

template <int MODE>
__device__ __forceinline__ void phase_gemm_dense(const Params& p, int tid, int layer, const half_t* A, const float* W, int N, int bid, int nb, unsigned char* smem) {
    constexpr int TS = USE_MFMA_GEMM ? 128 : 64;
    const int ntn = N / TS, ntiles = (M / TS) * ntn;
    float* P32 = wsp<float>(p, WS_BIG);
    float* XS = wsp<float>(p, WS_XS);
    for (int tile = bid; tile < ntiles; tile += nb) {
        const int tm = tile / ntn, tn = tile % ntn;
        const int m0 = tm * TS, n0 = tn * TS;
        auto rowsrc = [=](int i) -> long { return m0 + i; };
        auto bsrc = [=](int k, int c) -> const float* { return W + (size_t)k * N + n0 + c; };
        auto epi0 = [=](int i, int j, float v, float) { P32[(size_t)(m0 + i) * N + n0 + j] = v; };
        auto epi1 = [=](int i, int j, float v, float) {
            const int r = m0 + i, c = n0 + j;
            const float g = mods_ptr(p, layer, mods_row(r), 2)[c];
            XS[(size_t)r * 1024 + c] += g * v;
        };
#if USE_MFMA_GEMM
        if (MODE == 0) gemm_tile_mfma<false>(A, 1024, rowsrc, bsrc, 1024, epi0, smem, tid);
        else gemm_tile_mfma<false>(A, 1024, rowsrc, bsrc, 1024, epi1, smem, tid);
#else
        if (MODE == 0) gemm_tile_simple<false>(A, 1024, rowsrc, W + n0, nullptr, N, 1024, epi0, smem, tid);
        else gemm_tile_simple<false>(A, 1024, rowsrc, W + n0, nullptr, N, 1024, epi1, smem, tid);
#endif
    }
}

__device__ __forceinline__ float rope64(float v, int lane, int tpos) {
    const int axis = lane >> 5, half = (lane >> 4) & 1, f = lane & 15;
    const float pos = (float)(axis ? (tpos & 63) : (tpos >> 6));
    const float inv = powf(10000.0f, -(float)f / 16.0f);
    const float ang = pos * inv;
    const float cs = cosf(ang), sn = sinf(ang);
    const float other = __shfl_xor(v, 16, 64);
    return half == 0 ? (v * cs - other * sn) : (other * sn + v * cs);
}

__device__ __forceinline__ void phase_prep_even(const Params& p, int tid, int layer, int bid, int nb, unsigned char* smem) {
    constexpr int TK = 4;
    const int e = layer >> 1;
    float* lin = (float*)smem;
    float* vbuf = lin + TK * 256;
    float* t1 = vbuf + TK * 512;
    const int t = tid, wid = t >> 6, lane = t & 63;
    const float* P32 = wsp<float>(p, WS_BIG);
    half_t* Q16 = wsp<half_t>(p, WS_Q16); half_t* K16 = wsp<half_t>(p, WS_K16); half_t* V16 = wsp<half_t>(p, WS_V16);
    float* SR = wsp<float>(p, WS_SR); float* SV = wsp<float>(p, WS_SV); float* SKK = wsp<float>(p, WS_SKK);
    float* SW = wsp<float>(p, WS_SW); float* SKA = wsp<float>(p, WS_SKA); float* SKD = wsp<float>(p, WS_SKD);
    float* G = wsp<float>(p, WS_G); float* VF = wsp<float>(p, WS_VF); float* BONUS = wsp<float>(p, WS_BONUS);
    const float* qgain = p.ev_q_gain + e * 64; const float* kgain = p.ev_k_gain + e * 64;
    const float* mup = p.ev_mu_prev + e * 1792; const float* mun = p.ev_mu_next + e * 1792;
    for (int item = bid; item < M / TK; item += nb) {
        const int r0 = item * TK;
        for (int task = wid; task < 12 * TK; task += 4) {
            const int tok = task / 12, u = task % 12, r = r0 + tok, s = r % SEQA;
            float v = P32[(size_t)r * EVEN_COLS + u * 64 + lane];
            if (u < 10) {
                const float ss = wave_sum(v * v);
                v = v * rsqrtf(ss * (1.f / 64.f) + 1e-6f) * (u < 8 ? qgain[lane] : kgain[lane]);
                if (s >= NCTX) v = rope64(v, lane, s - NCTX);
                if (u < 8) v *= QSCALE;
            }
            if (u < 8) Q16[(size_t)r * 512 + u * 64 + lane] = (half_t)v;
            else if (u < 10) K16[(size_t)r * 128 + (u - 8) * 64 + lane] = (half_t)v;
            else V16[(size_t)r * 128 + (u - 10) * 64 + lane] = (half_t)v;
        }
        float rv[TK][2], kv[TK][2], vv[TK][2];
#pragma unroll
        for (int tok = 0; tok < TK; ++tok) {
            const int r = r0 + tok, s = r % SEQA;
            const bool hp = (s != 0 && s != NCTX), hn = (s != NCTX - 1 && s != SEQA - 1);
            const float* row = P32 + (size_t)r * EVEN_COLS + 768;
            auto sh = [&](int c) -> float {
                const float u = row[c];
                const float pv = hp ? row[c - EVEN_COLS] : 0.f, nv = hn ? row[c + EVEN_COLS] : 0.f;
                return u + mup[c] * (pv - u) + mun[c] * (nv - u);
            };
            const float xl = sh(1536 + t);
            lin[tok * 256 + t] = (t < 64) ? tanhf(xl) : ((t < 128) ? xl : sigmoidf_(xl));
#pragma unroll
            for (int jj = 0; jj < 2; ++jj) {
                const int c = t + 256 * jj;
                rv[tok][jj] = sh(c); kv[tok][jj] = sh(512 + c); vv[tok][jj] = sh(1024 + c);
                vbuf[tok * 512 + c] = vv[tok][jj];
            }
        }
        __syncthreads();
        if (e > 0) {
            {
                const int tok = t >> 5, j = t & 31;
                if (tok < TK) {
                    const float* v1 = p.ev_v1 + (size_t)(e - 1) * 512 * 32 + j;
                    float a = 0.f;
                    for (int c = 0; c < 512; ++c) a += vbuf[tok * 512 + c] * v1[c * 32];
                    t1[tok * 32 + j] = a;
                }
            }
            __syncthreads();
#pragma unroll
            for (int jj = 0; jj < 2; ++jj) {
                const int c = t + 256 * jj;
                const float* v2 = p.ev_v2 + (size_t)(e - 1) * 32 * 512 + c;
                const float v0 = p.ev_v0[(e - 1) * 512 + c];
                float z[TK];
#pragma unroll
                for (int tok = 0; tok < TK; ++tok) z[tok] = v0;
                #pragma unroll 1
                for (int j = 0; j < 32; ++j) { const float w = v2[j * 512];
#pragma unroll
                    for (int tok = 0; tok < TK; ++tok) z[tok] += t1[tok * 32 + j] * w; }
#pragma unroll
                for (int tok = 0; tok < TK; ++tok) { const float vf = VF[(size_t)(r0 + tok) * 512 + c]; vv[tok][jj] = vv[tok][jj] + (vf - vv[tok][jj]) * sigmoidf_(z[tok]); }
            }
        } else {
#pragma unroll
            for (int tok = 0; tok < TK; ++tok)
#pragma unroll
                for (int jj = 0; jj < 2; ++jj) VF[(size_t)(r0 + tok) * 512 + t + 256 * jj] = vv[tok][jj];
        }
        float kk[TK][2];
#pragma unroll
        for (int jj = 0; jj < 2; ++jj) {
            const int c = t + 256 * jj;
            const float kkc = p.ev_k_k[e * 512 + c];
            const float* g2 = p.ev_g2 + (size_t)e * 128 * 512 + c;
            float ag[TK];
#pragma unroll
            for (int tok = 0; tok < TK; ++tok) ag[tok] = 0.f;
            #pragma unroll 1
            for (int k = 0; k < 128; ++k) { const float w = g2[k * 512];
#pragma unroll
                for (int tok = 0; tok < TK; ++tok) ag[tok] += lin[tok * 256 + 128 + k] * w; }
#pragma unroll
            for (int tok = 0; tok < TK; ++tok) {
                const size_t o = (size_t)(r0 + tok) * 512 + c;
                const float kr = kv[tok][jj] * kkc;
                const float n2 = wave_sum(kr * kr);
                kk[tok][jj] = kr / fmaxf(sqrtf(n2), 1e-12f);
                SR[o] = rv[tok][jj]; SV[o] = vv[tok][jj]; SKK[o] = kk[tok][jj]; G[o] = ag[tok];
            }
        }
        float bon[TK][2];
#pragma unroll
        for (int tok = 0; tok < TK; ++tok) { bon[tok][0] = 0.f; bon[tok][1] = 0.f; }
        for (int dr = 0; dr < 2; ++dr) {
#pragma unroll
            for (int jj = 0; jj < 2; ++jj) {
                const int c = t + 256 * jj;
                const float* w2 = p.ev_w2 + ((size_t)(e * 2 + dr) * 64) * 512 + c;
                const float* a2 = p.ev_a2 + ((size_t)(e * 2 + dr) * 64) * 512 + c;
                const float w0 = p.ev_w0[(e * 2 + dr) * 512 + c], a0 = p.ev_a0[(e * 2 + dr) * 512 + c];
                const float kac = p.ev_k_a[e * 512 + c], rkc = p.ev_r_k[e * 512 + c];
                float aw[TK], aa[TK];
#pragma unroll
                for (int tok = 0; tok < TK; ++tok) { aw[tok] = w0; aa[tok] = a0; }
                #pragma unroll 1
                for (int k = 0; k < 64; ++k) { const float ww = w2[k * 512], wa = a2[k * 512];
#pragma unroll
                    for (int tok = 0; tok < TK; ++tok) { aw[tok] += lin[tok * 256 + k] * ww; aa[tok] += lin[tok * 256 + 64 + k] * wa; } }
#pragma unroll
                for (int tok = 0; tok < TK; ++tok) {
                    const size_t o = (size_t)dr * M * 512 + (size_t)(r0 + tok) * 512 + c;
                    const float w = expf(-DECAY_SCALE * sigmoidf_(aw[tok]));
                    const float a = sigmoidf_(aa[tok]);
                    const float kd = kv[tok][jj] * (1.f + (a - 1.f) * kac);
                    SW[o] = w; SKA[o] = kk[tok][jj] * a; SKD[o] = kd;
                    bon[tok][jj] += rv[tok][jj] * kd * rkc;
                }
            }
        }
#pragma unroll
        for (int tok = 0; tok < TK; ++tok)
#pragma unroll
            for (int jj = 0; jj < 2; ++jj) { const float b = wave_sum(bon[tok][jj]); if (lane == 0) BONUS[(size_t)(r0 + tok) * 8 + wid + 4 * jj] = b; }
        __syncthreads();
    }
}

__device__ __forceinline__ void phase_prep_odd(const Params& p, int tid, int bid, int nb) {
    const int wid = tid >> 6, lane = tid & 63;
    const float* P32 = wsp<float>(p, WS_BIG);
    half_t* Q16 = wsp<half_t>(p, WS_Q16); half_t* K16 = wsp<half_t>(p, WS_K16); half_t* V16 = wsp<half_t>(p, WS_V16);
    for (int task = bid * 4 + wid; task < M * 48; task += nb * 4) {
        const int r = task / 48, u = task % 48, s = r % SEQA;
        float v = P32[(size_t)r * ODD_COLS + u * 64 + lane];
        if (u < 32 && s >= NCTX) v = rope64(v, lane, s - NCTX);
        if (u < 16) Q16[(size_t)r * 1024 + u * 64 + lane] = (half_t)(v * QSCALE);
        else if (u < 32) K16[(size_t)r * 1024 + (u - 16) * 64 + lane] = (half_t)v;
        else V16[(size_t)r * 1024 + (u - 32) * 64 + lane] = (half_t)v;
    }
}

template <int MODE>
__device__ __forceinline__ void phase_attn_simple(const Params& p, int tid, int bid, int nb) {
    const int nitems = (MODE == 0) ? 72 * 8 : 72 * 32;
    const half_t* Q16 = wsp<half_t>(p, WS_Q16); const half_t* K16 = wsp<half_t>(p, WS_K16); const half_t* V16 = wsp<half_t>(p, WS_V16);
    for (int item = bid; item < nitems; item += nb) {
        int rbk, h, comp = 0, half = 0;
        if (MODE == 0) { rbk = item >> 3; h = item & 7; } else { rbk = item >> 5; const int rest = item & 31; h = rest >> 2; comp = (rest >> 1) & 1; half = rest & 1; }
        const int r = rbk * 256 + tid, b = r / SEQA, s = r - b * SEQA;
        const bool isctx = (rbk % 9) == 0;
        const int nkeys = isctx ? NCTX : SEQA;
        const size_t kbase = (size_t)b * SEQA;
        const int qstride = MODE == 0 ? 512 : 1024, qoff = MODE == 0 ? h * 64 : h * 128 + comp * 64;
        const int kstride = MODE == 0 ? 128 : 1024, koff = MODE == 0 ? (h >> 2) * 64 : h * 128 + comp * 64;
        const int voff = MODE == 0 ? (h >> 2) * 64 : h * 128 + half * 64;
        (void)s;
        float q[64], o[64];
#pragma unroll
        for (int d = 0; d < 64; ++d) { q[d] = (float)Q16[(size_t)r * qstride + qoff + d]; o[d] = 0.f; }
        float m = -INFINITY, l = 0.f;
        for (int k0 = 0; k0 < nkeys; k0 += 4) {
            float sc[4];
#pragma unroll
            for (int j = 0; j < 4; ++j) {
                const half_t* kp = K16 + (kbase + k0 + j) * kstride + koff;
                float a = 0.f;
#pragma unroll
                for (int d = 0; d < 64; ++d) a += q[d] * (float)kp[d];
                sc[j] = a;
            }
            const float tm = fmaxf(fmaxf(sc[0], sc[1]), fmaxf(sc[2], sc[3]));
            const float mn = fmaxf(m, tm);
            const float alpha = exp2f(m - mn);
            l *= alpha;
#pragma unroll
            for (int d = 0; d < 64; ++d) o[d] *= alpha;
#pragma unroll
            for (int j = 0; j < 4; ++j) {
                const float pj = exp2f(sc[j] - mn);
                l += pj;
                const half_t* vp = V16 + (kbase + k0 + j) * kstride + voff;
#pragma unroll
                for (int d = 0; d < 64; ++d) o[d] += pj * (float)vp[d];
            }
            m = mn;
        }
        const float inv = 1.f / l;
        if (MODE == 0) {
            half_t* dst = wsp<half_t>(p, WS_MIX16) + (size_t)r * 1024 + h * 64;
#pragma unroll
            for (int d = 0; d < 64; ++d) dst[d] = (half_t)(o[d] * inv);
        } else {
            float* dst = wsp<float>(p, WS_ATT32) + (((size_t)r * 8 + h) * 2 + comp) * 128 + half * 64;
#pragma unroll
            for (int d = 0; d < 64; ++d) dst[d] = o[d] * inv;
        }
    }
}

template <int MODE>
__device__ __forceinline__ void phase_attn_mfma(const Params& p, int tid, int bid, int nb, unsigned char* smem) {
    constexpr int DV = MODE == 0 ? 64 : 128, NDT = DV / 32, VRS = MODE == 0 ? 192 : 320, KCS = 1040, VCH = DV / 8, NVJ = VCH * 64 / 256;
    unsigned char* sK = smem;
    unsigned char* sV = smem + 8 * KCS;
    const int lane = tid & 63, wid = tid >> 6, h5 = lane >> 5, l31 = lane & 31;
    constexpr int NH = MODE == 0 ? 8 : 16;
    constexpr int NLATU = 8 * NH * 16, NU = NLATU + 8 * NH * 2;
    const half_t* Q16 = wsp<half_t>(p, WS_Q16); const half_t* K16 = wsp<half_t>(p, WS_K16); const half_t* V16 = wsp<half_t>(p, WS_V16);
    constexpr int qstride = MODE == 0 ? 512 : 1024, kstride = MODE == 0 ? 128 : 1024;
    for (int u = bid; u < NU; u += nb) {
        int b, hh, qrow0, nkeys;
        if (u < NLATU) { b = u / (NH * 16); const int rem = u % (NH * 16); hh = rem >> 4; qrow0 = b * SEQA + NCTX + (rem & 15) * 128; nkeys = SEQA; }
        else { const int v = u - NLATU; b = v / (NH * 2); const int rem = v % (NH * 2); hh = rem >> 1; qrow0 = b * SEQA + (rem & 1) * 128; nkeys = NCTX; }
        const int qoff = MODE == 0 ? hh * 64 : (hh >> 1) * 128 + (hh & 1) * 64;
        const int koff = MODE == 0 ? (hh >> 2) * 64 : qoff;
        const int voff = MODE == 0 ? (hh >> 2) * 64 : (hh >> 1) * 128;
        const size_t kbase = (size_t)b * SEQA;
        h8_t qf[4];
        {
            const half_t* qp = Q16 + (size_t)(qrow0 + wid * 32 + l31) * qstride + qoff + 8 * h5;
#pragma unroll
            for (int ks = 0; ks < 4; ++ks) qf[ks] = *(const h8_t*)(qp + 16 * ks);
        }
        f32x16_t o[NDT];
#pragma unroll
        for (int dt = 0; dt < NDT; ++dt)
#pragma unroll
            for (int r = 0; r < 16; ++r) o[dt][r] = 0.f;
        float mrun = -INFINITY, lrun = 0.f;
        h8_t rk[2], rv[NVJ];
#define ATT_LOAD(kt)                                                                                                         \
        {                                                                                                                    \
            _Pragma("unroll") for (int j = 0; j < 2; ++j) { const int i_ = tid + 256 * j;                                     \
                rk[j] = *(const h8_t*)(K16 + (kbase + (kt) * 64 + (i_ >> 3)) * kstride + koff + (i_ & 7) * 8); }              \
            _Pragma("unroll") for (int j = 0; j < NVJ; ++j) { const int i_ = tid + 256 * j;                                   \
                rv[j] = *(const h8_t*)(V16 + (kbase + (kt) * 64 + (i_ / VCH)) * kstride + voff + (i_ % VCH) * 8); }           \
        }
        const int ntile = nkeys >> 6;
        ATT_LOAD(0);
        for (int kt = 0; kt < ntile; ++kt) {
            __syncthreads();
#pragma unroll
            for (int j = 0; j < 2; ++j) { const int i_ = tid + 256 * j; *(h8_t*)(sK + (i_ & 7) * KCS + (i_ >> 3) * 16) = rk[j]; }
#pragma unroll
            for (int j = 0; j < NVJ; ++j) { const int i_ = tid + 256 * j; *(h8_t*)(sV + (i_ / VCH) * VRS + (i_ % VCH) * 16) = rv[j]; }
            __syncthreads();
            if (kt + 1 < ntile) ATT_LOAD(kt + 1);
            f32x16_t sc[2];
#pragma unroll
            for (int kh = 0; kh < 2; ++kh)
#pragma unroll
                for (int r = 0; r < 16; ++r) sc[kh][r] = 0.f;
#pragma unroll
            for (int ks = 0; ks < 4; ++ks)
#pragma unroll
                for (int kh = 0; kh < 2; ++kh) {
                    const h8_t kf = *(const h8_t*)(sK + (2 * ks + h5) * KCS + (kh * 32 + l31) * 16);
                    sc[kh] = __builtin_amdgcn_mfma_f32_32x32x16_f16(kf, qf[ks], sc[kh], 0, 0, 0);
                }
            float tmax = sc[0][0];
#pragma unroll
            for (int r = 1; r < 16; ++r) tmax = fmaxf(tmax, sc[0][r]);
#pragma unroll
            for (int r = 0; r < 16; ++r) tmax = fmaxf(tmax, sc[1][r]);
            tmax = fmaxf(tmax, __shfl_xor(tmax, 32, 64));
            const float mnew = fmaxf(mrun, tmax);
            const float alpha = __builtin_amdgcn_exp2f(mrun - mnew);
            mrun = mnew;
            float psum = 0.f;
#pragma unroll
            for (int kh = 0; kh < 2; ++kh)
#pragma unroll
                for (int r = 0; r < 16; ++r) { const float pv = __builtin_amdgcn_exp2f(sc[kh][r] - mnew); sc[kh][r] = pv; psum += pv; }
            lrun = lrun * alpha + psum;
#pragma unroll
            for (int dt = 0; dt < NDT; ++dt)
#pragma unroll
                for (int r = 0; r < 16; ++r) o[dt][r] *= alpha;
#pragma unroll
            for (int kh = 0; kh < 2; ++kh)
#pragma unroll
                for (int s2 = 0; s2 < 2; ++s2) {
                    h8_t pf;
#pragma unroll
                    for (int j = 0; j < 8; ++j) pf[j] = (half_t)sc[kh][8 * s2 + j];
                    const int row0 = kh * 32 + 16 * s2 + 4 * h5 + ((lane & 15) >> 2);
#pragma unroll
                    for (int dt = 0; dt < NDT; ++dt) {
                        const int col = dt * 32 + 16 * ((lane >> 4) & 1) + 4 * (lane & 3);
                        const s16x4_t lo = __builtin_amdgcn_ds_read_tr16_b64_v4i16((LAS s16x4_t*)(sV + row0 * VRS + col * 2));
                        const s16x4_t hi = __builtin_amdgcn_ds_read_tr16_b64_v4i16((LAS s16x4_t*)(sV + (row0 + 8) * VRS + col * 2));
                        s16x8_t v8; v8[0] = lo[0]; v8[1] = lo[1]; v8[2] = lo[2]; v8[3] = lo[3]; v8[4] = hi[0]; v8[5] = hi[1]; v8[6] = hi[2]; v8[7] = hi[3];
                        o[dt] = __builtin_amdgcn_mfma_f32_32x32x16_f16(__builtin_bit_cast(h8_t, v8), pf, o[dt], 0, 0, 0);
                    }
                }
        }
#undef ATT_LOAD
        const float ltot = lrun + __shfl_xor(lrun, 32, 64);
        const float inv = 1.f / ltot;
        const int qrow = qrow0 + wid * 32 + l31;
#pragma unroll
        for (int dt = 0; dt < NDT; ++dt)
#pragma unroll
            for (int rg = 0; rg < 4; ++rg) {
                const int d0 = dt * 32 + 8 * rg + 4 * h5;
                if (MODE == 0) {
                    h4_t ov; ov.x = (half_t)(o[dt][4 * rg + 0] * inv); ov.y = (half_t)(o[dt][4 * rg + 1] * inv); ov.z = (half_t)(o[dt][4 * rg + 2] * inv); ov.w = (half_t)(o[dt][4 * rg + 3] * inv);
                    *(h4_t*)(wsp<half_t>(p, WS_MIX16) + (size_t)qrow * 1024 + hh * 64 + d0) = ov;
                } else {
                    const float4 ov = make_float4(o[dt][4 * rg + 0] * inv, o[dt][4 * rg + 1] * inv, o[dt][4 * rg + 2] * inv, o[dt][4 * rg + 3] * inv);
                    *(float4*)(wsp<float>(p, WS_ATT32) + (((size_t)qrow * 8 + (hh >> 1)) * 2 + (hh & 1)) * 128 + d0) = ov;
                }
            }
    }
}

__device__ __forceinline__ void phase_diff_finish(const Params& p, int tid, int layer, int bid, int nb) {
    const int o = layer >> 1, wid = tid >> 6, lane = tid & 63;
    const float linit = 0.8f - 0.6f * expf(-0.3f * (float)layer);
    const float d1 = wave_sum(p.od_lq1[o * 64 + lane] * p.od_lk1[o * 64 + lane]);
    const float d2 = wave_sum(p.od_lq2[o * 64 + lane] * p.od_lk2[o * 64 + lane]);
    const float lam = expf(d1) - expf(d2) + linit;
    const float s0 = p.od_subln[o * 128 + lane], s1 = p.od_subln[o * 128 + 64 + lane];
    const float* ATT = wsp<float>(p, WS_ATT32);
    half_t* MIX = wsp<half_t>(p, WS_MIX16);
    for (int task = bid * 4 + wid; task < M * 8; task += nb * 4) {
        const int r = task >> 3, h = task & 7;
        const float* a = ATT + ((size_t)r * 8 + h) * 256;
        const float o0 = a[lane] - lam * a[128 + lane], o1 = a[64 + lane] - lam * a[192 + lane];
        const float ss = wave_sum(o0 * o0 + o1 * o1) * (1.f / 128.f);
        const float sc = rsqrtf(ss + 1e-5f) * (1.f - linit);
        MIX[(size_t)r * 1024 + h * 128 + lane] = (half_t)(o0 * sc * s0);
        MIX[(size_t)r * 1024 + h * 128 + 64 + lane] = (half_t)(o1 * sc * s1);
    }
}

__device__ __forceinline__ void phase_scan(const Params& p, int tid, int bid, int nb, unsigned char* smem) {
    constexpr int CH = 32;
    float* lds = (float*)smem;
    float* Lw = lds;
    float* Lv = lds + 5 * CH * 64;
    float* Ly = Lv + CH * 16;
    const int t = tid, wid = t >> 6, lane = t & 63, rloc = lane >> 4, kq = lane & 15;
    for (int item = bid; item < 512; item += nb) {
        const int chain = item >> 2, rq = item & 3, dir = chain & 1, bh = chain >> 1, b = bh >> 3, h = bh & 7;
        const size_t rowbase = (size_t)b * SEQA;
        const float* SCN = wsp<float>(p, WS_SR);
        const float* SV = wsp<float>(p, WS_SV);
        float* YS = wsp<float>(p, WS_YSC) + (size_t)dir * M * 512;
        auto tok_of = [=](int i) -> int { return dir == 0 ? i : (i < NCTX ? (NCTX - 1 - i) : (SEQA + NCTX - 1 - i)); };
        float4 pre0, pre1, pre2, pre3, pre4, pre5, pre6, pre7, pre8, pre9, prev;
        pre0 = pre1 = pre2 = pre3 = pre4 = pre5 = pre6 = pre7 = pre8 = pre9 = prev = make_float4(0, 0, 0, 0);
#define SCAN_LD1(cc, j, dst)                                                                                                       \
        {                                                                                                                          \
            const int idx = t + 256 * (j), st = idx / 80, rem = idx % 80, a = rem >> 4, f4 = rem & 15;                              \
            const size_t row = rowbase + tok_of((cc) * CH + st);                                                                   \
            const int plane = a < 3 ? 3 + 2 * a + dir : (a == 3 ? 2 : 0);                                                          \
            dst = *(const float4*)(SCN + ((size_t)plane * M + row) * 512 + h * 64 + f4 * 4);                                       \
        }
#define SCAN_ISSUE(cc)                                                                                                             \
        {                                                                                                                          \
            SCAN_LD1(cc, 0, pre0) SCAN_LD1(cc, 1, pre1) SCAN_LD1(cc, 2, pre2) SCAN_LD1(cc, 3, pre3) SCAN_LD1(cc, 4, pre4)           \
            SCAN_LD1(cc, 5, pre5) SCAN_LD1(cc, 6, pre6) SCAN_LD1(cc, 7, pre7) SCAN_LD1(cc, 8, pre8) SCAN_LD1(cc, 9, pre9)           \
            if (t < 128) { const int st = t >> 2, f4 = t & 3; const size_t row = rowbase + tok_of((cc) * CH + st);                  \
                prev = *(const float4*)(SV + row * 512 + h * 64 + rq * 16 + f4 * 4); }                                              \
        }
#define SCAN_ST1(j, srcv)                                                                                                          \
        {                                                                                                                          \
            const int idx = t + 256 * (j), st = idx / 80, rem = idx % 80, a = rem >> 4, f4 = rem & 15;                              \
            *(float4*)(Lw + a * CH * 64 + st * 64 + f4 * 4) = srcv;                                                                \
        }
#define SCAN_COMMIT()                                                                                                              \
        {                                                                                                                          \
            SCAN_ST1(0, pre0) SCAN_ST1(1, pre1) SCAN_ST1(2, pre2) SCAN_ST1(3, pre3) SCAN_ST1(4, pre4)                               \
            SCAN_ST1(5, pre5) SCAN_ST1(6, pre6) SCAN_ST1(7, pre7) SCAN_ST1(8, pre8) SCAN_ST1(9, pre9)                               \
            if (t < 128) { const int st = t >> 2, f4 = t & 3; *(float4*)(Lv + st * 16 + f4 * 4) = prev; }                          \
        }
        float S0 = 0.f, S1 = 0.f, S2 = 0.f, S3 = 0.f;
        SCAN_ISSUE(0);
        SCAN_COMMIT();
        __syncthreads();
        for (int c = 0; c < SEQA / CH; ++c) {
            if (c + 1 < SEQA / CH) SCAN_ISSUE(c + 1);
#pragma unroll 4
            for (int st = 0; st < CH; ++st) {
                const float4 w4 = *(const float4*)(Lw + 0 * CH * 64 + st * 64 + kq * 4);
                const float4 b4 = *(const float4*)(Lw + 1 * CH * 64 + st * 64 + kq * 4);
                const float4 d4 = *(const float4*)(Lw + 2 * CH * 64 + st * 64 + kq * 4);
                const float4 a4 = *(const float4*)(Lw + 3 * CH * 64 + st * 64 + kq * 4);
                const float4 r4 = *(const float4*)(Lw + 4 * CH * 64 + st * 64 + kq * 4);
                const float vr = Lv[st * 16 + wid * 4 + rloc];
                float pk = S0 * a4.x + S1 * a4.y + S2 * a4.z + S3 * a4.w;
                pk = sum16(pk);
                S0 = S0 * w4.x + (vr * d4.x - pk * b4.x);
                S1 = S1 * w4.y + (vr * d4.y - pk * b4.y);
                S2 = S2 * w4.z + (vr * d4.z - pk * b4.z);
                S3 = S3 * w4.w + (vr * d4.w - pk * b4.w);
                float y = S0 * r4.x + S1 * r4.y + S2 * r4.z + S3 * r4.w;
                y = sum16(y);
                if (kq == 0) Ly[st * 16 + wid * 4 + rloc] = y;
            }
            __syncthreads();
            if (t < 128) {
                const int st = t >> 2, f4 = t & 3; const size_t row = rowbase + tok_of(c * CH + st);
                *(float4*)(YS + row * 512 + h * 64 + rq * 16 + f4 * 4) = *(const float4*)(Ly + st * 16 + f4 * 4);
            }
            if (c + 1 < SEQA / CH) SCAN_COMMIT();
            __syncthreads();
        }
    }
}

__device__ __forceinline__ void phase_readout(const Params& p, int tid, int layer, int bid, int nb) {
    const int e = layer >> 1, wid = tid >> 6, lane = tid & 63;
    const float* Y0 = wsp<float>(p, WS_YSC); const float* Y1 = Y0 + (size_t)M * 512;
    const float* SV = wsp<float>(p, WS_SV); const float* G = wsp<float>(p, WS_G); const float* BONUS = wsp<float>(p, WS_BONUS);
    half_t* MIX = wsp<half_t>(p, WS_MIX16);
    for (int task = bid * 4 + wid; task < M * 8; task += nb * 4) {
        const int r = task >> 3, h = task & 7;
        const size_t o = (size_t)r * 512 + h * 64 + lane;
        const float y = Y0[o] + Y1[o];
        const float mu = wave_sum(y) * (1.f / 64.f);
        const float d = y - mu;
        const float var = wave_sum(d * d) * (1.f / 64.f);
        float yn = d * rsqrtf(var + GN_EPS) * p.ev_gn_w[e * 512 + h * 64 + lane] + p.ev_gn_b[e * 512 + h * 64 + lane];
        yn += BONUS[(size_t)r * 8 + h] * SV[o];
        MIX[(size_t)r * 1024 + 512 + h * 64 + lane] = (half_t)(yn * G[o]);
    }
}

__device__ __forceinline__ void phase_route(const Params& p, int tid, int layer, int bid, int nb, unsigned char* smem) {
    float* hbuf = (float*)smem;
    float* lg = hbuf + 8 * 1024;
    const int t = tid, wid = t >> 6, lane = t & 63;
    const bool last = (layer == DEPTH - 1);
    int* cnt = wsp<int>(p, WS_CNT) + layer * 32;
    int* list = wsp<int>(p, WS_LIST);
    float* GATE = wsp<float>(p, WS_GATE); int* ESLOT = wsp<int>(p, WS_ESLOT);
    for (int rg = bid; rg < M / 8; rg += nb) {
        const int r0 = rg * 8;
        if (last && (r0 % SEQA) < NCTX) continue;
#pragma unroll
        for (int q = 0; q < 2; ++q) {
            const int lr = wid * 2 + q, r = r0 + lr;
            const float4* xr = (const float4*)(wsp<float>(p, WS_XS) + (size_t)r * 1024);
            float4 v[4]; float ss = 0.f;
#pragma unroll
            for (int j = 0; j < 4; ++j) { v[j] = xr[lane + 64 * j]; ss += v[j].x * v[j].x + v[j].y * v[j].y + v[j].z * v[j].z + v[j].w * v[j].w; }
            ss = wave_sum(ss);
            norm_row_store(p, layer, r, 3, v, ss, lane, hbuf + lr * 1024);
        }
        __syncthreads();
        {
            const int lr = t >> 5, og = t & 31;
            const float* wrt = p.moe_w_rt + (size_t)layer * 1024 * 32 + og;
            const float* wgp = p.moe_w_grp + (size_t)layer * 1024 * 4 + (og & 3);
            float acc = 0.f, acc2 = 0.f;
            for (int d = 0; d < 1024; ++d) { const float hv = hbuf[lr * 1024 + d]; acc += hv * wrt[d * 32]; acc2 += hv * wgp[d * 4]; }
            lg[lr * 36 + 4 + og] = acc + p.moe_b_rt[layer * 32 + og];
            if (og < 4) lg[lr * 36 + og] = acc2 + p.moe_b_grp[layer * 4 + og];
        }
        __syncthreads();
        if (t < 8) {
            const int r = r0 + t;
            const float* L = lg + t * 36;
            int sel = 0; float mx = L[0];
            for (int g = 1; g < 4; ++g) if (L[g] > mx) { mx = L[g]; sel = g; }
            float z = 0.f;
            for (int g = 0; g < 4; ++g) z += expf(L[g] - mx);
            const float grp_w = 1.f / z;
            const float* E = L + 4 + sel * 8;
            int i1 = 0; float v1 = E[0];
            for (int j = 1; j < 8; ++j) if (E[j] > v1) { v1 = E[j]; i1 = j; }
            int i2 = -1; float v2 = -INFINITY;
            for (int j = 0; j < 8; ++j) if (j != i1 && E[j] > v2) { v2 = E[j]; i2 = j; }
            const float e2 = expf(v2 - v1);
            const float g1 = grp_w / (1.f + e2), g2 = grp_w * e2 / (1.f + e2);
            const int ea = sel * 8 + i1, eb = sel * 8 + i2;
            const int pa = atomicAdd(&cnt[ea], 1);
            const int pb = atomicAdd(&cnt[eb], 1);
            list[(size_t)ea * LISTCAP + pa] = r;
            list[(size_t)eb * LISTCAP + pb] = r;
            GATE[r * 2 + 0] = g1; GATE[r * 2 + 1] = g2;
            ESLOT[r * 2 + 0] = ea * 65536 + pa; ESLOT[r * 2 + 1] = eb * 65536 + pb;
        }
        __syncthreads();
    }
}

template <int TM>
__device__ __forceinline__ void moe_tables(const Params& p, int tid, int layer, int* tab  ) {
    if (tid == 0) {
        const int* cnt = wsp<int>(p, WS_CNT) + layer * 32;
        int ts = 0;
        for (int e = 0; e < 32; ++e) { const int c = cnt[e]; tab[e] = c; tab[32 + e] = ts; tab[65 + e] = ts * TM; ts += (c + TM - 1) / TM; }
        tab[64] = ts;
    }
    __syncthreads();
}
constexpr int MOE_TM = USE_MFMA_GEMM ? 128 : 64;
constexpr int MOE_TAB_OFF = 37120;
__device__ __forceinline__ void phase_moe1(const Params& p, int tid, int layer, int bid, int nb, unsigned char* smem) {
    constexpr int TM = MOE_TM;
    int* tab = (int*)(smem + MOE_TAB_OFF);
    moe_tables<TM>(p, tid, layer, tab);
    const int nrb = tab[64], nitems = nrb * 8;
    const half_t* H16 = wsp<half_t>(p, WS_H16);
    half_t* HM = wsp<half_t>(p, WS_HM16);
    const int* list = wsp<int>(p, WS_LIST);
    for (int item = bid; item < nitems; item += nb) {
        const int rb = item >> 3, nt = item & 7;
        int e = 0;
        while (e < 31 && tab[32 + e + 1] <= rb) ++e;
        const int lb = rb - tab[32 + e], cnt = tab[e], orow0 = tab[65 + e] + lb * TM;
        const int* le = list + (size_t)e * LISTCAP;
        auto rowsrc = [=](int i) -> long { const int pos = lb * TM + i; return pos < cnt ? (long)le[pos] : -1L; };
        const float* Wg = p.moe_w_gate + ((size_t)(layer * 32 + e)) * 1024 * 512 + nt * 64;
        const float* Wu = p.moe_w_up + ((size_t)(layer * 32 + e)) * 1024 * 512 + nt * 64;
        auto epi = [=](int i, int j, float g, float u) { HM[(size_t)(orow0 + i) * 512 + nt * 64 + j] = (half_t)(siluf_(g) * u); };
#if USE_MFMA_GEMM
        auto bsrc = [=](int k, int c) -> const float* { return (((c >> 5) & 1) ? Wu : Wg) + (size_t)k * 512 + (c >> 6) * 32 + (c & 31); };
        gemm_tile_mfma<true>(H16, 1024, rowsrc, bsrc, 1024, epi, smem, tid);
#else
        gemm_tile_simple<true>(H16, 1024, rowsrc, Wg, Wu, 512, 1024, epi, smem, tid);
#endif
    }
}
__device__ __forceinline__ void phase_moe2(const Params& p, int tid, int layer, int bid, int nb, unsigned char* smem) {
    constexpr int TM = MOE_TM, TN = USE_MFMA_GEMM ? 128 : 64, NTN = 1024 / TN;
    int* tab = (int*)(smem + MOE_TAB_OFF);
    moe_tables<TM>(p, tid, layer, tab);
    const int nrb = tab[64], nitems = nrb * NTN;
    const half_t* HM = wsp<half_t>(p, WS_HM16);
    float* YO = wsp<float>(p, WS_YOUT);
    for (int item = bid; item < nitems; item += nb) {
        const int rb = item / NTN, nt = item % NTN;
        int e = 0;
        while (e < 31 && tab[32 + e + 1] <= rb) ++e;
        const int lb = rb - tab[32 + e], orow0 = tab[65 + e] + lb * TM;
        auto rowsrc = [=](int i) -> long { return orow0 + i; };
        const float* Wd = p.moe_w_down + ((size_t)(layer * 32 + e)) * 512 * 1024 + nt * TN;
        auto epi = [=](int i, int j, float v, float) { YO[(size_t)(orow0 + i) * 1024 + nt * TN + j] = v; };
#if USE_MFMA_GEMM
        auto bsrc = [=](int k, int c) -> const float* { return Wd + (size_t)k * 1024 + c; };
        gemm_tile_mfma<false>(HM, 512, rowsrc, bsrc, 512, epi, smem, tid);
#else
        gemm_tile_simple<false>(HM, 512, rowsrc, Wd, nullptr, 1024, 512, epi, smem, tid);
#endif
    }
}

__device__ __forceinline__ void phase_combine(const Params& p, int tid, int layer, int bid, int nb, unsigned char* smem) {
    constexpr int TM = MOE_TM;
    int* tab = (int*)smem;
    moe_tables<TM>(p, tid, layer, tab);
    const int wid = tid >> 6, lane = tid & 63;
    const bool last = (layer == DEPTH - 1);
    const float* GATE = wsp<float>(p, WS_GATE); const int* ESLOT = wsp<int>(p, WS_ESLOT);
    const float* YO = wsp<float>(p, WS_YOUT);
    for (int r = bid * 4 + wid; r < M; r += nb * 4) {
        const int b = r / SEQA, s = r - b * SEQA;
        if (last && s < NCTX) continue;
        const int es0 = ESLOT[r * 2], es1 = ESLOT[r * 2 + 1];
        const float g0 = GATE[r * 2], g1 = GATE[r * 2 + 1];
        const size_t s0 = (size_t)(tab[65 + (es0 >> 16)] + (es0 & 65535)), s1 = (size_t)(tab[65 + (es1 >> 16)] + (es1 & 65535));
        float4* xr = (float4*)(wsp<float>(p, WS_XS) + (size_t)r * 1024);
        const float4* y0 = (const float4*)(YO + s0 * 1024); const float4* y1 = (const float4*)(YO + s1 * 1024);
        const float4* m5 = (const float4*)mods_ptr(p, layer, mods_row(r), 5);
        float4 v[4]; float ss = 0.f;
#pragma unroll
        for (int j = 0; j < 4; ++j) {
            const float4 x = xr[lane + 64 * j], a = y0[lane + 64 * j], c = y1[lane + 64 * j], g = m5[lane + 64 * j];
            float4 o;
            o.x = x.x + g.x * (g0 * a.x + g1 * c.x); o.y = x.y + g.y * (g0 * a.y + g1 * c.y);
            o.z = x.z + g.z * (g0 * a.z + g1 * c.z); o.w = x.w + g.w * (g0 * a.w + g1 * c.w);
            v[j] = o; ss += o.x * o.x + o.y * o.y + o.z * o.z + o.w * o.w;
        }
        ss = wave_sum(ss);
        if (!last) {
#pragma unroll
            for (int j = 0; j < 4; ++j) xr[lane + 64 * j] = v[j];
            norm_row_store(p, layer + 1, r, 0, v, ss, lane, nullptr);
        } else {
            const float rstd = rsqrtf(ss * (1.f / 1024.f) + 1e-6f);
            float4* dst = (float4*)(p.out + ((size_t)(b * NLAT + s - NCTX)) * 1024);
            const float4* fg = (const float4*)p.final_gain;
#pragma unroll
            for (int j = 0; j < 4; ++j) { const float4 g = fg[lane + 64 * j]; float4 o; o.x = v[j].x * rstd * g.x; o.y = v[j].y * rstd * g.y; o.z = v[j].z * rstd * g.z; o.w = v[j].w * rstd * g.w; dst[lane + 64 * j] = o; }
        }
    }
}


#define XB_TMO      128
#define XB_XCNT(j)  (256  + 64 * (j))
#define XB_XSUB(j)  (1280 + 64 * (j))
#define XB_XGEN(j)  (2304 + 64 * (j))
#define XB_TOP      3328
#define XB_TOPGEN   3392
#define XCD_BAR_WORDS 3456
#define XB_SPIN_CAP (1u << 22)

__device__ __forceinline__ unsigned xb_ld(unsigned* p)              { return __hip_atomic_load(p, __ATOMIC_RELAXED, __HIP_MEMORY_SCOPE_AGENT); }
__device__ __forceinline__ unsigned xb_add(unsigned* p, unsigned v) { return __hip_atomic_fetch_add(p, v, __ATOMIC_RELAXED, __HIP_MEMORY_SCOPE_AGENT); }
__device__ __forceinline__ unsigned xb_xcc_id() { return (unsigned)__builtin_amdgcn_s_getreg((3 << 11) | 20) & 0xFu; }
#define XB_SPIN(cond, bar) do { unsigned _sp = 0; while (cond) { __builtin_amdgcn_s_sleep(1); \
    if ((++_sp & 255u) == 0u) { if (xb_ld(&(bar)[XB_TMO])) break; if (_sp > XB_SPIN_CAP) { atomicAdd(&(bar)[XB_TMO], 1u); break; } } } } while (0)

struct XcdBarrier {
    unsigned* bar; unsigned x;
    volatile LAS unsigned* st;
};
__device__ __forceinline__ XcdBarrier xcd_barrier_post(unsigned* bar, volatile LAS unsigned* st) {
    XcdBarrier b; b.bar = bar; b.x = xb_xcc_id(); b.st = st;
    if (threadIdx.x == 0) (void)xb_add(&bar[XB_XCNT(b.x)], 1u);
    return b;
}
__device__ __forceinline__ void xcd_barrier_complete(unsigned* bar, unsigned x, unsigned& nloc, unsigned& nx) {
    const unsigned G = gridDim.x * gridDim.y * gridDim.z;
    unsigned sum, cnt, mine, sp = 0u;
    for (;;) {
        sum = 0u; cnt = 0u; mine = 0u;
#pragma unroll
        for (unsigned j = 0; j < 16; ++j) { const unsigned c = xb_ld(&bar[XB_XCNT(j)]); sum += c; cnt += (c > 0u) ? 1u : 0u; mine = (j == x) ? c : mine; }
        if (sum == G) break;
        __builtin_amdgcn_s_sleep(1);
        if ((++sp & 255u) == 0u) { if (xb_ld(&bar[XB_TMO])) break; if (sp > XB_SPIN_CAP) { atomicAdd(&bar[XB_TMO], 1u); break; } }
    }
    nloc = mine > 0u ? mine : 1u; nx = cnt > 0u ? cnt : 1u;
}
__device__ __forceinline__ void xcd_barrier(const XcdBarrier& b) {
    asm volatile("s_waitcnt vmcnt(0)" ::: "memory");
    __syncthreads();
    if (threadIdx.x == 0) {
        unsigned* bar = b.bar;
        __builtin_amdgcn_s_waitcnt(0);
        unsigned nloc = b.st[0], nx = b.st[1];
        if (nloc == 0u) { xcd_barrier_complete(bar, b.x, nloc, nx); b.st[0] = nloc; b.st[1] = nx; }
        const unsigned old = xb_add(&bar[XB_XSUB(b.x)], 1u);
        const unsigned gen = old / nloc;
        if (old + 1u == (gen + 1u) * nloc) {
            __builtin_amdgcn_fence(__ATOMIC_RELEASE, "agent");
            asm volatile("s_waitcnt vmcnt(0)" ::: "memory");
            const unsigned og = xb_add(&bar[XB_TOP], 1u);
            const unsigned tg = og / nx;
            if (og + 1u == (tg + 1u) * nx) xb_add(&bar[XB_TOPGEN], 1u);
            else XB_SPIN(xb_ld(&bar[XB_TOPGEN]) == tg, bar);
            __builtin_amdgcn_fence(__ATOMIC_ACQUIRE, "agent");
            xb_add(&bar[XB_XGEN(b.x)], 1u);
            asm volatile("s_waitcnt vmcnt(0)" ::: "memory");
        } else {
            XB_SPIN(xb_ld(&bar[XB_XGEN(b.x)]) == gen, bar);
            __builtin_amdgcn_fence(__ATOMIC_ACQUIRE, "agent");
            asm volatile("s_waitcnt vmcnt(0)" ::: "memory");
        }
    }
    __syncthreads();
}

enum { PH_MODS = 0, PH_COPY, PH_NORM1, PH_GEMM_IN, PH_PREP, PH_ATTN, PH_SCAN, PH_POST, PH_GEMM_OUT, PH_ROUTE, PH_MOE1, PH_MOE2, PH_COMBINE };

template <int PH>
__device__ __forceinline__ void run_phase(const Params& p, int tid, int layer, int bid, int nb, unsigned char* smem) {
    const bool even = (layer & 1) == 0;
    const int e = layer >> 1;
    if (PH == PH_MODS) phase_mods(p, tid, bid, nb, smem);
    else if (PH == PH_COPY) phase_copy(p, tid, bid, nb);
    else if (PH == PH_NORM1) phase_norm1(p, tid, layer, bid, nb);
    else if (PH == PH_GEMM_IN) {
        if (even) phase_gemm_dense<0>(p, tid, layer, wsp<half_t>(p, WS_H16), p.ev_w_in + (size_t)e * 1024 * EVEN_COLS, EVEN_COLS, bid, nb, smem);
        else phase_gemm_dense<0>(p, tid, layer, wsp<half_t>(p, WS_H16), p.od_w_in + (size_t)e * 1024 * ODD_COLS, ODD_COLS, bid, nb, smem);
    } else if (PH == PH_PREP) { if (even) phase_prep_even(p, tid, layer, bid, nb, smem); else phase_prep_odd(p, tid, bid, nb); }
    else if (PH == PH_ATTN) {
#if USE_MFMA_ATTN
        if (even) phase_attn_mfma<0>(p, tid, bid, nb, smem); else phase_attn_mfma<1>(p, tid, bid, nb, smem);
#else
        if (even) phase_attn_simple<0>(p, tid, bid, nb); else phase_attn_simple<1>(p, tid, bid, nb);
#endif
    }
    else if (PH == PH_SCAN) { if (even) phase_scan(p, tid, bid, nb, smem); }
    else if (PH == PH_POST) { if (even) phase_readout(p, tid, layer, bid, nb); else phase_diff_finish(p, tid, layer, bid, nb); }
    else if (PH == PH_GEMM_OUT) phase_gemm_dense<1>(p, tid, layer, wsp<half_t>(p, WS_MIX16), (even ? p.ev_w_out : p.od_w_out) + (size_t)e * 1024 * 1024, 1024, bid, nb, smem);
    else if (PH == PH_ROUTE) phase_route(p, tid, layer, bid, nb, smem);
    else if (PH == PH_MOE1) phase_moe1(p, tid, layer, bid, nb, smem);
    else if (PH == PH_MOE2) phase_moe2(p, tid, layer, bid, nb, smem);
    else if (PH == PH_COMBINE) phase_combine(p, tid, layer, bid, nb, smem);
}

template <int PH>
__global__ void __launch_bounds__(NT, 2) k_phase(Params p, int layer) {
    extern __shared__ __attribute__((aligned(16))) unsigned char smem[];
    run_phase<PH>(p, threadIdx.x, layer, blockIdx.x, gridDim.x, smem);
}

constexpr int NPTR = 42;
constexpr int MEGA_LDS = LDS_BYTES + 16 + NPTR * 8;
static_assert(sizeof(Params) == NPTR * 8, "Params must be 42 pointers");
__device__ __forceinline__ Params load_params(const unsigned char* tab) {
    const LAS unsigned* t = (const LAS unsigned*)tab;
    Params q;
    const void* v[NPTR];
#pragma unroll
    for (int i = 0; i < NPTR; ++i) {
        const unsigned lo = __builtin_amdgcn_readfirstlane(t[2 * i]), hi = __builtin_amdgcn_readfirstlane(t[2 * i + 1]);
        const unsigned long long u = ((unsigned long long)hi << 32) | lo;
        v[i] = (const void*)(const __attribute__((address_space(1))) void*)u;
    }
    __builtin_memcpy(&q, v, sizeof(Params));
    return q;
}
__device__ __forceinline__ unsigned* load_bar_ptr(const unsigned char* tab) {
    const LAS unsigned* t = (const LAS unsigned*)tab;
    const unsigned lo = __builtin_amdgcn_readfirstlane(t[2 * 41]), hi = __builtin_amdgcn_readfirstlane(t[2 * 41 + 1]);
    const unsigned long long u = (((unsigned long long)hi << 32) | lo) + WS_BAR;
    return (unsigned*)(__attribute__((address_space(1))) unsigned*)u;
}
#define GRID_BARRIER() { XcdBarrier b2_; b2_.bar = load_bar_ptr(smem + LDS_BYTES + 16); b2_.x = bar_x; b2_.st = (volatile LAS unsigned*)(smem + LDS_BYTES); xcd_barrier(b2_); }
#define RUN(PH, layer) { const Params q = load_params(smem + LDS_BYTES + 16); int tid_ = threadIdx.x; asm volatile("" : "+v"(tid_)); int bid_ = bid; asm volatile("" : "+s"(bid_)); run_phase<PH>(q, tid_, layer, bid_, nb, smem); }
__global__ void __launch_bounds__(NT, 2) k_mega(Params p) {
    extern __shared__ __attribute__((aligned(16))) unsigned char smem[];
    const int bid = blockIdx.x, nb = gridDim.x;
    if (threadIdx.x == 0) *(uint4*)(smem + LDS_BYTES) = make_uint4(0u, 0u, 0u, 0u);
    {
        unsigned long long v[NPTR];
        __builtin_memcpy(v, &p, sizeof(Params));
        unsigned long long* tab = (unsigned long long*)(smem + LDS_BYTES + 16);
        if (threadIdx.x == 0) {
#pragma unroll
            for (int i = 0; i < NPTR; ++i) tab[i] = v[i];
        }
    }
    unsigned* barw = (unsigned*)(p.ws + WS_BAR);
    __syncthreads();
    const unsigned bar_x = xcd_barrier_post(barw, (volatile LAS unsigned*)(smem + LDS_BYTES)).x;
    RUN(PH_MODS, 0);
    RUN(PH_COPY, 0);
    GRID_BARRIER();
    RUN(PH_NORM1, 0);
    GRID_BARRIER();
#pragma unroll 1
    for (int layer = 0; layer < DEPTH; ++layer) {
        RUN(PH_GEMM_IN, layer);
        GRID_BARRIER();
        RUN(PH_PREP, layer);
        GRID_BARRIER();
        RUN(PH_ATTN, layer);
        RUN(PH_SCAN, layer);
        GRID_BARRIER();
        RUN(PH_POST, layer);
        GRID_BARRIER();
        RUN(PH_GEMM_OUT, layer);
        GRID_BARRIER();
        RUN(PH_ROUTE, layer);
        GRID_BARRIER();
        RUN(PH_MOE1, layer);
        GRID_BARRIER();
        RUN(PH_MOE2, layer);
        GRID_BARRIER();
        RUN(PH_COMBINE, layer);
        if (layer + 1 < DEPTH) GRID_BARRIER();
    }
}

template <int PH>
static void launch_phase(const Params& p, int layer, int grid, hipStream_t stream) {
    static bool attr_set = false;
    if (!attr_set) { (void)hipFuncSetAttribute((const void*)k_phase<PH>, hipFuncAttributeMaxDynamicSharedMemorySize, LDS_BYTES); attr_set = true; }
    hipLaunchKernelGGL(k_phase<PH>, dim3(grid), dim3(NT), LDS_BYTES, stream, p, layer);
}

extern "C" void kernel_launch(void* const* d_in, const int* in_sizes, int n_in, void* d_out, int out_size, void* d_ws, size_t ws_size, hipStream_t stream) {
    if (n_in != 40 || ws_size < WS_END) { fprintf(stderr, "kernel_launch: unexpected inputs (n_in %d, ws %zu, need %zu)\n", n_in, ws_size, (size_t)WS_END); return; }
    Params p{};
    const float** pp = (const float**)&p;
    for (int i = 0; i < 40; ++i) pp[i] = (const float*)d_in[i];
    p.out = (float*)d_out; p.ws = (unsigned char*)d_ws;
    (void)hipMemsetAsync(d_ws, 0, WS_ZERO_BYTES, stream);
#if ONE_LAUNCH
    static int grid = 0;
    if (grid == 0) {
        int dev = 0, cus = 0, per_cu = 0;
        (void)hipGetDevice(&dev);
        (void)hipDeviceGetAttribute(&cus, hipDeviceAttributeMultiprocessorCount, dev);
        (void)hipFuncSetAttribute((const void*)k_mega, hipFuncAttributeMaxDynamicSharedMemorySize, MEGA_LDS);
        if (hipOccupancyMaxActiveBlocksPerMultiprocessor(&per_cu, (const void*)k_mega, NT, MEGA_LDS) != hipSuccess || per_cu < 1) per_cu = 1;
        (void)hipGetLastError();
        if (cus <= 0) cus = 256;
        grid = cus * (per_cu < 2 ? per_cu : 2);
    }
    hipLaunchKernelGGL(k_mega, dim3(grid), dim3(NT), MEGA_LDS, stream, p);
#else
    const int grid = 1024;
    launch_phase<PH_MODS>(p, 0, 512, stream);
    launch_phase<PH_COPY>(p, 0, grid, stream);
    launch_phase<PH_NORM1>(p, 0, grid, stream);
    for (int layer = 0; layer < DEPTH; ++layer) {
        launch_phase<PH_GEMM_IN>(p, layer, grid, stream);
        launch_phase<PH_PREP>(p, layer, grid, stream);
        launch_phase<PH_ATTN>(p, layer, grid, stream);
        if ((layer & 1) == 0) launch_phase<PH_SCAN>(p, layer, 512, stream);
        launch_phase<PH_POST>(p, layer, grid, stream);
        launch_phase<PH_GEMM_OUT>(p, layer, grid, stream);
        launch_phase<PH_ROUTE>(p, layer, grid, stream);
        launch_phase<PH_MOE1>(p, layer, grid, stream);
        launch_phase<PH_MOE2>(p, layer, grid, stream);
        launch_phase<PH_COMBINE>(p, layer, grid, stream);
    }
#endif
}
```

```cpp
#include <hip/hip_runtime.h>
#include <stdint.h>
#include <stdio.h>

#ifndef USE_MFMA_ATTN
#define USE_MFMA_ATTN 1
#endif
#ifndef USE_MFMA_GEMM
#define USE_MFMA_GEMM 1
#endif
#ifndef ONE_LAUNCH
#define ONE_LAUNCH 1
#endif

#define LAS __attribute__((address_space(3)))
typedef _Float16 half_t;
typedef _Float16 h4_t __attribute__((ext_vector_type(4)));
typedef _Float16 h8_t __attribute__((ext_vector_type(8)));

constexpr int D = 1024, NB = 8, NLAT = 2048, NCTX = 256, SEQA = NLAT + NCTX  , M = NB * SEQA  ;
constexpr int DEPTH = 4;
constexpr int EVEN_COLS = 2560, ODD_COLS = 3072;
constexpr int NEXP = 32, EH = 512;
constexpr int LISTCAP = 36864, MAXSLOT = 40960;
constexpr float DECAY_SCALE = 0.60653065971263342f;
constexpr float GN_EPS = 64e-5f;
constexpr float QSCALE = 0.125f * 1.4426950408889634f;
constexpr int NT = 256;
constexpr int LDS_BYTES = 65536;

constexpr size_t WS_BAR = 0;
constexpr size_t WS_CNT = 16384;
constexpr size_t WS_ZERO_BYTES = 32768;
constexpr size_t WS_MODS = 32768;
constexpr size_t WS_XS = 1u << 20;
constexpr size_t SZ_F32_1024 = (size_t)M * 1024 * 4;
constexpr size_t SZ_H16_1024 = (size_t)M * 1024 * 2;
constexpr size_t SZ_F32_512 = (size_t)M * 512 * 4;
constexpr size_t WS_H16 = WS_XS + SZ_F32_1024;
constexpr size_t WS_BIG = WS_H16 + SZ_H16_1024;
constexpr size_t SZ_BIG = (size_t)M * 3072 * 4;
constexpr size_t WS_Q16 = WS_BIG + SZ_BIG;
constexpr size_t WS_K16 = WS_Q16 + SZ_H16_1024;
constexpr size_t WS_V16 = WS_K16 + SZ_H16_1024;
constexpr size_t WS_MIX16 = WS_V16 + SZ_H16_1024;
constexpr size_t WS_SR = WS_MIX16 + SZ_H16_1024;
constexpr size_t WS_SV = WS_SR + SZ_F32_512;
constexpr size_t WS_SKK = WS_SV + SZ_F32_512;
constexpr size_t WS_SW = WS_SKK + SZ_F32_512;
constexpr size_t WS_SA = WS_SW + 2 * SZ_F32_512;
constexpr size_t WS_SK = WS_SA + 2 * SZ_F32_512;
constexpr size_t WS_G = WS_SK + 2 * SZ_F32_512;
constexpr size_t WS_VF = WS_G + SZ_F32_512;
constexpr size_t WS_BONUS = WS_VF + SZ_F32_512;
constexpr size_t WS_LIN16 = WS_BONUS + (size_t)2 * M * 8 * 4;
constexpr size_t WS_LIST = WS_LIN16 + (size_t)M * 256 * 2;
constexpr size_t WS_GATE = WS_LIST + (size_t)NEXP * LISTCAP * 4;
constexpr size_t WS_ESLOT = WS_GATE + (size_t)M * 2 * 4;
constexpr size_t WS_END = WS_ESLOT + (size_t)M * 2 * 4;
constexpr size_t WS_YSC = WS_BIG;
constexpr size_t WS_ATT32 = WS_BIG;
constexpr size_t WS_HM16 = WS_BIG;
constexpr size_t WS_YOUT = WS_BIG + (size_t)MAXSLOT * 512 * 2;
static_assert(WS_YOUT + (size_t)MAXSLOT * 1024 * 4 <= WS_BIG + SZ_BIG, "BIG region too small");
static_assert(WS_END < (size_t)1000 * 1000 * 1000, "workspace too large");

struct Params {
    const float *x, *c, *ctx, *c_ctx, *mod_w, *mod_b, *ev_w_in, *ev_w_out, *ev_q_gain, *ev_k_gain, *ev_mu_prev, *ev_mu_next, *ev_w0, *ev_w2,
        *ev_a0, *ev_a2, *ev_g2, *ev_k_k, *ev_k_a, *ev_r_k, *ev_gn_w, *ev_gn_b, *ev_v0, *ev_v1, *ev_v2, *od_w_in, *od_w_out, *od_lq1, *od_lk1,
        *od_lq2, *od_lk2, *od_subln, *moe_w_grp, *moe_b_grp, *moe_w_rt, *moe_b_rt, *moe_w_gate, *moe_w_up, *moe_w_down, *final_gain;
    float* out;
    unsigned char* ws;
};

template <int CTRL> __device__ __forceinline__ float dpp_mov(float v) {
    return __int_as_float(__builtin_amdgcn_update_dpp(0, __float_as_int(v), CTRL, 0xF, 0xF, true));
}
__device__ __forceinline__ float sum16(float v) {
    v += dpp_mov<0xB1>(v);
    v += dpp_mov<0x4E>(v);
    v += dpp_mov<0x141>(v);
    v += dpp_mov<0x140>(v);
    return v;
}
__device__ __forceinline__ float wave_sum(float v) {
    v = sum16(v);
    const float a = __int_as_float(__builtin_amdgcn_readlane(__float_as_int(v), 0)), b = __int_as_float(__builtin_amdgcn_readlane(__float_as_int(v), 16));
    const float c = __int_as_float(__builtin_amdgcn_readlane(__float_as_int(v), 32)), d = __int_as_float(__builtin_amdgcn_readlane(__float_as_int(v), 48));
    return (a + b) + (c + d);
}
__device__ __forceinline__ float sigmoidf_(float x) { return 1.f / (1.f + expf(-x)); }
__device__ __forceinline__ float siluf_(float x) { return x / (1.f + expf(-x)); }
__device__ __forceinline__ int mods_row(int r) { const int b = r / SEQA, s = r - b * SEQA; return s < NCTX ? 8 : b; }
__device__ __forceinline__ const float* mods_ptr(const Params& p, int layer, int mr, int chunk) {
    return (const float*)(p.ws + WS_MODS) + ((size_t)(layer * 9 + mr)) * 6144 + chunk * 1024;
}
template <class T> __device__ __forceinline__ T* wsp(const Params& p, size_t off) { return (T*)(p.ws + off); }

__device__ __forceinline__ void phase_mods(const Params& p, int tid, int bid, int nb, unsigned char* smem) {
    float* cond = (float*)smem;
    float* part = cond + 9 * 1024;
    const int t = tid;
    for (int i = t; i < 9 * 1024; i += NT) { const int r = i >> 10, d = i & 1023; const float v = (r < 8) ? p.c[r * 1024 + d] : p.c_ctx[d]; cond[i] = siluf_(v); }
    __syncthreads();
    float* mods = wsp<float>(p, WS_MODS);
    for (int item = bid; item < 512; item += nb) {
        const int layer = item >> 7, col0 = (item & 127) * 48;
        const int cq = t % 12, dg = t / 12;
        if (dg < 16) {
            float acc[9][4];
#pragma unroll
            for (int r = 0; r < 9; ++r)
#pragma unroll
                for (int j = 0; j < 4; ++j) acc[r][j] = 0.f;
            const float* W = p.mod_w + (size_t)layer * 1024 * 6144 + col0 + cq * 4;
            for (int i = 0; i < 64; ++i) {
                const int d = dg * 64 + i;
                const float4 w = *(const float4*)(W + (size_t)d * 6144);
#pragma unroll
                for (int r = 0; r < 9; ++r) { const float cv = cond[r * 1024 + d]; acc[r][0] += cv * w.x; acc[r][1] += cv * w.y; acc[r][2] += cv * w.z; acc[r][3] += cv * w.w; }
            }
#pragma unroll
            for (int r = 0; r < 9; ++r)
#pragma unroll
                for (int j = 0; j < 4; ++j) part[(dg * 9 + r) * 48 + cq * 4 + j] = acc[r][j];
        }
        __syncthreads();
        for (int o = t; o < 9 * 48; o += NT) {
            const int r = o / 48, cc = o % 48;
            float s = p.mod_b[layer * 6144 + col0 + cc];
            for (int g = 0; g < 16; ++g) s += part[(g * 9 + r) * 48 + cc];
            mods[((size_t)(layer * 9 + r)) * 6144 + col0 + cc] = s;
        }
        __syncthreads();
    }
}

__device__ __forceinline__ void phase_copy(const Params& p, int tid, int bid, int nb) {
    float4* XS = wsp<float4>(p, WS_XS);
    for (size_t i = (size_t)bid * NT + tid; i < (size_t)M * 256; i += (size_t)nb * NT) {
        const int r = (int)(i >> 8), c4 = (int)(i & 255);
        const int b = r / SEQA, s = r - b * SEQA;
        const float4* src = (s < NCTX) ? (const float4*)(p.ctx + ((size_t)(b * NCTX + s)) * 1024) : (const float4*)(p.x + ((size_t)(b * NLAT + s - NCTX)) * 1024);
        XS[i] = src[c4];
    }
}

__device__ __forceinline__ void norm_row_store(const Params& p, int layer, int r, int chunk_shift, const float4 (&v)[4], float ss, int lane, float* hbuf  ) {
    const float rstd = rsqrtf(ss * (1.f / 1024.f) + 1e-6f);
    const int mr = mods_row(r);
    const float4* sh = (const float4*)mods_ptr(p, layer, mr, chunk_shift);
    const float4* sc = (const float4*)mods_ptr(p, layer, mr, chunk_shift + 1);
    half_t* H = wsp<half_t>(p, WS_H16) + (size_t)r * 1024;
#pragma unroll
    for (int j = 0; j < 4; ++j) {
        const float4 a = sh[lane + 64 * j], b = sc[lane + 64 * j];
        float4 h;
        h.x = v[j].x * rstd * (1.f + b.x) + a.x; h.y = v[j].y * rstd * (1.f + b.y) + a.y;
        h.z = v[j].z * rstd * (1.f + b.z) + a.z; h.w = v[j].w * rstd * (1.f + b.w) + a.w;
        h4_t hh; hh.x = (half_t)h.x; hh.y = (half_t)h.y; hh.z = (half_t)h.z; hh.w = (half_t)h.w;
        *(h4_t*)(H + (lane + 64 * j) * 4) = hh;
        if (hbuf) *(float4*)(hbuf + (lane + 64 * j) * 4) = h;
    }
}
__device__ __forceinline__ void phase_norm1(const Params& p, int tid, int layer, int bid, int nb) {
    const int wid = tid >> 6, lane = tid & 63;
    for (int r = bid * 4 + wid; r < M; r += nb * 4) {
        const float4* xr = (const float4*)(wsp<float>(p, WS_XS) + (size_t)r * 1024);
        float4 v[4]; float ss = 0.f;
#pragma unroll
        for (int j = 0; j < 4; ++j) { v[j] = xr[lane + 64 * j]; ss += v[j].x * v[j].x + v[j].y * v[j].y + v[j].z * v[j].z + v[j].w * v[j].w; }
        ss = wave_sum(ss);
        norm_row_store(p, layer, r, 0, v, ss, lane, nullptr);
    }
}

typedef float f32x16_t __attribute__((ext_vector_type(16)));
typedef short s16x4_t __attribute__((__vector_size__(8)));
typedef short s16x8_t __attribute__((ext_vector_type(8)));
constexpr int GA_CS = 2064, GB_RS = 320, G_SA_BYTES = 8 * GA_CS, G_SB_BYTES = 64 * GB_RS, G_LDS_BYTES = G_SA_BYTES + G_SB_BYTES;
template <bool DUAL, class RowSrc, class BSrc, class Epi>
__device__ __forceinline__ void gemm_tile_mfma(const half_t* __restrict__ A, int lda, RowSrc rowsrc, BSrc bsrc, int K, Epi epi, unsigned char* smem, int tid) {
    unsigned char* sA = smem;
    unsigned char* sB = smem + G_SA_BYTES;
    const int lane = tid & 63, wid = tid >> 6, wm = wid >> 1, wn = wid & 1;
    long rs[4];
#pragma unroll
    for (int j = 0; j < 4; ++j) rs[j] = rowsrc((tid + 256 * j) >> 3);
    const int akc = tid & 7;
    h8_t ra[4]; float4 rb[8];
    f32x16_t acc[2][2];
#pragma unroll
    for (int i = 0; i < 2; ++i)
#pragma unroll
        for (int j = 0; j < 2; ++j)
#pragma unroll
            for (int r = 0; r < 16; ++r) acc[i][j][r] = 0.f;
    const int nkt = K >> 6;
#define GEMM_LOAD(kt)                                                                                                   \
    {                                                                                                                   \
        _Pragma("unroll") for (int j = 0; j < 4; ++j) {                                                                 \
            h8_t z = {0, 0, 0, 0, 0, 0, 0, 0};                                                                          \
            ra[j] = rs[j] >= 0 ? *(const h8_t*)(A + (size_t)rs[j] * lda + (kt) * 64 + akc * 8) : z;                      \
        }                                                                                                               \
        _Pragma("unroll") for (int j = 0; j < 8; ++j) {                                                                 \
            const int i_ = tid + 256 * j;                                                                               \
            rb[j] = *(const float4*)bsrc((kt) * 64 + (i_ >> 5), (i_ & 31) * 4);                                          \
        }                                                                                                               \
    }
    GEMM_LOAD(0);
    for (int kt = 0; kt < nkt; ++kt) {
        __syncthreads();
#pragma unroll
        for (int j = 0; j < 4; ++j) { const int i_ = tid + 256 * j; *(h8_t*)(sA + (i_ & 7) * GA_CS + (i_ >> 3) * 16) = ra[j]; }
#pragma unroll
        for (int j = 0; j < 8; ++j) {
            const int i_ = tid + 256 * j;
            h4_t hv; hv.x = (half_t)rb[j].x; hv.y = (half_t)rb[j].y; hv.z = (half_t)rb[j].z; hv.w = (half_t)rb[j].w;
            *(h4_t*)(sB + (i_ >> 5) * GB_RS + (i_ & 31) * 8) = hv;
        }
        __syncthreads();
        if (kt + 1 < nkt) GEMM_LOAD(kt + 1);
#pragma unroll
        for (int ks = 0; ks < 4; ++ks) {
            h8_t af[2], bf[2];
#pragma unroll
            for (int i = 0; i < 2; ++i) af[i] = *(const h8_t*)(sA + (2 * ks + (lane >> 5)) * GA_CS + (wm * 64 + i * 32 + (lane & 31)) * 16);
#pragma unroll
            for (int j = 0; j < 2; ++j) {
                const int row0 = 16 * ks + 8 * (lane >> 5) + ((lane & 15) >> 2);
                const int col = wn * 64 + j * 32 + 16 * ((lane >> 4) & 1) + 4 * (lane & 3);
                const s16x4_t lo = __builtin_amdgcn_ds_read_tr16_b64_v4i16((LAS s16x4_t*)(sB + row0 * GB_RS + col * 2));
                const s16x4_t hi = __builtin_amdgcn_ds_read_tr16_b64_v4i16((LAS s16x4_t*)(sB + (row0 + 4) * GB_RS + col * 2));
                s16x8_t b8; b8[0] = lo[0]; b8[1] = lo[1]; b8[2] = lo[2]; b8[3] = lo[3]; b8[4] = hi[0]; b8[5] = hi[1]; b8[6] = hi[2]; b8[7] = hi[3];
                bf[j] = __builtin_bit_cast(h8_t, b8);
            }
#pragma unroll
            for (int i = 0; i < 2; ++i)
#pragma unroll
                for (int j = 0; j < 2; ++j) acc[i][j] = __builtin_amdgcn_mfma_f32_32x32x16_f16(af[i], bf[j], acc[i][j], 0, 0, 0);
        }
    }
#undef GEMM_LOAD
#pragma unroll
    for (int i = 0; i < 2; ++i)
#pragma unroll
        for (int r = 0; r < 16; ++r) {
            const int lr = wm * 64 + i * 32 + (r & 3) + 8 * (r >> 2) + 4 * (lane >> 5);
            epi(lr, (DUAL ? wn * 32 : wn * 64) + (lane & 31), acc[i][0][r], acc[i][1][r]);
        }
    __syncthreads();
}

template <int MODE>
__device__ __forceinline__ void phase_gemm_dense(const Params& p, int tid, int layer, const half_t* A, const float* W, int N, int bid, int nb, unsigned char* smem) {
    const int ntn = N / 128, ntiles = (M / 128) * ntn;
    float* P32 = wsp<float>(p, WS_BIG);
    float* XS = wsp<float>(p, WS_XS);
    for (int tile = bid; tile < ntiles; tile += nb) {
        const int tm = tile / ntn, tn = tile % ntn;
        const int m0 = tm * 128, n0 = tn * 128;
        auto rowsrc = [=](int i) -> long { return m0 + i; };
        auto bsrc = [=](int k, int c) -> const float* { return W + (size_t)k * N + n0 + c; };
        if (MODE == 0) {
            auto epi = [=](int i, int j, float v0, float v1) { float* d = P32 + (size_t)(m0 + i) * N + n0 + j; d[0] = v0; d[32] = v1; };
            gemm_tile_mfma<false>(A, 1024, rowsrc, bsrc, 1024, epi, smem, tid);
        } else {
            auto epi = [=](int i, int j, float v0, float v1) {
                const int r = m0 + i, c = n0 + j;
                const float* g = mods_ptr(p, layer, mods_row(r), 2) + c;
                float* d = XS + (size_t)r * 1024 + c;
                d[0] += g[0] * v0; d[32] += g[32] * v1;
            };
            gemm_tile_mfma<false>(A, 1024, rowsrc, bsrc, 1024, epi, smem, tid);
        }
    }
}

__device__ __forceinline__ float rope64(float v, int lane, int tpos) {
    const int axis = lane >> 5, half = (lane >> 4) & 1, f = lane & 15;
    const float pos = (float)(axis ? (tpos & 63) : (tpos >> 6));
    const float inv = powf(10000.0f, -(float)f / 16.0f);
    const float ang = pos * inv;
    const float cs = cosf(ang), sn = sinf(ang);
    const float other = __shfl_xor(v, 16, 64);
    return half == 0 ? (v * cs - other * sn) : (other * sn + v * cs);
}

__device__ __forceinline__ void phase_prep_even(const Params& p, int tid, int layer, int bid, int nb, unsigned char* smem) {
    constexpr int TK = 16;
    const int e = layer >> 1;
    float* vbuf = (float*)smem;
    float* t1 = vbuf + TK * 512;
    const int t = tid, wid = t >> 6, lane = t & 63;
    const float* P32 = wsp<float>(p, WS_BIG);
    half_t* Q16 = wsp<half_t>(p, WS_Q16); half_t* K16 = wsp<half_t>(p, WS_K16); half_t* V16 = wsp<half_t>(p, WS_V16);
    float* SR = wsp<float>(p, WS_SR); float* SV = wsp<float>(p, WS_SV); float* SKK = wsp<float>(p, WS_SKK); float* SK = wsp<float>(p, WS_SK);
    float* VF = wsp<float>(p, WS_VF); half_t* LIN = wsp<half_t>(p, WS_LIN16);
    const float* qgain = p.ev_q_gain + e * 64; const float* kgain = p.ev_k_gain + e * 64;
    float mup[7], mun[7];
#pragma unroll
    for (int j = 0; j < 7; ++j) { mup[j] = p.ev_mu_prev[e * 1792 + t + 256 * j]; mun[j] = p.ev_mu_next[e * 1792 + t + 256 * j]; }
    const float kk0 = p.ev_k_k[e * 512 + t], kk1 = p.ev_k_k[e * 512 + 256 + t];
    for (int item = bid; item < M / TK; item += nb) {
        const int r0 = item * TK;
        for (int task = wid; task < 12 * TK; task += 4) {
            const int tok = task / 12, u = task % 12, r = r0 + tok, s = r % SEQA;
            float v = P32[(size_t)r * EVEN_COLS + u * 64 + lane];
            if (u < 10) {
                const float ss = wave_sum(v * v);
                v = v * rsqrtf(ss * (1.f / 64.f) + 1e-6f) * (u < 8 ? qgain[lane] : kgain[lane]);
                if (s >= NCTX) v = rope64(v, lane, s - NCTX);
                if (u < 8) v *= QSCALE;
            }
            if (u < 8) Q16[(size_t)r * 512 + u * 64 + lane] = (half_t)v;
            else if (u < 10) K16[(size_t)r * 128 + (u - 8) * 64 + lane] = (half_t)v;
            else V16[(size_t)r * 128 + (u - 10) * 64 + lane] = (half_t)v;
        }
        float prv[7], cur[7], nxt[7];
        {
            const int s0 = r0 % SEQA;
            const bool hp = (s0 != 0 && s0 != NCTX);
            const float* row = P32 + (size_t)r0 * EVEN_COLS + 768 + t;
#pragma unroll
            for (int j = 0; j < 7; ++j) { cur[j] = row[256 * j]; prv[j] = hp ? row[256 * j - EVEN_COLS] : 0.f; }
        }
#pragma unroll 1
        for (int tok = 0; tok < TK; ++tok) {
            const int r = r0 + tok, s = r % SEQA;
            const bool hn = (s != NCTX - 1 && s != SEQA - 1);
            const float* row = P32 + (size_t)r * EVEN_COLS + 768 + t;
#pragma unroll
            for (int j = 0; j < 7; ++j) nxt[j] = hn ? row[256 * j + EVEN_COLS] : 0.f;
            float u[7];
#pragma unroll
            for (int j = 0; j < 7; ++j) u[j] = cur[j] + mup[j] * (prv[j] - cur[j]) + mun[j] * (nxt[j] - cur[j]);
            const size_t o = (size_t)r * 512 + t;
            SR[o] = u[0]; SR[o + 256] = u[1];
            SK[o] = u[2]; SK[o + 256] = u[3];
            {
                const float k0 = u[2] * kk0, k1 = u[3] * kk1;
                const float n0 = wave_sum(k0 * k0), n1 = wave_sum(k1 * k1);
                SKK[o] = k0 / fmaxf(sqrtf(n0), 1e-12f); SKK[o + 256] = k1 / fmaxf(sqrtf(n1), 1e-12f);
            }
            if (e == 0) { SV[o] = u[4]; SV[o + 256] = u[5]; VF[o] = u[4]; VF[o + 256] = u[5]; }
            else { vbuf[tok * 512 + t] = u[4]; vbuf[tok * 512 + 256 + t] = u[5]; }
            const float xl = u[6];
            LIN[(size_t)r * 256 + t] = (half_t)((t < 64) ? tanhf(xl) : ((t < 128) ? xl : sigmoidf_(xl)));
#pragma unroll
            for (int j = 0; j < 7; ++j) { prv[j] = cur[j]; cur[j] = nxt[j]; }
        }
        if (e > 0) {
            __syncthreads();
            {
                const int tok = t >> 4, jp = (t & 15) * 2;
                const float* v1 = p.ev_v1 + (size_t)(e - 1) * 512 * 32 + jp;
                float a0 = 0.f, a1 = 0.f;
#pragma unroll 4
                for (int c = 0; c < 512; ++c) { const float2 w = *(const float2*)(v1 + c * 32); const float x = vbuf[tok * 512 + c]; a0 += x * w.x; a1 += x * w.y; }
                t1[tok * 32 + jp] = a0; t1[tok * 32 + jp + 1] = a1;
            }
            __syncthreads();
#pragma unroll
            for (int jj = 0; jj < 2; ++jj) {
                const int c = t + 256 * jj;
                const float* v2 = p.ev_v2 + (size_t)(e - 1) * 32 * 512 + c;
                const float v0 = p.ev_v0[(e - 1) * 512 + c];
                float z[TK];
#pragma unroll
                for (int tok = 0; tok < TK; ++tok) z[tok] = v0;
#pragma unroll 1
                for (int j = 0; j < 32; j += 4) {
                    const float w0 = v2[j * 512], w1 = v2[(j + 1) * 512], w2 = v2[(j + 2) * 512], w3 = v2[(j + 3) * 512];
#pragma unroll
                    for (int tok = 0; tok < TK; ++tok) { const float4 tt = *(const float4*)(t1 + tok * 32 + j); z[tok] += tt.x * w0 + tt.y * w1 + tt.z * w2 + tt.w * w3; }
                }
#pragma unroll
                for (int tok = 0; tok < TK; ++tok) {
                    const size_t o = (size_t)(r0 + tok) * 512 + c;
                    const float vv = vbuf[tok * 512 + c];
                    SV[o] = vv + (VF[o] - vv) * sigmoidf_(z[tok]);
                }
            }
            __syncthreads();
        }
    }
}

__device__ __forceinline__ void phase_lora(const Params& p, int tid, int layer, int bid, int nb, unsigned char* smem) {
    const int e = layer >> 1, lane = tid & 63;
    const half_t* LIN = wsp<half_t>(p, WS_LIN16);
    float* SW = wsp<float>(p, WS_SW); float* SA = wsp<float>(p, WS_SA); float* G = wsp<float>(p, WS_G); float* BONUS = wsp<float>(p, WS_BONUS);
    const float* SR = wsp<float>(p, WS_SR); const float* SK = wsp<float>(p, WS_SK);
    constexpr int NTILE = (M / 128) * 4;
    for (int item = bid; item < 5 * NTILE; item += nb) {
        const int job = item / NTILE, tile = item % NTILE, tm = tile >> 2, tn = tile & 3, m0 = tm * 128, n0 = tn * 128;
        auto rowsrc = [=](int i) -> long { return m0 + i; };
        if (job < 2) {
            const int dr = job;
            const float* W = p.ev_w2 + ((size_t)(e * 2 + dr) * 64) * 512 + n0;
            const float* w0 = p.ev_w0 + (e * 2 + dr) * 512 + n0;
            float* dst = SW + (size_t)dr * M * 512;
            auto bsrc = [=](int k, int c) -> const float* { return W + (size_t)k * 512 + c; };
            auto epi = [=](int i, int j, float v0, float v1) {
                float* d = dst + (size_t)(m0 + i) * 512 + n0 + j;
                d[0] = expf(-DECAY_SCALE * sigmoidf_(w0[j] + v0)); d[32] = expf(-DECAY_SCALE * sigmoidf_(w0[j + 32] + v1));
            };
            gemm_tile_mfma<false>(LIN, 256, rowsrc, bsrc, 64, epi, smem, tid);
        } else if (job < 4) {
            const int dr = job - 2;
            const float* W = p.ev_a2 + ((size_t)(e * 2 + dr) * 64) * 512 + n0;
            const float* a0 = p.ev_a0 + (e * 2 + dr) * 512 + n0;
            const float* ka = p.ev_k_a + e * 512 + n0; const float* rk = p.ev_r_k + e * 512 + n0;
            float* dst = SA + (size_t)dr * M * 512;
            float* bon = BONUS + (size_t)dr * M * 8;
            auto bsrc = [=](int k, int c) -> const float* { return W + (size_t)k * 512 + c; };
            auto epi = [=](int i, int j, float v0, float v1) {
                const size_t o = (size_t)(m0 + i) * 512 + n0 + j;
                const float a_0 = sigmoidf_(a0[j] + v0), a_1 = sigmoidf_(a0[j + 32] + v1);
                dst[o] = a_0; dst[o + 32] = a_1;
                float bsum = SR[o] * SK[o] * (1.f + (a_0 - 1.f) * ka[j]) * rk[j] + SR[o + 32] * SK[o + 32] * (1.f + (a_1 - 1.f) * ka[j + 32]) * rk[j + 32];
                bsum = sum16(bsum);
                bsum += __shfl_xor(bsum, 16, 64);
                if ((lane & 31) == 0) bon[(size_t)(m0 + i) * 8 + ((n0 + j) >> 6)] = bsum;
            };
            gemm_tile_mfma<false>(LIN + 64, 256, rowsrc, bsrc, 64, epi, smem, tid);
        } else {
            const float* W = p.ev_g2 + (size_t)e * 128 * 512 + n0;
            auto bsrc = [=](int k, int c) -> const float* { return W + (size_t)k * 512 + c; };
            auto epi = [=](int i, int j, float v0, float v1) { float* d = G + (size_t)(m0 + i) * 512 + n0 + j; d[0] = v0; d[32] = v1; };
            gemm_tile_mfma<false>(LIN + 128, 256, rowsrc, bsrc, 128, epi, smem, tid);
        }
    }
}

__device__ __forceinline__ void phase_prep_odd(const Params& p, int tid, int bid, int nb) {
    const int wid = tid >> 6, lane = tid & 63;
    const float* P32 = wsp<float>(p, WS_BIG);
    half_t* Q16 = wsp<half_t>(p, WS_Q16); half_t* K16 = wsp<half_t>(p, WS_K16); half_t* V16 = wsp<half_t>(p, WS_V16);
    for (int task = bid * 4 + wid; task < M * 48; task += nb * 4) {
        const int r = task / 48, u = task % 48, s = r % SEQA;
        float v = P32[(size_t)r * ODD_COLS + u * 64 + lane];
        if (u < 32 && s >= NCTX) v = rope64(v, lane, s - NCTX);
        if (u < 16) Q16[(size_t)r * 1024 + u * 64 + lane] = (half_t)(v * QSCALE);
        else if (u < 32) K16[(size_t)r * 1024 + (u - 16) * 64 + lane] = (half_t)v;
        else V16[(size_t)r * 1024 + (u - 32) * 64 + lane] = (half_t)v;
    }
}

template <int MODE>
__device__ __forceinline__ void phase_attn_mfma(const Params& p, int tid, int bid, int nb, unsigned char* smem) {
    constexpr int DV = MODE == 0 ? 64 : 128, NDT = DV / 32, VRS = MODE == 0 ? 192 : 320, KCS = 1040, VCH = DV / 8, NVJ = VCH * 64 / 256;
    unsigned char* sK = smem;
    unsigned char* sV = smem + 8 * KCS;
    const int lane = tid & 63, wid = tid >> 6, h5 = lane >> 5, l31 = lane & 31;
    constexpr int NH = MODE == 0 ? 8 : 16;
    constexpr int NLATU = 8 * NH * 16, NU = NLATU + 8 * NH * 2;
    const half_t* Q16 = wsp<half_t>(p, WS_Q16); const half_t* K16 = wsp<half_t>(p, WS_K16); const half_t* V16 = wsp<half_t>(p, WS_V16);
    constexpr int qstride = MODE == 0 ? 512 : 1024, kstride = MODE == 0 ? 128 : 1024;
    for (int u = bid; u < NU; u += nb) {
        int b, hh, qrow0, nkeys;
        if (u < NLATU) { b = u / (NH * 16); const int rem = u % (NH * 16); hh = rem >> 4; qrow0 = b * SEQA + NCTX + (rem & 15) * 128; nkeys = SEQA; }
        else { const int v = u - NLATU; b = v / (NH * 2); const int rem = v % (NH * 2); hh = rem >> 1; qrow0 = b * SEQA + (rem & 1) * 128; nkeys = NCTX; }
        const int qoff = MODE == 0 ? hh * 64 : (hh >> 1) * 128 + (hh & 1) * 64;
        const int koff = MODE == 0 ? (hh >> 2) * 64 : qoff;
        const int voff = MODE == 0 ? (hh >> 2) * 64 : (hh >> 1) * 128;
        const size_t kbase = (size_t)b * SEQA;
        h8_t qf[4];
        {
            const half_t* qp = Q16 + (size_t)(qrow0 + wid * 32 + l31) * qstride + qoff + 8 * h5;
#pragma unroll
            for (int ks = 0; ks < 4; ++ks) qf[ks] = *(const h8_t*)(qp + 16 * ks);
        }
        f32x16_t o[NDT];
#pragma unroll
        for (int dt = 0; dt < NDT; ++dt)
#pragma unroll
            for (int r = 0; r < 16; ++r) o[dt][r] = 0.f;
        float mrun = -INFINITY, lrun = 0.f;
        h8_t rk[2], rv[NVJ];
#define ATT_LOAD(kt)                                                                                                         \
        {                                                                                                                    \
            _Pragma("unroll") for (int j = 0; j < 2; ++j) { const int i_ = tid + 256 * j;                                     \
                rk[j] = *(const h8_t*)(K16 + (kbase + (kt) * 64 + (i_ >> 3)) * kstride + koff + (i_ & 7) * 8); }              \
            _Pragma("unroll") for (int j = 0; j < NVJ; ++j) { const int i_ = tid + 256 * j;                                   \
                rv[j] = *(const h8_t*)(V16 + (kbase + (kt) * 64 + (i_ / VCH)) * kstride + voff + (i_ % VCH) * 8); }           \
        }
        const int ntile = nkeys >> 6;
        ATT_LOAD(0);
        for (int kt = 0; kt < ntile; ++kt) {
            __syncthreads();
#pragma unroll
            for (int j = 0; j < 2; ++j) { const int i_ = tid + 256 * j; *(h8_t*)(sK + (i_ & 7) * KCS + (i_ >> 3) * 16) = rk[j]; }
#pragma unroll
            for (int j = 0; j < NVJ; ++j) { const int i_ = tid + 256 * j; *(h8_t*)(sV + (i_ / VCH) * VRS + (i_ % VCH) * 16) = rv[j]; }
            __syncthreads();
            if (kt + 1 < ntile) ATT_LOAD(kt + 1);
            f32x16_t sc[2];
#pragma unroll
            for (int kh = 0; kh < 2; ++kh)
#pragma unroll
                for (int r = 0; r < 16; ++r) sc[kh][r] = 0.f;
#pragma unroll
            for (int ks = 0; ks < 4; ++ks)
#pragma unroll
                for (int kh = 0; kh < 2; ++kh) {
                    const h8_t kf = *(const h8_t*)(sK + (2 * ks + h5) * KCS + (kh * 32 + l31) * 16);
                    sc[kh] = __builtin_amdgcn_mfma_f32_32x32x16_f16(kf, qf[ks], sc[kh], 0, 0, 0);
                }
            float tmax = sc[0][0];
#pragma unroll
            for (int r = 1; r < 16; ++r) tmax = fmaxf(tmax, sc[0][r]);
#pragma unroll
            for (int r = 0; r < 16; ++r) tmax = fmaxf(tmax, sc[1][r]);
            tmax = fmaxf(tmax, __shfl_xor(tmax, 32, 64));
            const float mnew = fmaxf(mrun, tmax);
            const float alpha = __builtin_amdgcn_exp2f(mrun - mnew);
            mrun = mnew;
            float psum = 0.f;
#pragma unroll
            for (int kh = 0; kh < 2; ++kh)
#pragma unroll
                for (int r = 0; r < 16; ++r) { const float pv = __builtin_amdgcn_exp2f(sc[kh][r] - mnew); sc[kh][r] = pv; psum += pv; }
            lrun = lrun * alpha + psum;
#pragma unroll
            for (int dt = 0; dt < NDT; ++dt)
#pragma unroll
                for (int r = 0; r < 16; ++r) o[dt][r] *= alpha;
#pragma unroll
            for (int kh = 0; kh < 2; ++kh)
#pragma unroll
                for (int s2 = 0; s2 < 2; ++s2) {
                    h8_t pf;
#pragma unroll
                    for (int j = 0; j < 8; ++j) pf[j] = (half_t)sc[kh][8 * s2 + j];
                    const int row0 = kh * 32 + 16 * s2 + 4 * h5 + ((lane & 15) >> 2);
#pragma unroll
                    for (int dt = 0; dt < NDT; ++dt) {
                        const int col = dt * 32 + 16 * ((lane >> 4) & 1) + 4 * (lane & 3);
                        const s16x4_t lo = __builtin_amdgcn_ds_read_tr16_b64_v4i16((LAS s16x4_t*)(sV + row0 * VRS + col * 2));
                        const s16x4_t hi = __builtin_amdgcn_ds_read_tr16_b64_v4i16((LAS s16x4_t*)(sV + (row0 + 8) * VRS + col * 2));
                        s16x8_t v8; v8[0] = lo[0]; v8[1] = lo[1]; v8[2] = lo[2]; v8[3] = lo[3]; v8[4] = hi[0]; v8[5] = hi[1]; v8[6] = hi[2]; v8[7] = hi[3];
                        o[dt] = __builtin_amdgcn_mfma_f32_32x32x16_f16(__builtin_bit_cast(h8_t, v8), pf, o[dt], 0, 0, 0);
                    }
                }
        }
#undef ATT_LOAD
        const float ltot = lrun + __shfl_xor(lrun, 32, 64);
        const float inv = 1.f / ltot;
        const int qrow = qrow0 + wid * 32 + l31;
#pragma unroll
        for (int dt = 0; dt < NDT; ++dt)
#pragma unroll
            for (int rg = 0; rg < 4; ++rg) {
                const int d0 = dt * 32 + 8 * rg + 4 * h5;
                if (MODE == 0) {
                    h4_t ov; ov.x = (half_t)(o[dt][4 * rg + 0] * inv); ov.y = (half_t)(o[dt][4 * rg + 1] * inv); ov.z = (half_t)(o[dt][4 * rg + 2] * inv); ov.w = (half_t)(o[dt][4 * rg + 3] * inv);
                    *(h4_t*)(wsp<half_t>(p, WS_MIX16) + (size_t)qrow * 1024 + hh * 64 + d0) = ov;
                } else {
                    const float4 ov = make_float4(o[dt][4 * rg + 0] * inv, o[dt][4 * rg + 1] * inv, o[dt][4 * rg + 2] * inv, o[dt][4 * rg + 3] * inv);
                    *(float4*)(wsp<float>(p, WS_ATT32) + (((size_t)qrow * 8 + (hh >> 1)) * 2 + (hh & 1)) * 128 + d0) = ov;
                }
            }
    }
}

__device__ __forceinline__ void phase_diff_finish(const Params& p, int tid, int layer, int bid, int nb) {
    const int o = layer >> 1, wid = tid >> 6, lane = tid & 63;
    const float linit = 0.8f - 0.6f * expf(-0.3f * (float)layer);
    const float d1 = wave_sum(p.od_lq1[o * 64 + lane] * p.od_lk1[o * 64 + lane]);
    const float d2 = wave_sum(p.od_lq2[o * 64 + lane] * p.od_lk2[o * 64 + lane]);
    const float lam = expf(d1) - expf(d2) + linit;
    const float s0 = p.od_subln[o * 128 + lane], s1 = p.od_subln[o * 128 + 64 + lane];
    const float* ATT = wsp<float>(p, WS_ATT32);
    half_t* MIX = wsp<half_t>(p, WS_MIX16);
    for (int task = bid * 4 + wid; task < M * 8; task += nb * 4) {
        const int r = task >> 3, h = task & 7;
        const float* a = ATT + ((size_t)r * 8 + h) * 256;
        const float o0 = a[lane] - lam * a[128 + lane], o1 = a[64 + lane] - lam * a[192 + lane];
        const float ss = wave_sum(o0 * o0 + o1 * o1) * (1.f / 128.f);
        const float sc = rsqrtf(ss + 1e-5f) * (1.f - linit);
        MIX[(size_t)r * 1024 + h * 128 + lane] = (half_t)(o0 * sc * s0);
        MIX[(size_t)r * 1024 + h * 128 + 64 + lane] = (half_t)(o1 * sc * s1);
    }
}

__device__ __forceinline__ void phase_scan(const Params& p, int tid, int layer, int bid, int nb, unsigned char* smem) {
    const int e = layer >> 1;
    constexpr int CH = 32;
    float* lds = (float*)smem;
    float* Lw = lds;
    float* Lv = lds + 5 * CH * 64;
    float* Ly = Lv + CH * 16;
    const int t = tid, wid = t >> 6, lane = t & 63, rloc = lane >> 4, kq = lane & 15;
    for (int item = bid; item < 512; item += nb) {
        const int chain = item >> 2, rq = item & 3, dir = chain & 1, bh = chain >> 1, b = bh >> 3, h = bh & 7;
        const size_t rowbase = (size_t)b * SEQA;
        const float* SCN = wsp<float>(p, WS_SR);
        const float* SV = wsp<float>(p, WS_SV);
        float* YS = wsp<float>(p, WS_YSC) + (size_t)dir * M * 512;
        auto tok_of = [=](int i) -> int { return dir == 0 ? i : (i < NCTX ? (NCTX - 1 - i) : (SEQA + NCTX - 1 - i)); };
        const int lf4 = t & 15, lst = t >> 4;
        const float4 ka4 = *(const float4*)(p.ev_k_a + e * 512 + h * 64 + lf4 * 4);
        float4 pw0, pa0, pk0, pq0, pr0, pw1, pa1, pk1, pq1, pr1, prev;
        pw0 = pa0 = pk0 = pq0 = pr0 = pw1 = pa1 = pk1 = pq1 = pr1 = prev = make_float4(0, 0, 0, 0);
#define SCAN_LDP(cc, sto, W_, A_, K_, Q_, R_)                                                                                      \
        {                                                                                                                          \
            const size_t off = (rowbase + tok_of((cc) * CH + lst + (sto))) * 512 + h * 64 + lf4 * 4;                                \
            W_ = *(const float4*)(SCN + (size_t)(3 + dir) * M * 512 + off);                                                        \
            A_ = *(const float4*)(SCN + (size_t)(5 + dir) * M * 512 + off);                                                        \
            K_ = *(const float4*)(SCN + (size_t)7 * M * 512 + off);                                                                \
            Q_ = *(const float4*)(SCN + (size_t)2 * M * 512 + off);                                                                \
            R_ = *(const float4*)(SCN + off);                                                                                      \
        }
#define SCAN_ISSUE(cc)                                                                                                             \
        {                                                                                                                          \
            SCAN_LDP(cc, 0, pw0, pa0, pk0, pq0, pr0) SCAN_LDP(cc, 16, pw1, pa1, pk1, pq1, pr1)                                      \
            if (t < 128) { const int st = t >> 2, f4 = t & 3; const size_t row = rowbase + tok_of((cc) * CH + st);                  \
                prev = *(const float4*)(SV + row * 512 + h * 64 + rq * 16 + f4 * 4); }                                              \
        }
#define SCAN_STP(sto, W_, A_, K_, Q_, R_)                                                                                          \
        {                                                                                                                          \
            float* d_ = Lw + (lst + (sto)) * 64 + lf4 * 4;                                                                         \
            *(float4*)(d_) = W_;                                                                                                   \
            *(float4*)(d_ + CH * 64) = make_float4(Q_.x * A_.x, Q_.y * A_.y, Q_.z * A_.z, Q_.w * A_.w);                             \
            *(float4*)(d_ + 2 * CH * 64) = make_float4(K_.x * (1.f + (A_.x - 1.f) * ka4.x), K_.y * (1.f + (A_.y - 1.f) * ka4.y),    \
                                                      K_.z * (1.f + (A_.z - 1.f) * ka4.z), K_.w * (1.f + (A_.w - 1.f) * ka4.w));    \
            *(float4*)(d_ + 3 * CH * 64) = Q_;                                                                                     \
            *(float4*)(d_ + 4 * CH * 64) = R_;                                                                                     \
        }
#define SCAN_COMMIT()                                                                                                              \
        {                                                                                                                          \
            SCAN_STP(0, pw0, pa0, pk0, pq0, pr0) SCAN_STP(16, pw1, pa1, pk1, pq1, pr1)                                              \
            if (t < 128) { const int st = t >> 2, f4 = t & 3; *(float4*)(Lv + st * 16 + f4 * 4) = prev; }                          \
        }
        float S0 = 0.f, S1 = 0.f, S2 = 0.f, S3 = 0.f;
        SCAN_ISSUE(0);
        SCAN_COMMIT();
        __syncthreads();
        for (int c = 0; c < SEQA / CH; ++c) {
            if (c + 1 < SEQA / CH) SCAN_ISSUE(c + 1);
#pragma unroll 4
            for (int st = 0; st < CH; ++st) {
                const float4 w4 = *(const float4*)(Lw + 0 * CH * 64 + st * 64 + kq * 4);
                const float4 b4 = *(const float4*)(Lw + 1 * CH * 64 + st * 64 + kq * 4);
                const float4 d4 = *(const float4*)(Lw + 2 * CH * 64 + st * 64 + kq * 4);
                const float4 a4 = *(const float4*)(Lw + 3 * CH * 64 + st * 64 + kq * 4);
                const float4 r4 = *(const float4*)(Lw + 4 * CH * 64 + st * 64 + kq * 4);
                const float vr = Lv[st * 16 + wid * 4 + rloc];
                float pk = S0 * a4.x + S1 * a4.y + S2 * a4.z + S3 * a4.w;
                pk = sum16(pk);
                S0 = S0 * w4.x + (vr * d4.x - pk * b4.x);
                S1 = S1 * w4.y + (vr * d4.y - pk * b4.y);
                S2 = S2 * w4.z + (vr * d4.z - pk * b4.z);
                S3 = S3 * w4.w + (vr * d4.w - pk * b4.w);
                float y = S0 * r4.x + S1 * r4.y + S2 * r4.z + S3 * r4.w;
                y = sum16(y);
                if (kq == 0) Ly[st * 16 + wid * 4 + rloc] = y;
            }
            __syncthreads();
            if (t < 128) {
                const int st = t >> 2, f4 = t & 3; const size_t row = rowbase + tok_of(c * CH + st);
                *(float4*)(YS + row * 512 + h * 64 + rq * 16 + f4 * 4) = *(const float4*)(Ly + st * 16 + f4 * 4);
            }
            if (c + 1 < SEQA / CH) SCAN_COMMIT();
            __syncthreads();
        }
    }
}

__device__ __forceinline__ void phase_readout(const Params& p, int tid, int layer, int bid, int nb) {
    const int e = layer >> 1, wid = tid >> 6, lane = tid & 63;
    const float* Y0 = wsp<float>(p, WS_YSC); const float* Y1 = Y0 + (size_t)M * 512;
    const float* SV = wsp<float>(p, WS_SV); const float* G = wsp<float>(p, WS_G); const float* BONUS = wsp<float>(p, WS_BONUS);
    half_t* MIX = wsp<half_t>(p, WS_MIX16);
    for (int task = bid * 4 + wid; task < M * 8; task += nb * 4) {
        const int r = task >> 3, h = task & 7;
        const size_t o = (size_t)r * 512 + h * 64 + lane;
        const float y = Y0[o] + Y1[o];
        const float mu = wave_sum(y) * (1.f / 64.f);
        const float d = y - mu;
        const float var = wave_sum(d * d) * (1.f / 64.f);
        float yn = d * rsqrtf(var + GN_EPS) * p.ev_gn_w[e * 512 + h * 64 + lane] + p.ev_gn_b[e * 512 + h * 64 + lane];
        yn += (BONUS[(size_t)r * 8 + h] + BONUS[(size_t)M * 8 + (size_t)r * 8 + h]) * SV[o];
        MIX[(size_t)r * 1024 + 512 + h * 64 + lane] = (half_t)(yn * G[o]);
    }
}

__device__ __forceinline__ void phase_route(const Params& p, int tid, int layer, int bid, int nb, unsigned char* smem) {
    float* hbuf = (float*)smem;
    float* lg = hbuf + 8 * 1024;
    float* part = lg + 8 * 36;
    const int t = tid, wid = t >> 6, lane = t & 63;
    const bool last = (layer == DEPTH - 1);
    int* cnt = wsp<int>(p, WS_CNT) + layer * 32;
    int* list = wsp<int>(p, WS_LIST);
    float* GATE = wsp<float>(p, WS_GATE); int* ESLOT = wsp<int>(p, WS_ESLOT);
    for (int rg = bid; rg < M / 8; rg += nb) {
        const int r0 = rg * 8;
        if (last && (r0 % SEQA) < NCTX) continue;
#pragma unroll
        for (int q = 0; q < 2; ++q) {
            const int lr = wid * 2 + q, r = r0 + lr;
            const float4* xr = (const float4*)(wsp<float>(p, WS_XS) + (size_t)r * 1024);
            float4 v[4]; float ss = 0.f;
#pragma unroll
            for (int j = 0; j < 4; ++j) { v[j] = xr[lane + 64 * j]; ss += v[j].x * v[j].x + v[j].y * v[j].y + v[j].z * v[j].z + v[j].w * v[j].w; }
            ss = wave_sum(ss);
            norm_row_store(p, layer, r, 3, v, ss, lane, hbuf + lr * 1024);
        }
        __syncthreads();
        {
            const int dg = t >> 5, og = t & 31;
            const float* wrt = p.moe_w_rt + (size_t)layer * 1024 * 32 + og;
            const float* wgp = p.moe_w_grp + (size_t)layer * 1024 * 4 + (og & 3);
            float acc[8], acc2[8];
#pragma unroll
            for (int rr = 0; rr < 8; ++rr) { acc[rr] = 0.f; acc2[rr] = 0.f; }
#pragma unroll 2
            for (int dd = 0; dd < 128; dd += 4) {
                const int d = dg * 128 + dd;
                const float w0 = wrt[(d + 0) * 32], w1 = wrt[(d + 1) * 32], w2 = wrt[(d + 2) * 32], w3 = wrt[(d + 3) * 32];
                const float g0 = wgp[(d + 0) * 4], g1 = wgp[(d + 1) * 4], g2 = wgp[(d + 2) * 4], g3 = wgp[(d + 3) * 4];
#pragma unroll
                for (int rr = 0; rr < 8; ++rr) {
                    const float4 hv = *(const float4*)(hbuf + rr * 1024 + d);
                    acc[rr] += hv.x * w0 + hv.y * w1 + hv.z * w2 + hv.w * w3;
                    acc2[rr] += hv.x * g0 + hv.y * g1 + hv.z * g2 + hv.w * g3;
                }
            }
#pragma unroll
            for (int rr = 0; rr < 8; ++rr) { part[(dg * 8 + rr) * 36 + 4 + og] = acc[rr]; if (og < 4) part[(dg * 8 + rr) * 36 + og] = acc2[rr]; }
        }
        __syncthreads();
        for (int o = t; o < 8 * 36; o += NT) {
            const int rr = o / 36, cc = o % 36;
            float sacc = cc < 4 ? p.moe_b_grp[layer * 4 + cc] : p.moe_b_rt[layer * 32 + cc - 4];
#pragma unroll
            for (int g = 0; g < 8; ++g) sacc += part[(g * 8 + rr) * 36 + cc];
            lg[o] = sacc;
        }
        __syncthreads();
        if (t < 8) {
            const int r = r0 + t;
            const float* L = lg + t * 36;
            int sel = 0; float mx = L[0];
            for (int g = 1; g < 4; ++g) if (L[g] > mx) { mx = L[g]; sel = g; }
            float z = 0.f;
            for (int g = 0; g < 4; ++g) z += expf(L[g] - mx);
            const float grp_w = 1.f / z;
            const float* E = L + 4 + sel * 8;
            int i1 = 0; float v1 = E[0];
            for (int j = 1; j < 8; ++j) if (E[j] > v1) { v1 = E[j]; i1 = j; }
            int i2 = -1; float v2 = -INFINITY;
            for (int j = 0; j < 8; ++j) if (j != i1 && E[j] > v2) { v2 = E[j]; i2 = j; }
            const float e2 = expf(v2 - v1);
            const float g1 = grp_w / (1.f + e2), g2 = grp_w * e2 / (1.f + e2);
            const int ea = sel * 8 + i1, eb = sel * 8 + i2;
            const int pa = atomicAdd(&cnt[ea], 1);
            const int pb = atomicAdd(&cnt[eb], 1);
            list[(size_t)ea * LISTCAP + pa] = r;
            list[(size_t)eb * LISTCAP + pb] = r;
            GATE[r * 2 + 0] = g1; GATE[r * 2 + 1] = g2;
            ESLOT[r * 2 + 0] = ea * 65536 + pa; ESLOT[r * 2 + 1] = eb * 65536 + pb;
        }
        __syncthreads();
    }
}

template <int TM>
__device__ __forceinline__ void moe_tables(const Params& p, int tid, int layer, int* tab  ) {
    if (tid == 0) {
        const int* cnt = wsp<int>(p, WS_CNT) + layer * 32;
        int ts = 0;
        for (int e = 0; e < 32; ++e) { const int c = cnt[e]; tab[e] = c; tab[32 + e] = ts; tab[65 + e] = ts * TM; ts += (c + TM - 1) / TM; }
        tab[64] = ts;
    }
    __syncthreads();
}
constexpr int MOE_TM = 128;
constexpr int MOE_TAB_OFF = 37120;
__device__ __forceinline__ void phase_moe1(const Params& p, int tid, int layer, int bid, int nb, unsigned char* smem) {
    constexpr int TM = MOE_TM;
    int* tab = (int*)(smem + MOE_TAB_OFF);
    moe_tables<TM>(p, tid, layer, tab);
    const int nrb = tab[64], nitems = nrb * 8;
    const half_t* H16 = wsp<half_t>(p, WS_H16);
    half_t* HM = wsp<half_t>(p, WS_HM16);
    const int* list = wsp<int>(p, WS_LIST);
    for (int item = bid; item < nitems; item += nb) {
        const int rb = item >> 3, nt = item & 7;
        int e = 0;
        while (e < 31 && tab[32 + e + 1] <= rb) ++e;
        const int lb = rb - tab[32 + e], cnt = tab[e], orow0 = tab[65 + e] + lb * TM;
        const int* le = list + (size_t)e * LISTCAP;
        auto rowsrc = [=](int i) -> long { const int pos = lb * TM + i; return pos < cnt ? (long)le[pos] : -1L; };
        const float* Wg = p.moe_w_gate + ((size_t)(layer * 32 + e)) * 1024 * 512 + nt * 64;
        const float* Wu = p.moe_w_up + ((size_t)(layer * 32 + e)) * 1024 * 512 + nt * 64;
        auto epi = [=](int i, int j, float g, float u) { HM[(size_t)(orow0 + i) * 512 + nt * 64 + j] = (half_t)(siluf_(g) * u); };
        auto bsrc = [=](int k, int c) -> const float* { return (((c >> 5) & 1) ? Wu : Wg) + (size_t)k * 512 + (c >> 6) * 32 + (c & 31); };
        gemm_tile_mfma<true>(H16, 1024, rowsrc, bsrc, 1024, epi, smem, tid);
    }
}
__device__ __forceinline__ void phase_moe2(const Params& p, int tid, int layer, int bid, int nb, unsigned char* smem) {
    constexpr int TM = MOE_TM, TN = 128, NTN = 1024 / TN;
    int* tab = (int*)(smem + MOE_TAB_OFF);
    moe_tables<TM>(p, tid, layer, tab);
    const int nrb = tab[64], nitems = nrb * NTN;
    const half_t* HM = wsp<half_t>(p, WS_HM16);
    float* YO = wsp<float>(p, WS_YOUT);
    for (int item = bid; item < nitems; item += nb) {
        const int rb = item / NTN, nt = item % NTN;
        int e = 0;
        while (e < 31 && tab[32 + e + 1] <= rb) ++e;
        const int lb = rb - tab[32 + e], orow0 = tab[65 + e] + lb * TM;
        auto rowsrc = [=](int i) -> long { return orow0 + i; };
        const float* Wd = p.moe_w_down + ((size_t)(layer * 32 + e)) * 512 * 1024 + nt * TN;
        auto epi = [=](int i, int j, float v0, float v1) { float* d = YO + (size_t)(orow0 + i) * 1024 + nt * TN + j; d[0] = v0; d[32] = v1; };
        auto bsrc = [=](int k, int c) -> const float* { return Wd + (size_t)k * 1024 + c; };
        gemm_tile_mfma<false>(HM, 512, rowsrc, bsrc, 512, epi, smem, tid);
    }
}

__device__ __forceinline__ void phase_combine(const Params& p, int tid, int layer, int bid, int nb, unsigned char* smem) {
    constexpr int TM = MOE_TM;
    int* tab = (int*)smem;
    moe_tables<TM>(p, tid, layer, tab);
    const int wid = tid >> 6, lane = tid & 63;
    const bool last = (layer == DEPTH - 1);
    const float* GATE = wsp<float>(p, WS_GATE); const int* ESLOT = wsp<int>(p, WS_ESLOT);
    const float* YO = wsp<float>(p, WS_YOUT);
    for (int r = bid * 4 + wid; r < M; r += nb * 4) {
        const int b = r / SEQA, s = r - b * SEQA;
        if (last && s < NCTX) continue;
        const int es0 = ESLOT[r * 2], es1 = ESLOT[r * 2 + 1];
        const float g0 = GATE[r * 2], g1 = GATE[r * 2 + 1];
        const size_t s0 = (size_t)(tab[65 + (es0 >> 16)] + (es0 & 65535)), s1 = (size_t)(tab[65 + (es1 >> 16)] + (es1 & 65535));
        float4* xr = (float4*)(wsp<float>(p, WS_XS) + (size_t)r * 1024);
        const float4* y0 = (const float4*)(YO + s0 * 1024); const float4* y1 = (const float4*)(YO + s1 * 1024);
        const float4* m5 = (const float4*)mods_ptr(p, layer, mods_row(r), 5);
        float4 v[4]; float ss = 0.f;
#pragma unroll
        for (int j = 0; j < 4; ++j) {
            const float4 x = xr[lane + 64 * j], a = y0[lane + 64 * j], c = y1[lane + 64 * j], g = m5[lane + 64 * j];
            float4 o;
            o.x = x.x + g.x * (g0 * a.x + g1 * c.x); o.y = x.y + g.y * (g0 * a.y + g1 * c.y);
            o.z = x.z + g.z * (g0 * a.z + g1 * c.z); o.w = x.w + g.w * (g0 * a.w + g1 * c.w);
            v[j] = o; ss += o.x * o.x + o.y * o.y + o.z * o.z + o.w * o.w;
        }
        ss = wave_sum(ss);
        if (!last) {
#pragma unroll
            for (int j = 0; j < 4; ++j) xr[lane + 64 * j] = v[j];
            norm_row_store(p, layer + 1, r, 0, v, ss, lane, nullptr);
        } else {
            const float rstd = rsqrtf(ss * (1.f / 1024.f) + 1e-6f);
            float4* dst = (float4*)(p.out + ((size_t)(b * NLAT + s - NCTX)) * 1024);
            const float4* fg = (const float4*)p.final_gain;
#pragma unroll
            for (int j = 0; j < 4; ++j) { const float4 g = fg[lane + 64 * j]; float4 o; o.x = v[j].x * rstd * g.x; o.y = v[j].y * rstd * g.y; o.z = v[j].z * rstd * g.z; o.w = v[j].w * rstd * g.w; dst[lane + 64 * j] = o; }
        }
    }
}


#define XB_TMO      128
#define XB_XCNT(j)  (256  + 64 * (j))
#define XB_XSUB(j)  (1280 + 64 * (j))
#define XB_XGEN(j)  (2304 + 64 * (j))
#define XB_TOP      3328
#define XB_TOPGEN   3392
#define XCD_BAR_WORDS 3456
#define XB_SPIN_CAP (1u << 22)

__device__ __forceinline__ unsigned xb_ld(unsigned* p)              { return __hip_atomic_load(p, __ATOMIC_RELAXED, __HIP_MEMORY_SCOPE_AGENT); }
__device__ __forceinline__ unsigned xb_add(unsigned* p, unsigned v) { return __hip_atomic_fetch_add(p, v, __ATOMIC_RELAXED, __HIP_MEMORY_SCOPE_AGENT); }
__device__ __forceinline__ unsigned xb_xcc_id() { return (unsigned)__builtin_amdgcn_s_getreg((3 << 11) | 20) & 0xFu; }
#define XB_SPIN(cond, bar) do { unsigned _sp = 0; while (cond) { __builtin_amdgcn_s_sleep(1); \
    if ((++_sp & 255u) == 0u) { if (xb_ld(&(bar)[XB_TMO])) break; if (_sp > XB_SPIN_CAP) { atomicAdd(&(bar)[XB_TMO], 1u); break; } } } } while (0)

struct XcdBarrier {
    unsigned* bar; unsigned x;
    volatile LAS unsigned* st;
};
__device__ __forceinline__ XcdBarrier xcd_barrier_post(unsigned* bar, volatile LAS unsigned* st) {
    XcdBarrier b; b.bar = bar; b.x = xb_xcc_id(); b.st = st;
    if (threadIdx.x == 0) (void)xb_add(&bar[XB_XCNT(b.x)], 1u);
    return b;
}
__device__ __forceinline__ void xcd_barrier_complete(unsigned* bar, unsigned x, unsigned& nloc, unsigned& nx) {
    const unsigned G = gridDim.x * gridDim.y * gridDim.z;
    unsigned sum, cnt, mine, sp = 0u;
    for (;;) {
        sum = 0u; cnt = 0u; mine = 0u;
#pragma unroll
        for (unsigned j = 0; j < 16; ++j) { const unsigned c = xb_ld(&bar[XB_XCNT(j)]); sum += c; cnt += (c > 0u) ? 1u : 0u; mine = (j == x) ? c : mine; }
        if (sum == G) break;
        __builtin_amdgcn_s_sleep(1);
        if ((++sp & 255u) == 0u) { if (xb_ld(&bar[XB_TMO])) break; if (sp > XB_SPIN_CAP) { atomicAdd(&bar[XB_TMO], 1u); break; } }
    }
    nloc = mine > 0u ? mine : 1u; nx = cnt > 0u ? cnt : 1u;
}
__device__ __forceinline__ void xcd_barrier(const XcdBarrier& b) {
    asm volatile("s_waitcnt vmcnt(0)" ::: "memory");
    __syncthreads();
    if (threadIdx.x == 0) {
        unsigned* bar = b.bar;
        __builtin_amdgcn_s_waitcnt(0);
        unsigned nloc = b.st[0], nx = b.st[1];
        if (nloc == 0u) { xcd_barrier_complete(bar, b.x, nloc, nx); b.st[0] = nloc; b.st[1] = nx; }
        const unsigned old = xb_add(&bar[XB_XSUB(b.x)], 1u);
        const unsigned gen = old / nloc;
        if (old + 1u == (gen + 1u) * nloc) {
            __builtin_amdgcn_fence(__ATOMIC_RELEASE, "agent");
            asm volatile("s_waitcnt vmcnt(0)" ::: "memory");
            const unsigned og = xb_add(&bar[XB_TOP], 1u);
            const unsigned tg = og / nx;
            if (og + 1u == (tg + 1u) * nx) xb_add(&bar[XB_TOPGEN], 1u);
            else XB_SPIN(xb_ld(&bar[XB_TOPGEN]) == tg, bar);
            __builtin_amdgcn_fence(__ATOMIC_ACQUIRE, "agent");
            xb_add(&bar[XB_XGEN(b.x)], 1u);
            asm volatile("s_waitcnt vmcnt(0)" ::: "memory");
        } else {
            XB_SPIN(xb_ld(&bar[XB_XGEN(b.x)]) == gen, bar);
            __builtin_amdgcn_fence(__ATOMIC_ACQUIRE, "agent");
            asm volatile("s_waitcnt vmcnt(0)" ::: "memory");
        }
    }
    __syncthreads();
}

enum { PH_MODS = 0, PH_COPY, PH_NORM1, PH_GEMM_IN, PH_PREP, PH_ATTN, PH_SCAN, PH_POST, PH_GEMM_OUT, PH_ROUTE, PH_MOE1, PH_MOE2, PH_COMBINE, PH_LORA };

template <int PH>
__device__ __forceinline__ void run_phase(const Params& p, int tid, int layer, int bid, int nb, unsigned char* smem) {
    const bool even = (layer & 1) == 0;
    const int e = layer >> 1;
    if (PH == PH_MODS) phase_mods(p, tid, bid, nb, smem);
    else if (PH == PH_COPY) phase_copy(p, tid, bid, nb);
    else if (PH == PH_NORM1) phase_norm1(p, tid, layer, bid, nb);
    else if (PH == PH_GEMM_IN) {
        if (even) phase_gemm_dense<0>(p, tid, layer, wsp<half_t>(p, WS_H16), p.ev_w_in + (size_t)e * 1024 * EVEN_COLS, EVEN_COLS, bid, nb, smem);
        else phase_gemm_dense<0>(p, tid, layer, wsp<half_t>(p, WS_H16), p.od_w_in + (size_t)e * 1024 * ODD_COLS, ODD_COLS, bid, nb, smem);
    } else if (PH == PH_PREP) { if (even) phase_prep_even(p, tid, layer, bid, nb, smem); else phase_prep_odd(p, tid, bid, nb); }
    else if (PH == PH_ATTN) {
        if (even) phase_attn_mfma<0>(p, tid, bid, nb, smem); else phase_attn_mfma<1>(p, tid, bid, nb, smem);
    }
    else if (PH == PH_LORA) { if (even) phase_lora(p, tid, layer, bid, nb, smem); }
    else if (PH == PH_SCAN) { if (even) phase_scan(p, tid, layer, bid, nb, smem); }
    else if (PH == PH_POST) { if (even) phase_readout(p, tid, layer, bid, nb); else phase_diff_finish(p, tid, layer, bid, nb); }
    else if (PH == PH_GEMM_OUT) phase_gemm_dense<1>(p, tid, layer, wsp<half_t>(p, WS_MIX16), (even ? p.ev_w_out : p.od_w_out) + (size_t)e * 1024 * 1024, 1024, bid, nb, smem);
    else if (PH == PH_ROUTE) phase_route(p, tid, layer, bid, nb, smem);
    else if (PH == PH_MOE1) phase_moe1(p, tid, layer, bid, nb, smem);
    else if (PH == PH_MOE2) phase_moe2(p, tid, layer, bid, nb, smem);
    else if (PH == PH_COMBINE) phase_combine(p, tid, layer, bid, nb, smem);
}

template <int PH>
__global__ void __launch_bounds__(NT, 2) k_phase(Params p, int layer) {
    extern __shared__ __attribute__((aligned(16))) unsigned char smem[];
    run_phase<PH>(p, threadIdx.x, layer, blockIdx.x, gridDim.x, smem);
}

constexpr int NPTR = 42;
constexpr int MEGA_LDS = LDS_BYTES + 16 + NPTR * 8;
static_assert(sizeof(Params) == NPTR * 8, "Params must be 42 pointers");
__device__ __forceinline__ Params load_params(const unsigned char* tab) {
    const LAS unsigned* t = (const LAS unsigned*)tab;
    Params q;
    const void* v[NPTR];
#pragma unroll
    for (int i = 0; i < NPTR; ++i) {
        const unsigned lo = __builtin_amdgcn_readfirstlane(t[2 * i]), hi = __builtin_amdgcn_readfirstlane(t[2 * i + 1]);
        const unsigned long long u = ((unsigned long long)hi << 32) | lo;
        v[i] = (const void*)(const __attribute__((address_space(1))) void*)u;
    }
    __builtin_memcpy(&q, v, sizeof(Params));
    return q;
}
__device__ __forceinline__ unsigned* load_bar_ptr(const unsigned char* tab) {
    const LAS unsigned* t = (const LAS unsigned*)tab;
    const unsigned lo = __builtin_amdgcn_readfirstlane(t[2 * 41]), hi = __builtin_amdgcn_readfirstlane(t[2 * 41 + 1]);
    const unsigned long long u = (((unsigned long long)hi << 32) | lo) + WS_BAR;
    return (unsigned*)(__attribute__((address_space(1))) unsigned*)u;
}
#define GRID_BARRIER() { XcdBarrier b2_; b2_.bar = load_bar_ptr(smem + LDS_BYTES + 16); b2_.x = bar_x; b2_.st = (volatile LAS unsigned*)(smem + LDS_BYTES); xcd_barrier(b2_); }
#ifndef PROBE_DUP
#define PROBE_DUP -1
#endif
#define RUN(PH, layer) { if (PH == PROBE_DUP) { const Params q0 = load_params(smem + LDS_BYTES + 16); int tid0_ = threadIdx.x; asm volatile("" : "+v"(tid0_)); int bid0_ = bid; asm volatile("" : "+s"(bid0_)); run_phase<PH>(q0, tid0_, layer, bid0_, nb, smem); __syncthreads(); } const Params q = load_params(smem + LDS_BYTES + 16); int tid_ = threadIdx.x; asm volatile("" : "+v"(tid_)); int bid_ = bid; asm volatile("" : "+s"(bid_)); run_phase<PH>(q, tid_, layer, bid_, nb, smem); }
__global__ void __launch_bounds__(NT, 2) k_mega(Params p) {
    extern __shared__ __attribute__((aligned(16))) unsigned char smem[];
    const int bid = blockIdx.x, nb = gridDim.x;
    if (threadIdx.x == 0) *(uint4*)(smem + LDS_BYTES) = make_uint4(0u, 0u, 0u, 0u);
    {
        unsigned long long v[NPTR];
        __builtin_memcpy(v, &p, sizeof(Params));
        unsigned long long* tab = (unsigned long long*)(smem + LDS_BYTES + 16);
        if (threadIdx.x == 0) {
#pragma unroll
            for (int i = 0; i < NPTR; ++i) tab[i] = v[i];
        }
    }
    unsigned* barw = (unsigned*)(p.ws + WS_BAR);
    __syncthreads();
    const unsigned bar_x = xcd_barrier_post(barw, (volatile LAS unsigned*)(smem + LDS_BYTES)).x;
    RUN(PH_MODS, 0);
    RUN(PH_COPY, 0);
    GRID_BARRIER();
    RUN(PH_NORM1, 0);
    GRID_BARRIER();
#pragma unroll 1
    for (int layer = 0; layer < DEPTH; ++layer) {
        RUN(PH_GEMM_IN, layer);
        GRID_BARRIER();
        RUN(PH_PREP, layer);
        GRID_BARRIER();
        RUN(PH_ATTN, layer);
        if ((layer & 1) == 0) {
            RUN(PH_LORA, layer);
            GRID_BARRIER();
            RUN(PH_SCAN, layer);
        }
        GRID_BARRIER();
        RUN(PH_POST, layer);
        GRID_BARRIER();
        RUN(PH_GEMM_OUT, layer);
        GRID_BARRIER();
        RUN(PH_ROUTE, layer);
        GRID_BARRIER();
        RUN(PH_MOE1, layer);
        GRID_BARRIER();
        RUN(PH_MOE2, layer);
        GRID_BARRIER();
        RUN(PH_COMBINE, layer);
        if (layer + 1 < DEPTH) GRID_BARRIER();
    }
}

template <int PH>
static void launch_phase(const Params& p, int layer, int grid, hipStream_t stream) {
    static bool attr_set = false;
    if (!attr_set) { (void)hipFuncSetAttribute((const void*)k_phase<PH>, hipFuncAttributeMaxDynamicSharedMemorySize, LDS_BYTES); attr_set = true; }
    hipLaunchKernelGGL(k_phase<PH>, dim3(grid), dim3(NT), LDS_BYTES, stream, p, layer);
}

extern "C" void kernel_launch(void* const* d_in, const int* in_sizes, int n_in, void* d_out, int out_size, void* d_ws, size_t ws_size, hipStream_t stream) {
    if (n_in != 40 || ws_size < WS_END) { fprintf(stderr, "kernel_launch: unexpected inputs (n_in %d, ws %zu, need %zu)\n", n_in, ws_size, (size_t)WS_END); return; }
    Params p{};
    const float** pp = (const float**)&p;
    for (int i = 0; i < 40; ++i) pp[i] = (const float*)d_in[i];
    p.out = (float*)d_out; p.ws = (unsigned char*)d_ws;
    (void)hipMemsetAsync(d_ws, 0, WS_ZERO_BYTES, stream);
#if ONE_LAUNCH
    static int grid = 0;
    if (grid == 0) {
        int dev = 0, cus = 0, per_cu = 0;
        (void)hipGetDevice(&dev);
        (void)hipDeviceGetAttribute(&cus, hipDeviceAttributeMultiprocessorCount, dev);
        (void)hipFuncSetAttribute((const void*)k_mega, hipFuncAttributeMaxDynamicSharedMemorySize, MEGA_LDS);
        if (hipOccupancyMaxActiveBlocksPerMultiprocessor(&per_cu, (const void*)k_mega, NT, MEGA_LDS) != hipSuccess || per_cu < 1) per_cu = 1;
        (void)hipGetLastError();
        if (cus <= 0) cus = 256;
        grid = cus * (per_cu < 2 ? per_cu : 2);
    }
    hipLaunchKernelGGL(k_mega, dim3(grid), dim3(NT), MEGA_LDS, stream, p);
#else
    const int grid = 1024;
    launch_phase<PH_MODS>(p, 0, 512, stream);
    launch_phase<PH_COPY>(p, 0, grid, stream);
    launch_phase<PH_NORM1>(p, 0, grid, stream);
    for (int layer = 0; layer < DEPTH; ++layer) {
        launch_phase<PH_GEMM_IN>(p, layer, grid, stream);
        launch_phase<PH_PREP>(p, layer, grid, stream);
        launch_phase<PH_ATTN>(p, layer, grid, stream);
        if ((layer & 1) == 0) { launch_phase<PH_LORA>(p, layer, grid, stream); launch_phase<PH_SCAN>(p, layer, 512, stream); }
        launch_phase<PH_POST>(p, layer, grid, stream);
        launch_phase<PH_GEMM_OUT>(p, layer, grid, stream);
        launch_phase<PH_ROUTE>(p, layer, grid, stream);
        launch_phase<PH_MOE1>(p, layer, grid, stream);
        launch_phase<PH_MOE2>(p, layer, grid, stream);
        launch_phase<PH_COMBINE>(p, layer, grid, stream);
    }
#endif
}
```

```cpp
#include <hip/hip_runtime.h>
#include <stdint.h>
#include <stdio.h>

#ifndef USE_MFMA_ATTN
#define USE_MFMA_ATTN 1
#endif
#ifndef USE_MFMA_GEMM
#define USE_MFMA_GEMM 1
#endif
#ifndef ONE_LAUNCH
#define ONE_LAUNCH 1
#endif

#define LAS __attribute__((address_space(3)))
typedef _Float16 half_t;
typedef _Float16 h4_t __attribute__((ext_vector_type(4)));
typedef _Float16 h8_t __attribute__((ext_vector_type(8)));

constexpr int D = 1024, NB = 8, NLAT = 2048, NCTX = 256, SEQA = NLAT + NCTX  , M = NB * SEQA  ;
constexpr int DEPTH = 4;
constexpr int EVEN_COLS = 2560, ODD_COLS = 3072;
constexpr int NEXP = 32, EH = 512;
constexpr int LISTCAP = 36864, MAXSLOT = 40960;
constexpr int NSHARD = 8, SHCAP = LISTCAP / NSHARD;
constexpr float DECAY_SCALE = 0.60653065971263342f;
constexpr float GN_EPS = 64e-5f;
constexpr float QSCALE = 0.125f * 1.4426950408889634f;
constexpr int NT = 256;
constexpr int LDS_BYTES = 75776;

constexpr size_t WS_BAR = 0;
constexpr size_t WS_CNT = 16384;
constexpr size_t WS_ZERO_BYTES = 24576;
constexpr size_t WS_ROPE = 24576;
constexpr size_t WS_MODS = 32768;
constexpr size_t WS_XS = 1u << 20;
constexpr size_t SZ_F32_1024 = (size_t)M * 1024 * 4;
constexpr size_t SZ_H16_1024 = (size_t)M * 1024 * 2;
constexpr size_t SZ_F32_512 = (size_t)M * 512 * 4;
constexpr size_t WS_H16 = WS_XS + SZ_F32_1024;
constexpr size_t WS_BIG = WS_H16 + SZ_H16_1024;
constexpr size_t SZ_BIG = (size_t)M * 8 * 2 * 128 * 4;
constexpr size_t WS_Q16 = WS_BIG + SZ_BIG;
constexpr size_t WS_K16 = WS_Q16 + SZ_H16_1024;
constexpr size_t WS_V16 = WS_K16 + SZ_H16_1024;
constexpr size_t WS_MIX16 = WS_V16 + SZ_H16_1024;
constexpr size_t WS_SR = WS_MIX16 + SZ_H16_1024;
constexpr size_t WS_SV = WS_SR + SZ_F32_512;
constexpr size_t WS_SKK = WS_SV + SZ_F32_512;
constexpr size_t WS_SW = WS_SKK + SZ_F32_512;
constexpr size_t WS_SA = WS_SW + 2 * SZ_F32_512;
constexpr size_t WS_SK = WS_SA + 2 * SZ_F32_512;
constexpr size_t WS_G = WS_SK + 2 * SZ_F32_512;
constexpr size_t WS_VF = WS_G + SZ_F32_512;
constexpr size_t WS_BONUS = WS_VF + SZ_F32_512;
constexpr size_t WS_LIN16 = WS_BONUS + (size_t)2 * M * 8 * 4;
constexpr size_t WS_LIST = WS_LIN16 + (size_t)M * 256 * 2;
constexpr size_t WS_GATE = WS_LIST + (size_t)NEXP * LISTCAP * 4;
constexpr size_t WS_ESLOT = WS_GATE + (size_t)M * 2 * 4;
constexpr size_t WS_W16 = WS_ESLOT + (size_t)M * 2 * 4;
constexpr size_t W16_EV_IN = 0, W16_OD_IN = W16_EV_IN + (size_t)2 * 1024 * EVEN_COLS, W16_EV_OUT = W16_OD_IN + (size_t)2 * 1024 * ODD_COLS,
                 W16_OD_OUT = W16_EV_OUT + (size_t)2 * 1024 * 1024, W16_W2 = W16_OD_OUT + (size_t)2 * 1024 * 1024, W16_A2 = W16_W2 + (size_t)4 * 64 * 512,
                 W16_G2 = W16_A2 + (size_t)4 * 64 * 512, W16_MOE = W16_G2 + (size_t)2 * 128 * 512,
                 W16_MOE_GATE = W16_MOE, W16_MOE_UP = W16_MOE + (size_t)32 * 1024 * 512, W16_MOE_DOWN = W16_MOE_UP + (size_t)32 * 1024 * 512,
                 W16_ELEMS = W16_MOE_DOWN + (size_t)32 * 512 * 1024;
constexpr size_t WS_WR = WS_W16 + W16_ELEMS * 2;
constexpr size_t WS_END = WS_WR + (size_t)4 * 64 * 3 * 64 * 4 * 4;
constexpr size_t WS_YSC = WS_BIG;
constexpr size_t WS_ATT32 = WS_BIG;
constexpr size_t WS_HM16 = WS_BIG;
constexpr size_t WS_YOUT = WS_BIG + (size_t)MAXSLOT * 512 * 2;
constexpr size_t WS_RW32 = WS_BIG;
static_assert(WS_YOUT + (size_t)MAXSLOT * 1024 * 2 <= WS_BIG + SZ_BIG, "BIG region too small");
static_assert(WS_END < (size_t)1040 * 1000 * 1000, "workspace too large");

struct Params {
    const float *x, *c, *ctx, *c_ctx, *mod_w, *mod_b, *ev_w_in, *ev_w_out, *ev_q_gain, *ev_k_gain, *ev_mu_prev, *ev_mu_next, *ev_w0, *ev_w2,
        *ev_a0, *ev_a2, *ev_g2, *ev_k_k, *ev_k_a, *ev_r_k, *ev_gn_w, *ev_gn_b, *ev_v0, *ev_v1, *ev_v2, *od_w_in, *od_w_out, *od_lq1, *od_lk1,
        *od_lq2, *od_lk2, *od_subln, *moe_w_grp, *moe_b_grp, *moe_w_rt, *moe_b_rt, *moe_w_gate, *moe_w_up, *moe_w_down, *final_gain;
    float* out;
    unsigned char* ws;
};

template <int CTRL> __device__ __forceinline__ float dpp_mov(float v) {
    return __int_as_float(__builtin_amdgcn_update_dpp(0, __float_as_int(v), CTRL, 0xF, 0xF, true));
}
__device__ __forceinline__ float sum16(float v) {
    v += dpp_mov<0xB1>(v);
    v += dpp_mov<0x4E>(v);
    v += dpp_mov<0x141>(v);
    v += dpp_mov<0x140>(v);
    return v;
}
__device__ __forceinline__ float wave_sum(float v) {
    v = sum16(v);
    const float a = __int_as_float(__builtin_amdgcn_readlane(__float_as_int(v), 0)), b = __int_as_float(__builtin_amdgcn_readlane(__float_as_int(v), 16));
    const float c = __int_as_float(__builtin_amdgcn_readlane(__float_as_int(v), 32)), d = __int_as_float(__builtin_amdgcn_readlane(__float_as_int(v), 48));
    return (a + b) + (c + d);
}
__device__ __forceinline__ h4_t to_h4(float4 v) { h4_t h; h.x = (half_t)v.x; h.y = (half_t)v.y; h.z = (half_t)v.z; h.w = (half_t)v.w; return h; }
__device__ __forceinline__ float4 from_h4(h4_t h) { return make_float4((float)h.x, (float)h.y, (float)h.z, (float)h.w); }
__device__ __forceinline__ float sigmoidf_(float x) { return 1.f / (1.f + expf(-x)); }
__device__ __forceinline__ float fsigmoid(float x) { return __builtin_amdgcn_rcpf(1.f + __builtin_amdgcn_exp2f(-1.4426950408889634f * x)); }
__device__ __forceinline__ float siluf_(float x) { return x / (1.f + expf(-x)); }
__device__ __forceinline__ int mods_row(int r) { const int b = r / SEQA, s = r - b * SEQA; return s < NCTX ? 8 : b; }
__device__ __forceinline__ const float* mods_ptr(const Params& p, int layer, int mr, int chunk) {
    return (const float*)(p.ws + WS_MODS) + ((size_t)(layer * 9 + mr)) * 6144 + chunk * 1024;
}
template <class T> __device__ __forceinline__ T* wsp(const Params& p, size_t off) { return (T*)(p.ws + off); }

constexpr int NPTR = 42;
constexpr int MEGA_LDS = LDS_BYTES + 16 + NPTR * 8 + 16;
static_assert(sizeof(Params) == NPTR * 8, "Params must be 42 pointers");
__device__ __forceinline__ Params load_params(const unsigned char* tab) {
    const LAS unsigned* t = (const LAS unsigned*)tab;
    Params q;
    const void* v[NPTR];
#pragma unroll
    for (int i = 0; i < NPTR; ++i) {
        const unsigned lo = __builtin_amdgcn_readfirstlane(t[2 * i]), hi = __builtin_amdgcn_readfirstlane(t[2 * i + 1]);
        const unsigned long long u = ((unsigned long long)hi << 32) | lo;
        v[i] = (const void*)(const __attribute__((address_space(1))) void*)u;
    }
    __builtin_memcpy(&q, v, sizeof(Params));
    return q;
}
__device__ __forceinline__ void convert_w16(const float* __restrict__ src, half_t* __restrict__ dst, size_t n, int tid, int bid, int nb) {
    const size_t n8 = n >> 3, st = (size_t)nb * NT;
#pragma unroll 1
    for (size_t i0 = (size_t)bid * NT + tid; i0 < n8; i0 += 4 * st) {
        float4 a[4], b[4];
#pragma unroll
        for (int u = 0; u < 4; ++u) {
            const size_t i = i0 + u * st;
            if (i < n8) { a[u] = ((const float4*)src)[2 * i]; b[u] = ((const float4*)src)[2 * i + 1]; } else { a[u] = make_float4(0.f, 0.f, 0.f, 0.f); b[u] = a[u]; }
        }
        __builtin_amdgcn_sched_barrier(0);
#pragma unroll
        for (int u = 0; u < 4; ++u) {
            const size_t i = i0 + u * st;
            h8_t h; h[0] = (half_t)a[u].x; h[1] = (half_t)a[u].y; h[2] = (half_t)a[u].z; h[3] = (half_t)a[u].w; h[4] = (half_t)b[u].x; h[5] = (half_t)b[u].y; h[6] = (half_t)b[u].z; h[7] = (half_t)b[u].w;
            if (i < n8) ((h8_t*)dst)[i] = h;
        }
    }
}
__device__ __forceinline__ void convert_dense_weights(const Params& p, int tid, int bid, int nb) {
    half_t* W16 = wsp<half_t>(p, WS_W16);
    convert_w16(p.ev_w_in, W16 + W16_EV_IN, (size_t)2 * 1024 * EVEN_COLS, tid, bid, nb);
    convert_w16(p.od_w_in, W16 + W16_OD_IN, (size_t)2 * 1024 * ODD_COLS, tid, bid, nb);
    convert_w16(p.ev_w_out, W16 + W16_EV_OUT, (size_t)2 * 1024 * 1024, tid, bid, nb);
    convert_w16(p.od_w_out, W16 + W16_OD_OUT, (size_t)2 * 1024 * 1024, tid, bid, nb);
    convert_w16(p.ev_w2, W16 + W16_W2, (size_t)4 * 64 * 512, tid, bid, nb);
    convert_w16(p.ev_a2, W16 + W16_A2, (size_t)4 * 64 * 512, tid, bid, nb);
    convert_w16(p.ev_g2, W16 + W16_G2, (size_t)2 * 128 * 512, tid, bid, nb);
}
constexpr int MOE_CV_CHUNKS = 3 * 2097152;
__device__ __forceinline__ void convert_moe_steps(const unsigned char* ptab, int layer, int tid, int bid, int nb, int q0, int q1) {
    if (q0 >= q1) return;
    const Params p = load_params(ptab);
    half_t* W16 = wsp<half_t>(p, WS_W16) + W16_MOE;
    const size_t lofs = (size_t)layer * 32 * 1024 * 512;
#pragma unroll 1
    for (int q = q0; q < q1; q += 4) {
        float4 a[4], b[4];
#pragma unroll
        for (int u = 0; u < 4; ++u) {
            const size_t i = ((size_t)(q + u) * nb + bid) * NT + tid;
            const bool ok = q + u < q1 && i < (size_t)MOE_CV_CHUNKS;
            const int tsel = (int)(i >> 21); const size_t off = (i & 2097151u) * 8;
            const float* src = (tsel == 0 ? p.moe_w_gate : tsel == 1 ? p.moe_w_up : p.moe_w_down) + lofs + off;
            if (ok) { a[u] = ((const float4*)src)[0]; b[u] = ((const float4*)src)[1]; } else { a[u] = make_float4(0.f, 0.f, 0.f, 0.f); b[u] = a[u]; }
        }
        __builtin_amdgcn_sched_barrier(0);
#pragma unroll
        for (int u = 0; u < 4; ++u) {
            const size_t i = ((size_t)(q + u) * nb + bid) * NT + tid;
            const bool ok = q + u < q1 && i < (size_t)MOE_CV_CHUNKS;
            const int tsel = (int)(i >> 21); const size_t off = (i & 2097151u) * 8;
            h8_t h; h[0] = (half_t)a[u].x; h[1] = (half_t)a[u].y; h[2] = (half_t)a[u].z; h[3] = (half_t)a[u].w; h[4] = (half_t)b[u].x; h[5] = (half_t)b[u].y; h[6] = (half_t)b[u].z; h[7] = (half_t)b[u].w;
            if (ok) *(h8_t*)(W16 + (size_t)tsel * 32 * 1024 * 512 + off) = h;
        }
    }
}

__device__ __forceinline__ void phase_mods(const Params& p, int tid, int bid, int nb, unsigned char* smem) {
    float* cond = (float*)smem;
    float* part = cond + 9 * 1024;
    const int t = tid;
    {
        float4 cv[9];
#pragma unroll
        for (int r = 0; r < 9; ++r) cv[r] = r < 8 ? ((const float4*)(p.c + r * 1024))[t] : ((const float4*)p.c_ctx)[t];
        __builtin_amdgcn_sched_barrier(0);
#pragma unroll
        for (int r = 0; r < 9; ++r) ((float4*)(cond + r * 1024))[t] = make_float4(siluf_(cv[r].x), siluf_(cv[r].y), siluf_(cv[r].z), siluf_(cv[r].w));
    }
    __syncthreads();
    if (bid == 0) {
        float2* ROPE = wsp<float2>(p, WS_ROPE);
        for (int i = t; i < 64 * 16; i += NT) { const float ang = (float)(i >> 4) * powf(10000.0f, -(float)(i & 15) / 16.0f); ROPE[i] = make_float2(cosf(ang), sinf(ang)); }
    }
    float* mods = wsp<float>(p, WS_MODS);
    for (int item = bid; item < 512; item += nb) {
        const int layer = item >> 7, col0 = (item & 127) * 48;
        const int cq = t % 12, dg = t / 12;
        if (dg < 16) {
            float acc[9][4];
#pragma unroll
            for (int r = 0; r < 9; ++r)
#pragma unroll
                for (int j = 0; j < 4; ++j) acc[r][j] = 0.f;
            const float* W = p.mod_w + (size_t)layer * 1024 * 6144 + col0 + cq * 4;
#pragma unroll 1
            for (int i0 = 0; i0 < 64; i0 += 16) {
                float4 w[16];
#pragma unroll
                for (int u = 0; u < 16; ++u) w[u] = *(const float4*)(W + (size_t)(dg * 64 + i0 + u) * 6144);
                __builtin_amdgcn_sched_barrier(0);
#pragma unroll
                for (int u = 0; u < 16; ++u) {
                    const int d = dg * 64 + i0 + u;
#pragma unroll
                    for (int r = 0; r < 9; ++r) { const float cv = cond[r * 1024 + d]; acc[r][0] += cv * w[u].x; acc[r][1] += cv * w[u].y; acc[r][2] += cv * w[u].z; acc[r][3] += cv * w[u].w; }
                }
            }
#pragma unroll
            for (int r = 0; r < 9; ++r)
#pragma unroll
                for (int j = 0; j < 4; ++j) part[(dg * 9 + r) * 48 + cq * 4 + j] = acc[r][j];
        }
        __syncthreads();
        for (int o = t; o < 9 * 48; o += NT) {
            const int r = o / 48, cc = o % 48;
            float s = p.mod_b[layer * 6144 + col0 + cc];
            for (int g = 0; g < 16; ++g) s += part[(g * 9 + r) * 48 + cc];
            mods[((size_t)(layer * 9 + r)) * 6144 + col0 + cc] = s;
        }
        __syncthreads();
    }
}

__device__ __forceinline__ void norm_row_store(const Params& p, int layer, int r, int chunk_shift, const float4 (&v)[4], float ss, int lane, float* hbuf  ) {
    const float rstd = rsqrtf(ss * (1.f / 1024.f) + 1e-6f);
    const int mr = mods_row(r);
    const float4* sh = (const float4*)mods_ptr(p, layer, mr, chunk_shift);
    const float4* sc = (const float4*)mods_ptr(p, layer, mr, chunk_shift + 1);
    half_t* H = wsp<half_t>(p, WS_H16) + (size_t)r * 1024;
    float4 a[4], b[4];
#pragma unroll
    for (int j = 0; j < 4; ++j) { a[j] = sh[lane + 64 * j]; b[j] = sc[lane + 64 * j]; }
    __builtin_amdgcn_sched_barrier(0);
#pragma unroll
    for (int j = 0; j < 4; ++j) {
        float4 h;
        h.x = v[j].x * rstd * (1.f + b[j].x) + a[j].x; h.y = v[j].y * rstd * (1.f + b[j].y) + a[j].y;
        h.z = v[j].z * rstd * (1.f + b[j].z) + a[j].z; h.w = v[j].w * rstd * (1.f + b[j].w) + a[j].w;
        h4_t hh; hh.x = (half_t)h.x; hh.y = (half_t)h.y; hh.z = (half_t)h.z; hh.w = (half_t)h.w;
        *(h4_t*)(H + (lane + 64 * j) * 4) = hh;
        if (hbuf) *(float4*)(hbuf + (lane + 64 * j) * 4) = h;
    }
}
__device__ __forceinline__ void phase_norm1(const Params& p, int tid, int layer, int bid, int nb) {
    const int wid = tid >> 6, lane = tid & 63;
    for (int r = bid * 4 + wid; r < M; r += nb * 4) {
        const int b = r / SEQA, s = r - b * SEQA;
        const float4* xr = (s < NCTX) ? (const float4*)(p.ctx + ((size_t)(b * NCTX + s)) * 1024) : (const float4*)(p.x + ((size_t)(b * NLAT + s - NCTX)) * 1024);
        float4* xs = (float4*)(wsp<float>(p, WS_XS) + (size_t)r * 1024);
        float4 v[4]; float ss = 0.f;
#pragma unroll
        for (int j = 0; j < 4; ++j) v[j] = xr[lane + 64 * j];
        __builtin_amdgcn_sched_barrier(0);
#pragma unroll
        for (int j = 0; j < 4; ++j) { xs[lane + 64 * j] = v[j]; ss += v[j].x * v[j].x + v[j].y * v[j].y + v[j].z * v[j].z + v[j].w * v[j].w; }
        ss = wave_sum(ss);
        norm_row_store(p, layer, r, 0, v, ss, lane, nullptr);
    }
}

typedef float f32x16_t __attribute__((ext_vector_type(16)));
typedef short s16x4_t __attribute__((__vector_size__(8)));
typedef short s16x8_t __attribute__((ext_vector_type(8)));
constexpr int GT_P = 132;
constexpr int GA_CS = 2064, GB_RS = 320, G_SA_BYTES = 8 * GA_CS, G_SB_BYTES = 64 * GB_RS, G_LDS_BYTES = G_SA_BYTES + G_SB_BYTES;
struct TileSrc { const half_t* A; const half_t* B0; const half_t* B1; unsigned aoff[4]; };
struct GemmRegs { h8_t xa0, xa1, xa2, xa3, xb0, xb1, xb2, xb3, ya0, ya1, ya2, ya3, yb0, yb1, yb2, yb3; };
template <class RowSrc> __device__ __forceinline__ void tile_aoff(TileSrc& T, RowSrc rowsrc, int lda, int tid) {
#pragma unroll
    for (int j = 0; j < 4; ++j) { const long rsj = rowsrc((tid + 256 * j) >> 3); T.aoff[j] = ((unsigned)(rsj >= 0 ? rsj : 0) * (unsigned)lda + (tid & 7) * 8) * 2u; }
}
struct EpiLd { float4 a, b; };
template <bool DUAL, class LdF, class Epi>
__device__ __forceinline__ void gemm_tile_mfma(const TileSrc& cur, const TileSrc& nxt, bool has_next, bool preloaded, GemmRegs& R, int ldb, int K, LdF ldf, Epi epi, unsigned char* smem, int tid) {
    const int lane = tid & 63, wid = tid >> 6, wm = wid >> 1, wn = wid & 1;
    const unsigned bvoff = (DUAL ? (unsigned)(tid >> 3) * (unsigned)ldb + (tid & 7) * 8 : (unsigned)(tid >> 4) * (unsigned)ldb + (tid & 15) * 8) * 2u;
    const int bst = DUAL ? (tid >> 3) * GB_RS + ((tid & 7) >> 2) * 128 + (tid & 3) * 16 : (tid >> 4) * GB_RS + (tid & 15) * 16;
    const int ast = (tid & 7) * GA_CS + (tid >> 3) * 16;
    f32x16_t acc[2][2];
#pragma unroll
    for (int i = 0; i < 2; ++i)
#pragma unroll
        for (int j = 0; j < 2; ++j)
#pragma unroll
            for (int r = 0; r < 16; ++r) acc[i][j][r] = 0.f;
    const int nkt = K >> 6;
#define GLD(dst, off, base) asm volatile("global_load_dwordx4 %0, %1, %2" : "=v"(dst) : "v"(off), "s"(base) : "memory")
#define PIN4(a, b, c, d) asm volatile("" : "+v"(a), "+v"(b), "+v"(c), "+v"(d) :: "memory")
#define BBASE(T, kt, j) (DUAL ? (((j) & 1) ? (T).B1 : (T).B0) + (size_t)((kt) * 64 + 32 * ((j) >> 1)) * ldb : (T).B0 + (size_t)((kt) * 64 + 16 * (j)) * ldb)
#define LOADSET(P, kt, T)                                                                                               \
    {                                                                                                                   \
        const half_t* Ak_ = (T).A + (kt) * 64;                                                                          \
        GLD(R.P##a0, (T).aoff[0], Ak_); GLD(R.P##a1, (T).aoff[1], Ak_); GLD(R.P##a2, (T).aoff[2], Ak_); GLD(R.P##a3, (T).aoff[3], Ak_); \
        GLD(R.P##b0, bvoff, BBASE(T, kt, 0)); GLD(R.P##b1, bvoff, BBASE(T, kt, 1)); GLD(R.P##b2, bvoff, BBASE(T, kt, 2)); GLD(R.P##b3, bvoff, BBASE(T, kt, 3)); \
    }
#define WAITSET(P, newer) { if (newer) asm volatile("s_waitcnt vmcnt(8)" ::: "memory"); else asm volatile("s_waitcnt vmcnt(0)" ::: "memory"); \
        PIN4(R.P##a0, R.P##a1, R.P##a2, R.P##a3); PIN4(R.P##b0, R.P##b1, R.P##b2, R.P##b3); }
#define STORESET(P, buf)                                                                                                \
    {                                                                                                                   \
        unsigned char* sA_ = smem + (buf) * G_LDS_BYTES + ast; unsigned char* sB_ = smem + (buf) * G_LDS_BYTES + G_SA_BYTES + bst; \
        *(h8_t*)(sA_) = R.P##a0; *(h8_t*)(sA_ + 512) = R.P##a1; *(h8_t*)(sA_ + 1024) = R.P##a2; *(h8_t*)(sA_ + 1536) = R.P##a3;    \
        *(h8_t*)(sB_) = R.P##b0; *(h8_t*)(sB_ + (DUAL ? 64 : 16 * GB_RS)) = R.P##b1;                                      \
        *(h8_t*)(sB_ + (DUAL ? 32 * GB_RS : 32 * GB_RS)) = R.P##b2; *(h8_t*)(sB_ + (DUAL ? 32 * GB_RS + 64 : 48 * GB_RS)) = R.P##b3; \
    }
#define LDFRAG(ks, AF, BF)                                                                                              \
    {                                                                                                                   \
        _Pragma("unroll") for (int i = 0; i < 2; ++i) AF[i] = *(const h8_t*)(sA + (2 * (ks) + (lane >> 5)) * GA_CS + (wm * 64 + i * 32 + (lane & 31)) * 16); \
        _Pragma("unroll") for (int j = 0; j < 2; ++j) {                                                                 \
            const int row0 = 16 * (ks) + 8 * (lane >> 5) + ((lane & 15) >> 2);                                          \
            const int col = wn * 64 + j * 32 + 16 * ((lane >> 4) & 1) + 4 * (lane & 3);                                  \
            const s16x4_t lo = __builtin_amdgcn_ds_read_tr16_b64_v4i16((LAS s16x4_t*)(sB + row0 * GB_RS + col * 2));     \
            const s16x4_t hi = __builtin_amdgcn_ds_read_tr16_b64_v4i16((LAS s16x4_t*)(sB + (row0 + 4) * GB_RS + col * 2)); \
            s16x8_t b8; b8[0] = lo[0]; b8[1] = lo[1]; b8[2] = lo[2]; b8[3] = lo[3]; b8[4] = hi[0]; b8[5] = hi[1]; b8[6] = hi[2]; b8[7] = hi[3]; \
            BF[j] = __builtin_bit_cast(h8_t, b8);                                                                       \
        }                                                                                                               \
    }
#define MFMA4(AF, BF)                                                                                                   \
    { _Pragma("unroll") for (int i = 0; i < 2; ++i) _Pragma("unroll") for (int j = 0; j < 2; ++j) acc[i][j] = __builtin_amdgcn_mfma_f32_32x32x16_f16(AF[i], BF[j], acc[i][j], 0, 0, 0); }
#define MFMA_STAGE(buf)                                                                                                 \
    {                                                                                                                   \
        const unsigned char* sA = smem + (buf) * G_LDS_BYTES; const unsigned char* sB = sA + G_SA_BYTES;                  \
        h8_t afA[2], bfA[2], afB[2], bfB[2];                                                                            \
        LDFRAG(0, afA, bfA); __builtin_amdgcn_sched_barrier(0);                                                          \
        LDFRAG(1, afB, bfB); __builtin_amdgcn_sched_barrier(0); MFMA4(afA, bfA); __builtin_amdgcn_sched_barrier(0);      \
        LDFRAG(2, afA, bfA); __builtin_amdgcn_sched_barrier(0); MFMA4(afB, bfB); __builtin_amdgcn_sched_barrier(0);      \
        LDFRAG(3, afB, bfB); __builtin_amdgcn_sched_barrier(0); MFMA4(afA, bfA); __builtin_amdgcn_sched_barrier(0);      \
        MFMA4(afB, bfB);                                                                                                \
    }
    if (!preloaded) { LOADSET(x, 0, cur); if (nkt > 1) LOADSET(y, 1, cur); }
    WAITSET(x, nkt > 1);
    __syncthreads();
    STORESET(x, 0);
    if (nkt > 2) LOADSET(x, 2, cur);
    __syncthreads();
    for (int kt = 0; kt < nkt; kt += 2) {
        if (kt + 1 < nkt) { WAITSET(y, kt + 2 < nkt); STORESET(y, 1); if (kt + 3 < nkt) LOADSET(y, kt + 3, cur); }
        MFMA_STAGE(0);
        __syncthreads();
        if (kt + 1 >= nkt) break;
        if (kt + 2 < nkt) { WAITSET(x, kt + 3 < nkt); STORESET(x, 0); if (kt + 4 < nkt) LOADSET(x, kt + 4, cur); }
        MFMA_STAGE(1);
        __syncthreads();
    }
    if (has_next) { LOADSET(x, 0, nxt); if (nkt > 1) LOADSET(y, 1, nxt); }
#undef MFMA_STAGE
#undef MFMA4
#undef LDFRAG
#undef STORESET
#undef WAITSET
#undef LOADSET
#undef BBASE
#undef PIN4
#undef GLD
    float* T = (float*)smem;
#pragma unroll
    for (int i = 0; i < 2; ++i)
#pragma unroll
        for (int r = 0; r < 16; ++r) {
            const int lr = wm * 64 + i * 32 + (r & 3) + 8 * (r >> 2) + 4 * (lane >> 5);
            if (DUAL) { const float g = acc[i][0][r]; T[lr * GT_P + wn * 32 + (lane & 31)] = g * fsigmoid(g) * acc[i][1][r]; }
            else { T[lr * GT_P + wn * 64 + (lane & 31)] = acc[i][0][r]; T[lr * GT_P + wn * 64 + 32 + (lane & 31)] = acc[i][1][r]; }
        }
    __syncthreads();
    constexpr int CPR = DUAL ? 16 : 32, EB = 4;
    const int c4 = (tid % CPR) * 4;
#pragma unroll 1
    for (int q0 = 0; q0 < 128 * CPR / 256; q0 += EB) {
        EpiLd ld[EB]; float4 tv[EB];
#pragma unroll
        for (int k = 0; k < EB; ++k) ld[k] = ldf((tid + 256 * (q0 + k)) / CPR, c4);
#pragma unroll
        for (int k = 0; k < EB; ++k) tv[k] = *(const float4*)(T + ((tid + 256 * (q0 + k)) / CPR) * GT_P + c4);
        __builtin_amdgcn_sched_barrier(0);
#pragma unroll
        for (int k = 0; k < EB; ++k) epi((tid + 256 * (q0 + k)) / CPR, c4, tv[k], ld[k], T);
    }
    __syncthreads();
}

__device__ __forceinline__ EpiLd rope_ld(int d, int tpos, const float2* __restrict__ ROPE) {
    const int pos = (d & 32) ? (tpos & 63) : (tpos >> 6);
    EpiLd l; l.a = *(const float4*)(ROPE + pos * 16 + (d & 15)); l.b = *(const float4*)(ROPE + pos * 16 + (d & 15) + 2);
    return l;
}
__device__ __forceinline__ float4 rope4(float4 v, float4 o  , int d, const EpiLd& cs) {
    const float4 cs01 = cs.a, cs23 = cs.b;
    float4 r;
    if (d & 16) { r.x = o.x * cs01.y + v.x * cs01.x; r.y = o.y * cs01.w + v.y * cs01.z; r.z = o.z * cs23.y + v.z * cs23.x; r.w = o.w * cs23.w + v.w * cs23.z; }
    else { r.x = v.x * cs01.x - o.x * cs01.y; r.y = v.y * cs01.z - o.y * cs01.w; r.z = v.z * cs23.x - o.z * cs23.y; r.w = v.w * cs23.z - o.w * cs23.w; }
    return r;
}
template <int MODE>
__device__ __forceinline__ void phase_gemm_dense(const Params& p, int tid, int layer, const half_t* A, const half_t* W, int N, int bid, int nb, unsigned char* smem) {
    const int ntn = N / 128, ntiles = (M / 128) * ntn;
    float* XS = wsp<float>(p, WS_XS);
    half_t* Q16 = wsp<half_t>(p, WS_Q16); half_t* K16 = wsp<half_t>(p, WS_K16); half_t* V16 = wsp<half_t>(p, WS_V16);
    half_t* RW = wsp<half_t>(p, WS_RW32);
    const float2* ROPE = wsp<float2>(p, WS_ROPE);
    const int e = layer >> 1;
    const bool xcd_order = (nb & 7) == 0;
    const int nper = 18 * ntn, nslot = nb >> 3;
    const int cv_total = (MOE_CV_CHUNKS + nb * NT - 1) / (nb * NT);
    int cv_done = 0;
    auto tile_of = [=](int it, int& tm, int& tn) -> bool {
        if (xcd_order) {
            const int L = it * nslot + (bid >> 3);
            if (L >= nper) return false;
            const int mg = L / (6 * ntn), rem = L - mg * 6 * ntn;
            tn = rem / 6; tm = (bid & 7) * 18 + mg * 6 + (rem - tn * 6);
        } else {
            const int tile = it * nb + bid;
            if (tile >= ntiles) return false;
            tm = tile / ntn; tn = tile % ntn;
        }
        return true;
    };
    auto make_src = [=](int tm, int tn) -> TileSrc {
        TileSrc T; T.A = A; T.B0 = W + tn * 128; T.B1 = nullptr;
        const int m0 = tm * 128;
        tile_aoff(T, [=](int i) -> long { return m0 + i; }, 1024, tid);
        return T;
    };
    GemmRegs R;
    int tm = 0, tn = 0;
    bool have = tile_of(0, tm, tn), pre = false;
    TileSrc cur = make_src(tm, tn);
    for (int it = 0; have; ++it) {
        int tm2 = 0, tn2 = 0;
        const bool hn = tile_of(it + 1, tm2, tn2);
        const TileSrc nx = make_src(tm2, tn2);
        const int m0 = tm * 128, n0 = tn * 128;
        const int s0 = m0 % SEQA;
        const bool lat = s0 >= NCTX;
        const int jc = (tid & 31) * 4;
        const EpiLd noload = {make_float4(0.f, 0.f, 0.f, 0.f), make_float4(0.f, 0.f, 0.f, 0.f)};
        if (MODE == 1) {
            const float4 g = *(const float4*)(mods_ptr(p, layer, mods_row(m0), 2) + n0 + jc);
            auto ldf = [=](int i, int j) -> EpiLd { EpiLd l; l.a = *(const float4*)(XS + (size_t)(m0 + i) * 1024 + n0 + j); l.b = l.a; return l; };
            auto epi = [=](int i, int j, float4 v, const EpiLd& l, const float*) {
                float4 x = l.a;
                x.x += g.x * v.x; x.y += g.y * v.y; x.z += g.z * v.z; x.w += g.w * v.w;
                *(float4*)(XS + (size_t)(m0 + i) * 1024 + n0 + j) = x;
            };
            gemm_tile_mfma<false>(cur, nx, hn, pre, R, N, 1024, ldf, epi, smem, tid);
        } else if (MODE == 2) {
            const int region = tn >> 3;
            half_t* dstb = (region == 0 ? Q16 : region == 1 ? K16 : V16) + (n0 & 1023);
            const bool dorope = region < 2 && lat;
            auto ldf = [=](int i, int j) -> EpiLd { return dorope ? rope_ld(j & 63, s0 - NCTX + i, ROPE) : noload; };
            auto epi = [=](int i, int j, float4 v, const EpiLd& l, const float* T) {
                if (dorope) v = rope4(v, *(const float4*)(T + i * GT_P + (j ^ 16)), j & 63, l);
                if (region == 0) { v.x *= QSCALE; v.y *= QSCALE; v.z *= QSCALE; v.w *= QSCALE; }
                *(h4_t*)(dstb + (size_t)(m0 + i) * 1024 + j) = to_h4(v);
            };
            gemm_tile_mfma<false>(cur, nx, hn, pre, R, N, 1024, ldf, epi, smem, tid);
        } else {
            const float* gain = (tn == 4 ? p.ev_k_gain : p.ev_q_gain) + e * 64;
            const float4 g = *(const float4*)(gain + (jc & 63)), go = *(const float4*)(gain + ((jc & 63) ^ 16));
            const bool dorope = tn < 5 && lat;
            auto ldf = [=](int i, int j) -> EpiLd { return dorope ? rope_ld(j & 63, s0 - NCTX + i, ROPE) : noload; };
            auto epi = [=](int i, int j, float4 v, const EpiLd& l, const float* T) {
                const int r = m0 + i;
                if (tn >= 6) *(h4_t*)(RW + (size_t)r * 1792 + (n0 - 768) + j) = to_h4(v);
                else if (tn == 5) *(h4_t*)(V16 + (size_t)r * 128 + (n0 - 640) + j) = to_h4(v);
                else {
                    const int d = j & 63;
                    const float ss = sum16(v.x * v.x + v.y * v.y + v.z * v.z + v.w * v.w);
                    const float rstd = rsqrtf(ss * (1.f / 64.f) + 1e-6f);
                    v.x *= rstd * g.x; v.y *= rstd * g.y; v.z *= rstd * g.z; v.w *= rstd * g.w;
                    if (lat) {
                        float4 o = *(const float4*)(T + i * GT_P + (j ^ 16));
                        o.x *= rstd * go.x; o.y *= rstd * go.y; o.z *= rstd * go.z; o.w *= rstd * go.w;
                        v = rope4(v, o, d, l);
                    }
                    if (tn == 4) *(h4_t*)(K16 + (size_t)r * 128 + (n0 - 512) + j) = to_h4(v);
                    else { v.x *= QSCALE; v.y *= QSCALE; v.z *= QSCALE; v.w *= QSCALE; *(h4_t*)(Q16 + (size_t)r * 512 + n0 + j) = to_h4(v); }
                }
            };
            gemm_tile_mfma<false>(cur, nx, hn, pre, R, N, 1024, ldf, epi, smem, tid);
        }
        if (MODE >= 2) { const int q1 = cv_done + 8 < cv_total ? cv_done + 8 : cv_total; convert_moe_steps(smem + LDS_BYTES + 16, layer, tid, bid, nb, cv_done, q1); cv_done = q1; }
        cur = nx; tm = tm2; tn = tn2; have = hn; pre = hn;
    }
    if (MODE >= 2) convert_moe_steps(smem + LDS_BYTES + 16, layer, tid, bid, nb, cv_done, cv_total);
}

__device__ __forceinline__ void phase_prep_even(const Params& p, int tid, int layer, int bid, int nb, unsigned char* smem) {
    constexpr int TK = 16;
    const int e = layer >> 1;
    float* vbuf = (float*)smem;
    float* t1 = vbuf + TK * 512;
    float* t1p = t1 + TK * 32;
    const int t = tid, wid = t >> 6, lane = t & 63;
    const half_t* RW = wsp<half_t>(p, WS_RW32);
    half_t* SR = wsp<half_t>(p, WS_SR); half_t* SV = wsp<half_t>(p, WS_SV); half_t* SKK = wsp<half_t>(p, WS_SKK); half_t* SK = wsp<half_t>(p, WS_SK);
    half_t* VF = wsp<half_t>(p, WS_VF); half_t* LIN = wsp<half_t>(p, WS_LIN16);
    float* mus = t1p + 8 * TK * 32;
    for (int i = t; i < 2 * 1792; i += NT) mus[i] = i < 1792 ? p.ev_mu_prev[e * 1792 + i] : p.ev_mu_next[e * 1792 + i - 1792];
    __syncthreads();
    const float4* MUP = (const float4*)mus + lane; const float4* MUN = (const float4*)(mus + 1792) + lane;
    const float4 kk0 = *(const float4*)(p.ev_k_k + e * 512 + lane * 4), kk1 = *(const float4*)(p.ev_k_k + e * 512 + 256 + lane * 4);
    for (int item = bid; item < M / TK; item += nb) {
        const int r0 = item * TK;
#pragma unroll 1
        for (int q4 = 0; q4 < TK / 4; ++q4) {
            const int tok = q4 * 4 + wid, r = r0 + tok, s = r % SEQA;
            const float fp = (s != 0 && s != NCTX) ? 1.f : 0.f, fn = (s != NCTX - 1 && s != SEQA - 1) ? 1.f : 0.f;
            const h4_t* row = (const h4_t*)(RW + (size_t)r * 1792) + lane;
            const h4_t* rowp = (const h4_t*)(RW + (size_t)(r > 0 ? r - 1 : 0) * 1792) + lane;
            const h4_t* rown = (const h4_t*)(RW + (size_t)(r < M - 1 ? r + 1 : M - 1) * 1792) + lane;
            h4_t ch[7], ph[7], nh[7];
#pragma unroll
            for (int q = 0; q < 7; ++q) { ch[q] = row[64 * q]; ph[q] = rowp[64 * q]; nh[q] = rown[64 * q]; }
            __builtin_amdgcn_sched_barrier(0);
            float4 c[7], pv[7], nx[7];
#pragma unroll
            for (int q = 0; q < 7; ++q) { c[q] = from_h4(ch[q]); pv[q] = from_h4(ph[q]); nx[q] = from_h4(nh[q]); }
#pragma unroll
            for (int q = 0; q < 7; ++q) {
                pv[q].x *= fp; pv[q].y *= fp; pv[q].z *= fp; pv[q].w *= fp;
                nx[q].x *= fn; nx[q].y *= fn; nx[q].z *= fn; nx[q].w *= fn;
            }
            float4 u[7];
#pragma unroll
            for (int q = 0; q < 7; ++q) {
                const float4 mp = MUP[64 * q], mn = MUN[64 * q];
                u[q].x = c[q].x + mp.x * (pv[q].x - c[q].x) + mn.x * (nx[q].x - c[q].x); u[q].y = c[q].y + mp.y * (pv[q].y - c[q].y) + mn.y * (nx[q].y - c[q].y);
                u[q].z = c[q].z + mp.z * (pv[q].z - c[q].z) + mn.z * (nx[q].z - c[q].z); u[q].w = c[q].w + mp.w * (pv[q].w - c[q].w) + mn.w * (nx[q].w - c[q].w);
            }
            const size_t o = (size_t)r * 512 + lane * 4;
            *(h4_t*)(SR + o) = to_h4(u[0]); *(h4_t*)(SR + o + 256) = to_h4(u[1]);
            *(h4_t*)(SK + o) = to_h4(u[2]); *(h4_t*)(SK + o + 256) = to_h4(u[3]);
            {
                float4 a = make_float4(u[2].x * kk0.x, u[2].y * kk0.y, u[2].z * kk0.z, u[2].w * kk0.w), b2 = make_float4(u[3].x * kk1.x, u[3].y * kk1.y, u[3].z * kk1.z, u[3].w * kk1.w);
                const float na = 1.f / fmaxf(sqrtf(sum16(a.x * a.x + a.y * a.y + a.z * a.z + a.w * a.w)), 1e-12f);
                const float nb2 = 1.f / fmaxf(sqrtf(sum16(b2.x * b2.x + b2.y * b2.y + b2.z * b2.z + b2.w * b2.w)), 1e-12f);
                *(h4_t*)(SKK + o) = to_h4(make_float4(a.x * na, a.y * na, a.z * na, a.w * na));
                *(h4_t*)(SKK + o + 256) = to_h4(make_float4(b2.x * nb2, b2.y * nb2, b2.z * nb2, b2.w * nb2));
            }
            if (e == 0) { const h4_t v4 = to_h4(u[4]), v5 = to_h4(u[5]); *(h4_t*)(SV + o) = v4; *(h4_t*)(SV + o + 256) = v5; *(h4_t*)(VF + o) = v4; *(h4_t*)(VF + o + 256) = v5; }
            else { *(float4*)(vbuf + tok * 512 + lane * 4) = u[4]; *(float4*)(vbuf + tok * 512 + 256 + lane * 4) = u[5]; }
            {
                float4 x = u[6];
                if (lane < 16) { x.x = tanhf(x.x); x.y = tanhf(x.y); x.z = tanhf(x.z); x.w = tanhf(x.w); }
                else if (lane >= 32) { x.x = sigmoidf_(x.x); x.y = sigmoidf_(x.y); x.z = sigmoidf_(x.z); x.w = sigmoidf_(x.w); }
                *(h4_t*)(LIN + (size_t)r * 256 + lane * 4) = to_h4(x);
            }
        }
        if (e > 0) {
            __syncthreads();
            {
                const int j = t & 31, cg = t >> 5;
                const float* v1 = p.ev_v1 + (size_t)(e - 1) * 512 * 32 + (size_t)cg * 64 * 32 + j;
                float acc[TK];
#pragma unroll
                for (int tok = 0; tok < TK; ++tok) acc[tok] = 0.f;
#pragma unroll 2
                for (int cc = 0; cc < 64; cc += 8) {
                    float w[8];
#pragma unroll
                    for (int k = 0; k < 8; ++k) w[k] = v1[(cc + k) * 32];
#pragma unroll
                    for (int tok = 0; tok < TK; ++tok) {
                        const float4 xa = *(const float4*)(vbuf + tok * 512 + cg * 64 + cc), xb = *(const float4*)(vbuf + tok * 512 + cg * 64 + cc + 4);
                        acc[tok] += xa.x * w[0] + xa.y * w[1] + xa.z * w[2] + xa.w * w[3] + xb.x * w[4] + xb.y * w[5] + xb.z * w[6] + xb.w * w[7];
                    }
                }
#pragma unroll
                for (int tok = 0; tok < TK; ++tok) t1p[(cg * TK + tok) * 32 + j] = acc[tok];
            }
            __syncthreads();
            for (int o2 = t; o2 < TK * 32; o2 += NT) {
                float a = 0.f;
#pragma unroll
                for (int g = 0; g < 8; ++g) a += t1p[g * TK * 32 + o2];
                t1[o2] = a;
            }
            __syncthreads();
#pragma unroll
            for (int jj = 0; jj < 2; ++jj) {
                const int c = t + 256 * jj;
                const float* v2 = p.ev_v2 + (size_t)(e - 1) * 32 * 512 + c;
                const float v0 = p.ev_v0[(e - 1) * 512 + c];
                float z[TK];
#pragma unroll
                for (int tok = 0; tok < TK; ++tok) z[tok] = v0;
#pragma unroll 2
                for (int j = 0; j < 32; j += 4) {
                    const float w0 = v2[j * 512], w1 = v2[(j + 1) * 512], w2 = v2[(j + 2) * 512], w3 = v2[(j + 3) * 512];
#pragma unroll
                    for (int tok = 0; tok < TK; ++tok) { const float4 tt = *(const float4*)(t1 + tok * 32 + j); z[tok] += tt.x * w0 + tt.y * w1 + tt.z * w2 + tt.w * w3; }
                }
#pragma unroll
                for (int tok = 0; tok < TK; ++tok) {
                    const size_t o = (size_t)(r0 + tok) * 512 + c;
                    const float vv = vbuf[tok * 512 + c];
                    SV[o] = (half_t)(vv + ((float)VF[o] - vv) * sigmoidf_(z[tok]));
                }
            }
            __syncthreads();
        }
    }
}

__device__ __forceinline__ void phase_lora(const Params& p, int tid, int layer, int bid, int nb, unsigned char* smem) {
    const int e = layer >> 1;
    const half_t* LIN = wsp<half_t>(p, WS_LIN16);
    float* SW = wsp<float>(p, WS_SW); half_t* SA = wsp<half_t>(p, WS_SA); half_t* G = wsp<half_t>(p, WS_G);
    constexpr int NTILE = (M / 128) * 4;
    GemmRegs R;
    for (int item = bid; item < 5 * NTILE; item += nb) {
        const int job = item / NTILE, tile = item % NTILE, tm = tile >> 2, tn = tile & 3, m0 = tm * 128, n0 = tn * 128;
        auto rowsrc = [=](int i) -> long { return m0 + i; };
        if (job < 4) {
            const int dr = job & 1;
            const bool isw = job < 2;
            const half_t* W = wsp<half_t>(p, WS_W16) + (isw ? W16_W2 : W16_A2) + ((size_t)(e * 2 + dr) * 64) * 512 + n0;
            const float* bias = (isw ? p.ev_w0 : p.ev_a0) + (e * 2 + dr) * 512 + n0;
            float* dstw = SW + (size_t)dr * M * 512 + n0; half_t* dsta = SA + (size_t)dr * M * 512 + n0;
            TileSrc T; T.A = LIN + (isw ? 0 : 64); T.B0 = W; T.B1 = nullptr; tile_aoff(T, rowsrc, 256, tid);
            const float4 b = *(const float4*)(bias + (tid & 31) * 4);
            auto ldf = [=](int, int) -> EpiLd { return EpiLd{make_float4(0.f, 0.f, 0.f, 0.f), make_float4(0.f, 0.f, 0.f, 0.f)}; };
            auto epi = [=](int i, int j, float4 v, const EpiLd&, const float*) {
                float4 o; o.x = fsigmoid(b.x + v.x); o.y = fsigmoid(b.y + v.y); o.z = fsigmoid(b.z + v.z); o.w = fsigmoid(b.w + v.w);
                if (isw) {
                    constexpr float C = -DECAY_SCALE * 1.4426950408889634f;
                    o.x = __builtin_amdgcn_exp2f(C * o.x); o.y = __builtin_amdgcn_exp2f(C * o.y); o.z = __builtin_amdgcn_exp2f(C * o.z); o.w = __builtin_amdgcn_exp2f(C * o.w);
                }
                if (isw) *(float4*)(dstw + (size_t)(m0 + i) * 512 + j) = o; else *(h4_t*)(dsta + (size_t)(m0 + i) * 512 + j) = to_h4(o);
            };
            gemm_tile_mfma<false>(T, T, false, false, R, 512, 64, ldf, epi, smem, tid);
        } else {
            const half_t* W = wsp<half_t>(p, WS_W16) + W16_G2 + (size_t)e * 128 * 512 + n0;
            TileSrc T; T.A = LIN + 128; T.B0 = W; T.B1 = nullptr; tile_aoff(T, rowsrc, 256, tid);
            auto ldf = [=](int, int) -> EpiLd { return EpiLd{make_float4(0.f, 0.f, 0.f, 0.f), make_float4(0.f, 0.f, 0.f, 0.f)}; };
            auto epi = [=](int i, int j, float4 v, const EpiLd&, const float*) { *(h4_t*)(G + (size_t)(m0 + i) * 512 + n0 + j) = to_h4(v); };
            gemm_tile_mfma<false>(T, T, false, false, R, 512, 128, ldf, epi, smem, tid);
        }
    }
}

template <int MODE>
__device__ __forceinline__ void phase_attn_mfma(const Params& p, int tid, int bid, int nb, unsigned char* smem) {
    constexpr int DV = MODE == 0 ? 64 : 128, NDT = DV / 32, VRS = MODE == 0 ? 192 : 320, KCS = 1040, VCH = DV / 8, NVJ = VCH * 64 / 256;
    unsigned char* sK = smem;
    unsigned char* sV = smem + 8 * KCS;
    const int lane = tid & 63, wid = tid >> 6, h5 = lane >> 5, l31 = lane & 31;
    constexpr int NH = MODE == 0 ? 8 : 16;
    constexpr int NLATU = 8 * NH * 16, NU = NLATU + 8 * NH * 2;
    const half_t* Q16 = wsp<half_t>(p, WS_Q16); const half_t* K16 = wsp<half_t>(p, WS_K16); const half_t* V16 = wsp<half_t>(p, WS_V16);
    constexpr int qstride = MODE == 0 ? 512 : 1024, kstride = MODE == 0 ? 128 : 1024;
    for (int u = bid; u < NU; u += nb) {
        int b, hh, qrow0, nkeys;
        if (u < NLATU) { b = u / (NH * 16); const int rem = u % (NH * 16); hh = rem >> 4; qrow0 = b * SEQA + NCTX + (rem & 15) * 128; nkeys = SEQA; }
        else { const int v = u - NLATU; b = v / (NH * 2); const int rem = v % (NH * 2); hh = rem >> 1; qrow0 = b * SEQA + (rem & 1) * 128; nkeys = NCTX; }
        const int qoff = MODE == 0 ? hh * 64 : (hh >> 1) * 128 + (hh & 1) * 64;
        const int koff = MODE == 0 ? (hh >> 2) * 64 : qoff;
        const int voff = MODE == 0 ? (hh >> 2) * 64 : (hh >> 1) * 128;
        const size_t kbase = (size_t)b * SEQA;
        h8_t qf[4];
        {
            const half_t* qp = Q16 + (size_t)(qrow0 + wid * 32 + l31) * qstride + qoff + 8 * h5;
#pragma unroll
            for (int ks = 0; ks < 4; ++ks) qf[ks] = *(const h8_t*)(qp + 16 * ks);
        }
        f32x16_t o[NDT];
#pragma unroll
        for (int dt = 0; dt < NDT; ++dt)
#pragma unroll
            for (int r = 0; r < 16; ++r) o[dt][r] = 0.f;
        float mref = 0.f, lrun = 0.f;
        h8_t rk[2], rv[NVJ];
#define ATT_LOAD(kt)                                                                                                         \
        {                                                                                                                    \
            _Pragma("unroll") for (int j = 0; j < 2; ++j) { const int i_ = tid + 256 * j;                                     \
                rk[j] = *(const h8_t*)(K16 + (kbase + (kt) * 64 + (i_ >> 3)) * kstride + koff + (i_ & 7) * 8); }              \
            _Pragma("unroll") for (int j = 0; j < NVJ; ++j) { const int i_ = tid + 256 * j;                                   \
                rv[j] = *(const h8_t*)(V16 + (kbase + (kt) * 64 + (i_ / VCH)) * kstride + voff + (i_ % VCH) * 8); }           \
        }
        const int ntile = nkeys >> 6;
        ATT_LOAD(0);
        for (int kt = 0; kt < ntile; ++kt) {
            __syncthreads();
#pragma unroll
            for (int j = 0; j < 2; ++j) { const int i_ = tid + 256 * j; *(h8_t*)(sK + (i_ & 7) * KCS + (i_ >> 3) * 16) = rk[j]; }
#pragma unroll
            for (int j = 0; j < NVJ; ++j) { const int i_ = tid + 256 * j; *(h8_t*)(sV + (i_ / VCH) * VRS + (i_ % VCH) * 16) = rv[j]; }
            __syncthreads();
            if (kt + 1 < ntile) ATT_LOAD(kt + 1);
            f32x16_t sc[2];
#pragma unroll
            for (int kh = 0; kh < 2; ++kh)
#pragma unroll
                for (int r = 0; r < 16; ++r) sc[kh][r] = -mref;
#pragma unroll
            for (int ks = 0; ks < 4; ++ks)
#pragma unroll
                for (int kh = 0; kh < 2; ++kh) {
                    const h8_t kf = *(const h8_t*)(sK + (2 * ks + h5) * KCS + (kh * 32 + l31) * 16);
                    sc[kh] = __builtin_amdgcn_mfma_f32_32x32x16_f16(kf, qf[ks], sc[kh], 0, 0, 0);
                }
            float tmax = sc[0][0];
#pragma unroll
            for (int r = 1; r < 16; ++r) tmax = fmaxf(tmax, sc[0][r]);
#pragma unroll
            for (int r = 0; r < 16; ++r) tmax = fmaxf(tmax, sc[1][r]);
            if (kt == 0 || __any(tmax > 6.0f)) {
                tmax = fmaxf(tmax, __shfl_xor(tmax, 32, 64));
                const float delta = kt == 0 ? tmax : fmaxf(tmax, 0.f);
                const float alpha = kt == 0 ? 1.f : __builtin_amdgcn_exp2f(-delta);
                mref += delta;
                lrun *= alpha;
#pragma unroll
                for (int dt = 0; dt < NDT; ++dt)
#pragma unroll
                    for (int r = 0; r < 16; ++r) o[dt][r] *= alpha;
#pragma unroll
                for (int kh = 0; kh < 2; ++kh)
#pragma unroll
                    for (int r = 0; r < 16; ++r) sc[kh][r] -= delta;
            }
            float psum = 0.f;
#pragma unroll
            for (int kh = 0; kh < 2; ++kh)
#pragma unroll
                for (int r = 0; r < 16; ++r) { const float pv = __builtin_amdgcn_exp2f(sc[kh][r]); sc[kh][r] = pv; psum += pv; }
            lrun += psum;
#pragma unroll
            for (int kh = 0; kh < 2; ++kh)
#pragma unroll
                for (int s2 = 0; s2 < 2; ++s2) {
                    h8_t pf;
#pragma unroll
                    for (int j = 0; j < 8; ++j) pf[j] = (half_t)sc[kh][8 * s2 + j];
                    const int row0 = kh * 32 + 16 * s2 + 4 * h5 + ((lane & 15) >> 2);
#pragma unroll
                    for (int dt = 0; dt < NDT; ++dt) {
                        const int col = dt * 32 + 16 * ((lane >> 4) & 1) + 4 * (lane & 3);
                        const s16x4_t lo = __builtin_amdgcn_ds_read_tr16_b64_v4i16((LAS s16x4_t*)(sV + row0 * VRS + col * 2));
                        const s16x4_t hi = __builtin_amdgcn_ds_read_tr16_b64_v4i16((LAS s16x4_t*)(sV + (row0 + 8) * VRS + col * 2));
                        s16x8_t v8; v8[0] = lo[0]; v8[1] = lo[1]; v8[2] = lo[2]; v8[3] = lo[3]; v8[4] = hi[0]; v8[5] = hi[1]; v8[6] = hi[2]; v8[7] = hi[3];
                        o[dt] = __builtin_amdgcn_mfma_f32_32x32x16_f16(__builtin_bit_cast(h8_t, v8), pf, o[dt], 0, 0, 0);
                    }
                }
        }
#undef ATT_LOAD
        const float ltot = lrun + __shfl_xor(lrun, 32, 64);
        const float inv = 1.f / ltot;
        const int qrow = qrow0 + wid * 32 + l31;
#pragma unroll
        for (int dt = 0; dt < NDT; ++dt)
#pragma unroll
            for (int rg = 0; rg < 4; ++rg) {
                const int d0 = dt * 32 + 8 * rg + 4 * h5;
                if (MODE == 0) {
                    h4_t ov; ov.x = (half_t)(o[dt][4 * rg + 0] * inv); ov.y = (half_t)(o[dt][4 * rg + 1] * inv); ov.z = (half_t)(o[dt][4 * rg + 2] * inv); ov.w = (half_t)(o[dt][4 * rg + 3] * inv);
                    *(h4_t*)(wsp<half_t>(p, WS_MIX16) + (size_t)qrow * 1024 + hh * 64 + d0) = ov;
                } else {
                    const float4 ov = make_float4(o[dt][4 * rg + 0] * inv, o[dt][4 * rg + 1] * inv, o[dt][4 * rg + 2] * inv, o[dt][4 * rg + 3] * inv);
                    *(h4_t*)(wsp<half_t>(p, WS_ATT32) + (((size_t)qrow * 8 + (hh >> 1)) * 2 + (hh & 1)) * 128 + d0) = to_h4(ov);
                }
            }
    }
}

__device__ __forceinline__ void phase_diff_finish(const Params& p, int tid, int layer, int bid, int nb) {
    const int o = layer >> 1, wid = tid >> 6, lane = tid & 63, l31 = lane & 31;
    const float linit = 0.8f - 0.6f * expf(-0.3f * (float)layer);
    const float d1 = wave_sum(p.od_lq1[o * 64 + lane] * p.od_lk1[o * 64 + lane]);
    const float d2 = wave_sum(p.od_lq2[o * 64 + lane] * p.od_lk2[o * 64 + lane]);
    const float lam = expf(d1) - expf(d2) + linit;
    const float4 sl = *(const float4*)(p.od_subln + o * 128 + l31 * 4);
    const half_t* ATT = wsp<half_t>(p, WS_ATT32);
    half_t* MIX = wsp<half_t>(p, WS_MIX16);
    for (int task = bid * 4 + wid; task < M * 4; task += nb * 4) {
        const int r = task >> 2, h = (task & 3) * 2 + (lane >> 5);
        const half_t* a = ATT + ((size_t)r * 8 + h) * 256 + l31 * 4;
        const h4_t x0h = *(const h4_t*)a, x1h = *(const h4_t*)(a + 128);
        const float4 x0 = from_h4(x0h), x1 = from_h4(x1h);
        const float4 v = make_float4(x0.x - lam * x1.x, x0.y - lam * x1.y, x0.z - lam * x1.z, x0.w - lam * x1.w);
        float ss = sum16(v.x * v.x + v.y * v.y + v.z * v.z + v.w * v.w);
        ss += __shfl_xor(ss, 16, 64);
        const float sc = rsqrtf(ss * (1.f / 128.f) + 1e-5f) * (1.f - linit);
        *(h4_t*)(MIX + (size_t)r * 1024 + h * 128 + l31 * 4) = to_h4(make_float4(v.x * sc * sl.x, v.y * sc * sl.y, v.z * sc * sl.z, v.w * sc * sl.w));
    }
}

__device__ __forceinline__ void phase_scan(const Params& p, int tid, int layer, int bid, int nb, unsigned char* smem) {
    const int e = layer >> 1;
    constexpr int CH = 32;
    float* lds = (float*)smem;
    float* Lw = lds;
    float* Lv = lds + 5 * CH * 64;
    float* Ly = Lv + CH * 16;
    const int t = tid, wid = t >> 6, lane = t & 63, rloc = lane >> 4, kq = lane & 15;
    for (int item = bid; item < 512; item += nb) {
        const int chain = item >> 2, rq = item & 3, dir = chain & 1, bh = chain >> 1, b = bh >> 3, h = bh & 7;
        const size_t rowbase = (size_t)b * SEQA;
        const float* SWp = wsp<float>(p, WS_SW) + (size_t)dir * M * 512;
        const half_t* SAp = wsp<half_t>(p, WS_SA) + (size_t)dir * M * 512;
        const half_t* SKp = wsp<half_t>(p, WS_SK); const half_t* SQp = wsp<half_t>(p, WS_SKK); const half_t* SRp = wsp<half_t>(p, WS_SR);
        const half_t* SV = wsp<half_t>(p, WS_SV);
        half_t* YS = wsp<half_t>(p, WS_YSC) + (size_t)dir * M * 512;
        auto tok_of = [=](int i) -> int { return dir == 0 ? i : (i < NCTX ? (NCTX - 1 - i) : (SEQA + NCTX - 1 - i)); };
        const int lf4 = t & 15, lst = t >> 4;
        const float4 ka4 = *(const float4*)(p.ev_k_a + e * 512 + h * 64 + lf4 * 4);
        float4 pw0, pw1; h4_t pa0, pk0, pq0, pr0, pa1, pk1, pq1, pr1, prev;
        pw0 = pw1 = make_float4(0, 0, 0, 0); pa0 = pk0 = pq0 = pr0 = pa1 = pk1 = pq1 = pr1 = prev = (h4_t){0, 0, 0, 0};
#define SCAN_LDP(cc, sto, W_, A_, K_, Q_, R_)                                                                                      \
        {                                                                                                                          \
            const size_t off = (rowbase + tok_of((cc) * CH + lst + (sto))) * 512 + h * 64 + lf4 * 4;                                \
            W_ = *(const float4*)(SWp + off);                                                                                      \
            A_ = *(const h4_t*)(SAp + off);                                                                                        \
            K_ = *(const h4_t*)(SKp + off);                                                                                        \
            Q_ = *(const h4_t*)(SQp + off);                                                                                        \
            R_ = *(const h4_t*)(SRp + off);                                                                                        \
        }
#define SCAN_ISSUE(cc)                                                                                                             \
        {                                                                                                                          \
            SCAN_LDP(cc, 0, pw0, pa0, pk0, pq0, pr0) SCAN_LDP(cc, 16, pw1, pa1, pk1, pq1, pr1)                                      \
            if (t < 128) { const int st = t >> 2, f4 = t & 3; const size_t row = rowbase + tok_of((cc) * CH + st);                  \
                prev = *(const h4_t*)(SV + row * 512 + h * 64 + rq * 16 + f4 * 4); }                                                \
        }
#define SCAN_STP(sto, W_, Ah_, Kh_, Qh_, Rh_)                                                                                      \
        {                                                                                                                          \
            const float4 A_ = from_h4(Ah_), K_ = from_h4(Kh_), Q_ = from_h4(Qh_);                                                   \
            float* d_ = Lw + (lst + (sto)) * 64 + lf4 * 4;                                                                         \
            *(float4*)(d_) = W_;                                                                                                   \
            *(float4*)(d_ + CH * 64) = make_float4(Q_.x * A_.x, Q_.y * A_.y, Q_.z * A_.z, Q_.w * A_.w);                             \
            *(float4*)(d_ + 2 * CH * 64) = make_float4(K_.x * (1.f + (A_.x - 1.f) * ka4.x), K_.y * (1.f + (A_.y - 1.f) * ka4.y),    \
                                                      K_.z * (1.f + (A_.z - 1.f) * ka4.z), K_.w * (1.f + (A_.w - 1.f) * ka4.w));    \
            *(float4*)(d_ + 3 * CH * 64) = Q_;                                                                                     \
            *(float4*)(d_ + 4 * CH * 64) = from_h4(Rh_);                                                                           \
        }
#define SCAN_COMMIT()                                                                                                              \
        {                                                                                                                          \
            SCAN_STP(0, pw0, pa0, pk0, pq0, pr0) SCAN_STP(16, pw1, pa1, pk1, pq1, pr1)                                              \
            if (t < 128) { const int st = t >> 2, f4 = t & 3; *(float4*)(Lv + st * 16 + f4 * 4) = from_h4(prev); }                  \
        }
        typedef float f32x2_t __attribute__((ext_vector_type(2)));
        f32x2_t S01 = {0.f, 0.f}, S23 = {0.f, 0.f};
        SCAN_ISSUE(0);
        SCAN_COMMIT();
        __syncthreads();
        for (int c = 0; c < SEQA / CH; ++c) {
            if (c + 1 < SEQA / CH) SCAN_ISSUE(c + 1);
            float4 nw4 = *(const float4*)(Lw + 0 * CH * 64 + kq * 4), nb4 = *(const float4*)(Lw + 1 * CH * 64 + kq * 4), nd4 = *(const float4*)(Lw + 2 * CH * 64 + kq * 4);
            float4 na4 = *(const float4*)(Lw + 3 * CH * 64 + kq * 4), nr4 = *(const float4*)(Lw + 4 * CH * 64 + kq * 4);
            float nvr = Lv[wid * 4 + rloc];
#pragma unroll 4
            for (int st = 0; st < CH; ++st) {
                const float4 w4 = nw4, b4 = nb4, d4 = nd4, a4 = na4, r4 = nr4;
                const float vr = nvr;
                const int sn = (st + 1 < CH) ? st + 1 : st;
                nw4 = *(const float4*)(Lw + 0 * CH * 64 + sn * 64 + kq * 4);
                nb4 = *(const float4*)(Lw + 1 * CH * 64 + sn * 64 + kq * 4);
                nd4 = *(const float4*)(Lw + 2 * CH * 64 + sn * 64 + kq * 4);
                na4 = *(const float4*)(Lw + 3 * CH * 64 + sn * 64 + kq * 4);
                nr4 = *(const float4*)(Lw + 4 * CH * 64 + sn * 64 + kq * 4);
                nvr = Lv[sn * 16 + wid * 4 + rloc];
                f32x2_t pp = S01 * (f32x2_t){a4.x, a4.y};
                pp = S23 * (f32x2_t){a4.z, a4.w} + pp;
                const float pk = sum16(pp.x + pp.y);
                const f32x2_t t01 = (f32x2_t){d4.x, d4.y} * vr - (f32x2_t){b4.x, b4.y} * pk, t23 = (f32x2_t){d4.z, d4.w} * vr - (f32x2_t){b4.z, b4.w} * pk;
                S01 = S01 * (f32x2_t){w4.x, w4.y} + t01;
                S23 = S23 * (f32x2_t){w4.z, w4.w} + t23;
                f32x2_t yy = S01 * (f32x2_t){r4.x, r4.y};
                yy = S23 * (f32x2_t){r4.z, r4.w} + yy;
                Ly[st * 256 + t] = yy.x + yy.y;
            }
            __syncthreads();
            {
                const int rw = t & 15;
#pragma unroll
                for (int hh = 0; hh < 2; ++hh) {
                    const int st = (t >> 4) + 16 * hh;
                    const float4* pp = (const float4*)(Ly + st * 256 + rw * 16);
                    const float4 a = pp[0], b2 = pp[1], c2 = pp[2], d2 = pp[3];
                    const float y = ((a.x + a.y) + (a.z + a.w)) + ((b2.x + b2.y) + (b2.z + b2.w)) + ((c2.x + c2.y) + (c2.z + c2.w)) + ((d2.x + d2.y) + (d2.z + d2.w));
                    YS[(rowbase + tok_of(c * CH + st)) * 512 + h * 64 + rq * 16 + rw] = (half_t)y;
                }
            }
            if (c + 1 < SEQA / CH) SCAN_COMMIT();
            __syncthreads();
        }
    }
}

__device__ __forceinline__ void phase_readout(const Params& p, int tid, int layer, int bid, int nb) {
    const int e = layer >> 1, wid = tid >> 6, lane = tid & 63;
    const half_t* Y0 = wsp<half_t>(p, WS_YSC); const half_t* Y1 = Y0 + (size_t)M * 512;
    const half_t* SV = wsp<half_t>(p, WS_SV); const half_t* G = wsp<half_t>(p, WS_G);
    const half_t* SR = wsp<half_t>(p, WS_SR); const half_t* SK = wsp<half_t>(p, WS_SK); const half_t* SA0 = wsp<half_t>(p, WS_SA); const half_t* SA1 = SA0 + (size_t)M * 512;
    half_t* MIX = wsp<half_t>(p, WS_MIX16);
    for (int task = bid * 4 + wid; task < M * 2; task += nb * 4) {
        const int r = task >> 1, c = (task & 1) * 256 + lane * 4;
        const size_t o = (size_t)r * 512 + c;
        const h4_t y0h = *(const h4_t*)(Y0 + o), y1h = *(const h4_t*)(Y1 + o);
        const h4_t srh = *(const h4_t*)(SR + o), skh = *(const h4_t*)(SK + o), a0h = *(const h4_t*)(SA0 + o), a1h = *(const h4_t*)(SA1 + o), svh = *(const h4_t*)(SV + o), ggh = *(const h4_t*)(G + o);
        const float4 ka = *(const float4*)(p.ev_k_a + e * 512 + c), rk = *(const float4*)(p.ev_r_k + e * 512 + c);
        const float4 gw = *(const float4*)(p.ev_gn_w + e * 512 + c), gb = *(const float4*)(p.ev_gn_b + e * 512 + c);
        __builtin_amdgcn_sched_barrier(0);
        const float4 y0 = from_h4(y0h), y1 = from_h4(y1h);
        const float4 sr = from_h4(srh), sk = from_h4(skh), a0 = from_h4(a0h), a1 = from_h4(a1h), sv = from_h4(svh), gg = from_h4(ggh);
        const float4 y = make_float4(y0.x + y1.x, y0.y + y1.y, y0.z + y1.z, y0.w + y1.w);
        const float mu = sum16(y.x + y.y + y.z + y.w) * (1.f / 64.f);
        const float4 d = make_float4(y.x - mu, y.y - mu, y.z - mu, y.w - mu);
        const float var = sum16(d.x * d.x + d.y * d.y + d.z * d.z + d.w * d.w) * (1.f / 64.f);
        const float bonus = sum16(sr.x * sk.x * rk.x * (2.f + (a0.x + a1.x - 2.f) * ka.x) + sr.y * sk.y * rk.y * (2.f + (a0.y + a1.y - 2.f) * ka.y)
                                + sr.z * sk.z * rk.z * (2.f + (a0.z + a1.z - 2.f) * ka.z) + sr.w * sk.w * rk.w * (2.f + (a0.w + a1.w - 2.f) * ka.w));
        const float rs = rsqrtf(var + GN_EPS);
        float4 out;
        out.x = (d.x * rs * gw.x + gb.x + bonus * sv.x) * gg.x; out.y = (d.y * rs * gw.y + gb.y + bonus * sv.y) * gg.y;
        out.z = (d.z * rs * gw.z + gb.z + bonus * sv.z) * gg.z; out.w = (d.w * rs * gw.w + gb.w + bonus * sv.w) * gg.w;
        *(h4_t*)(MIX + (size_t)r * 1024 + 512 + c) = to_h4(out);
    }
}

typedef float f32x4v_t __attribute__((ext_vector_type(4)));
__device__ __forceinline__ void phase_route(const Params& p, int tid, int layer, int bid, int nb, unsigned char* smem) {
    constexpr int RB = 16, HP = 1028;
    float* hbuf = (float*)smem;
    float* lg = hbuf + RB * HP;
    float* part = hbuf;
    const int t = tid, wid = t >> 6, lane = t & 63;
    const bool last = (layer == DEPTH - 1);
    const int shard = bid & (NSHARD - 1);
    int* cnt = wsp<int>(p, WS_CNT) + (layer * NSHARD + shard) * 32;
    int* list = wsp<int>(p, WS_LIST);
    float* GATE = wsp<float>(p, WS_GATE); int* ESLOT = wsp<int>(p, WS_ESLOT);
    const f32x4v_t* WRl = (const f32x4v_t*)(wsp<float>(p, WS_WR)) + (size_t)layer * 64 * 3 * 64 + lane;
    for (int rg = bid; rg < M / RB; rg += nb) {
        const int r0 = rg * RB;
        if (last && (r0 % SEQA) < NCTX) continue;
        {
            float4 v[4][4]; float ss[4];
#pragma unroll
            for (int q = 0; q < 4; ++q) {
                const float4* xr = (const float4*)(wsp<float>(p, WS_XS) + (size_t)(r0 + wid * 4 + q) * 1024);
#pragma unroll
                for (int j = 0; j < 4; ++j) v[q][j] = xr[lane + 64 * j];
            }
            __builtin_amdgcn_sched_barrier(0);
#pragma unroll
            for (int q = 0; q < 4; ++q) {
                float a = 0.f;
#pragma unroll
                for (int j = 0; j < 4; ++j) a += v[q][j].x * v[q][j].x + v[q][j].y * v[q][j].y + v[q][j].z * v[q][j].z + v[q][j].w * v[q][j].w;
                ss[q] = wave_sum(a);
            }
#pragma unroll
            for (int q = 0; q < 4; ++q) norm_row_store(p, layer, r0 + wid * 4 + q, 3, v[q], ss[q], lane, hbuf + (wid * 4 + q) * HP);
        }
        __syncthreads();
        {
            f32x4v_t acc0 = {0.f, 0.f, 0.f, 0.f}, acc1 = {0.f, 0.f, 0.f, 0.f}, acc2 = {0.f, 0.f, 0.f, 0.f};
            const float* ap = hbuf + (lane & 15) * HP + 4 * (lane >> 4) + wid * 256;
            const f32x4v_t* bp = WRl + (size_t)wid * 16 * 3 * 64;
            f32x4v_t nb0 = bp[0], nb1 = bp[64], nb2 = bp[128];
#pragma unroll 4
            for (int S = 0; S < 16; ++S) {
                const f32x4v_t b0 = nb0, b1 = nb1, b2 = nb2;
                const int Sn = S + 1 < 16 ? S + 1 : S;
                nb0 = bp[Sn * 192]; nb1 = bp[Sn * 192 + 64]; nb2 = bp[Sn * 192 + 128];
                const float4 a = *(const float4*)(ap + 16 * S);
                acc0 = __builtin_amdgcn_mfma_f32_16x16x4f32(a.x, b0[0], acc0, 0, 0, 0); acc1 = __builtin_amdgcn_mfma_f32_16x16x4f32(a.x, b1[0], acc1, 0, 0, 0); acc2 = __builtin_amdgcn_mfma_f32_16x16x4f32(a.x, b2[0], acc2, 0, 0, 0);
                acc0 = __builtin_amdgcn_mfma_f32_16x16x4f32(a.y, b0[1], acc0, 0, 0, 0); acc1 = __builtin_amdgcn_mfma_f32_16x16x4f32(a.y, b1[1], acc1, 0, 0, 0); acc2 = __builtin_amdgcn_mfma_f32_16x16x4f32(a.y, b2[1], acc2, 0, 0, 0);
                acc0 = __builtin_amdgcn_mfma_f32_16x16x4f32(a.z, b0[2], acc0, 0, 0, 0); acc1 = __builtin_amdgcn_mfma_f32_16x16x4f32(a.z, b1[2], acc1, 0, 0, 0); acc2 = __builtin_amdgcn_mfma_f32_16x16x4f32(a.z, b2[2], acc2, 0, 0, 0);
                acc0 = __builtin_amdgcn_mfma_f32_16x16x4f32(a.w, b0[3], acc0, 0, 0, 0); acc1 = __builtin_amdgcn_mfma_f32_16x16x4f32(a.w, b1[3], acc1, 0, 0, 0); acc2 = __builtin_amdgcn_mfma_f32_16x16x4f32(a.w, b2[3], acc2, 0, 0, 0);
            }
            __syncthreads();
#pragma unroll
            for (int rgi = 0; rgi < 4; ++rgi) {
                const int rr = 4 * (lane >> 4) + rgi, cc = lane & 15;
                part[((wid * 3 + 0) * 16 + rr) * 16 + cc] = acc0[rgi]; part[((wid * 3 + 1) * 16 + rr) * 16 + cc] = acc1[rgi]; part[((wid * 3 + 2) * 16 + rr) * 16 + cc] = acc2[rgi];
            }
        }
        __syncthreads();
        for (int o = t; o < RB * 36; o += NT) {
            const int rr = o / 36, cc = o % 36;
            const int ct = cc < 4 ? 2 : (cc - 4) >> 4, col = cc < 4 ? cc : (cc - 4) & 15;
            float sacc = cc < 4 ? p.moe_b_grp[layer * 4 + cc] : p.moe_b_rt[layer * 32 + cc - 4];
#pragma unroll
            for (int g = 0; g < 4; ++g) sacc += part[((g * 3 + ct) * 16 + rr) * 16 + col];
            lg[o] = sacc;
        }
        __syncthreads();
        if (t < RB) {
            const int r = r0 + t;
            const float* L = lg + t * 36;
            int sel = 0; float mx = L[0];
            for (int g = 1; g < 4; ++g) if (L[g] > mx) { mx = L[g]; sel = g; }
            float z = 0.f;
            for (int g = 0; g < 4; ++g) z += expf(L[g] - mx);
            const float grp_w = 1.f / z;
            const float* E = L + 4 + sel * 8;
            int i1 = 0; float v1 = E[0];
            for (int j = 1; j < 8; ++j) if (E[j] > v1) { v1 = E[j]; i1 = j; }
            int i2 = -1; float v2 = -INFINITY;
            for (int j = 0; j < 8; ++j) if (j != i1 && E[j] > v2) { v2 = E[j]; i2 = j; }
            const float e2 = expf(v2 - v1);
            const float g1 = grp_w / (1.f + e2), g2 = grp_w * e2 / (1.f + e2);
            const int ea = sel * 8 + i1, eb = sel * 8 + i2;
            const int pa = atomicAdd(&cnt[ea], 1);
            const int pb = atomicAdd(&cnt[eb], 1);
            list[(size_t)ea * LISTCAP + shard * SHCAP + pa] = r;
            list[(size_t)eb * LISTCAP + shard * SHCAP + pb] = r;
            GATE[r * 2 + 0] = g1; GATE[r * 2 + 1] = g2;
            ESLOT[r * 2 + 0] = (ea << 16) | (shard << 13) | pa; ESLOT[r * 2 + 1] = (eb << 16) | (shard << 13) | pb;
        }
        __syncthreads();
    }
}

template <int TM>
__device__ __forceinline__ void moe_tables(const Params& p, int tid, int layer, int* tab  ) {
    if (tid < 32) {
        const int* cnt = wsp<int>(p, WS_CNT) + layer * NSHARD * 32;
        int cs[NSHARD];
#pragma unroll
        for (int sh = 0; sh < NSHARD; ++sh) cs[sh] = cnt[sh * 32 + tid];
        __builtin_amdgcn_sched_barrier(0);
        int tot = 0;
#pragma unroll
        for (int sh = 0; sh < NSHARD; ++sh) { tab[97 + tid * NSHARD + sh] = tot; tot += cs[sh]; }
        tab[tid] = tot;
    }
    __syncthreads();
    if (tid == 0) {
        int ts = 0;
        for (int e = 0; e < 32; ++e) { const int c = tab[e]; tab[32 + e] = ts; tab[65 + e] = ts * TM; ts += (c + TM - 1) / TM; }
        tab[64] = ts;
    }
    __syncthreads();
}
constexpr int MOE_TM = 128;
constexpr int MOE_TAB_OFF = 2 * G_LDS_BYTES + 128;
__device__ __forceinline__ void moe_item(const int* tab, int rb, int& e, int& lb, int& orow0) {
    e = 0;
    while (e < 31 && tab[32 + e + 1] <= rb) ++e;
    lb = rb - tab[32 + e]; orow0 = tab[65 + e] + lb * MOE_TM;
}
__device__ __forceinline__ void phase_moe1(const Params& p, int tid, int layer, int bid, int nb, unsigned char* smem) {
    constexpr int TM = MOE_TM;
    int* tab = (int*)(smem + MOE_TAB_OFF);
    moe_tables<TM>(p, tid, layer, tab);
    const int nrb = tab[64], nitems = nrb * 8;
    const half_t* H16 = wsp<half_t>(p, WS_H16);
    half_t* HM = wsp<half_t>(p, WS_HM16);
    const int* list = wsp<int>(p, WS_LIST);
    const half_t* W16 = wsp<half_t>(p, WS_W16);
    auto make_src = [=](int item) -> TileSrc {
        const int rb = item >> 3, nt = item & 7;
        int e, lb, orow0; moe_item(tab, rb, e, lb, orow0);
        const int cnt = tab[e];
        const int* le = list + (size_t)e * LISTCAP;
        const int* sb = tab + 97 + e * NSHARD;
        TileSrc T; T.A = H16;
        T.B0 = W16 + W16_MOE_GATE + (size_t)e * 1024 * 512 + nt * 64; T.B1 = W16 + W16_MOE_UP + (size_t)e * 1024 * 512 + nt * 64;
        tile_aoff(T, [=](int i) -> long {
            const int pos = lb * TM + i;
            if (pos >= cnt) return -1L;
            int sh = 0;
#pragma unroll
            for (int q = 1; q < NSHARD; ++q) sh += (sb[q] <= pos) ? 1 : 0;
            return (long)le[sh * SHCAP + pos - sb[sh]];
        }, 1024, tid);
        return T;
    };
    GemmRegs R;
    bool pre = false;
    if (bid < nitems) {
        TileSrc cur = make_src(bid);
        for (int item = bid; item < nitems; item += nb) {
            const bool hn = item + nb < nitems;
            const TileSrc nx = hn ? make_src(item + nb) : cur;
            const int rb = item >> 3, nt = item & 7;
            int e, lb, orow0; moe_item(tab, rb, e, lb, orow0);
            auto ldf = [=](int, int) -> EpiLd { return EpiLd{make_float4(0.f, 0.f, 0.f, 0.f), make_float4(0.f, 0.f, 0.f, 0.f)}; };
            auto epi = [=](int i, int j, float4 v, const EpiLd&, const float*) { *(h4_t*)(HM + (size_t)(orow0 + i) * 512 + nt * 64 + j) = to_h4(v); };
            gemm_tile_mfma<true>(cur, nx, hn, pre, R, 512, 1024, ldf, epi, smem, tid);
            cur = nx; pre = hn;
        }
    }
}
__device__ __forceinline__ void phase_moe2(const Params& p, int tid, int layer, int bid, int nb, unsigned char* smem) {
    constexpr int TM = MOE_TM, TN = 128, NTN = 1024 / TN;
    int* tab = (int*)(smem + MOE_TAB_OFF);
    moe_tables<TM>(p, tid, layer, tab);
    const int nrb = tab[64], nitems = nrb * NTN;
    const half_t* HM = wsp<half_t>(p, WS_HM16);
    half_t* YO = wsp<half_t>(p, WS_YOUT);
    const half_t* W16 = wsp<half_t>(p, WS_W16);
    auto make_src = [=](int item) -> TileSrc {
        const int rb = item / NTN, nt = item % NTN;
        int e, lb, orow0; moe_item(tab, rb, e, lb, orow0);
        TileSrc T; T.A = HM; T.B0 = W16 + W16_MOE_DOWN + (size_t)e * 512 * 1024 + nt * TN; T.B1 = nullptr;
        tile_aoff(T, [=](int i) -> long { return orow0 + i; }, 512, tid);
        return T;
    };
    GemmRegs R;
    bool pre = false;
    if (bid < nitems) {
        TileSrc cur = make_src(bid);
        for (int item = bid; item < nitems; item += nb) {
            const bool hn = item + nb < nitems;
            const TileSrc nx = hn ? make_src(item + nb) : cur;
            const int rb = item / NTN, nt = item % NTN;
            int e, lb, orow0; moe_item(tab, rb, e, lb, orow0);
            auto ldf = [=](int, int) -> EpiLd { return EpiLd{make_float4(0.f, 0.f, 0.f, 0.f), make_float4(0.f, 0.f, 0.f, 0.f)}; };
            auto epi = [=](int i, int j, float4 v, const EpiLd&, const float*) { *(h4_t*)(YO + (size_t)(orow0 + i) * 1024 + nt * TN + j) = to_h4(v); };
            gemm_tile_mfma<false>(cur, nx, hn, pre, R, 1024, 512, ldf, epi, smem, tid);
            cur = nx; pre = hn;
        }
    }
}

__device__ __forceinline__ void phase_combine(const Params& p, int tid, int layer, int bid, int nb, unsigned char* smem) {
    constexpr int TM = MOE_TM;
    int* tab = (int*)smem;
    moe_tables<TM>(p, tid, layer, tab);
    const int wid = tid >> 6, lane = tid & 63;
    const bool last = (layer == DEPTH - 1);
    const float* GATE = wsp<float>(p, WS_GATE); const int* ESLOT = wsp<int>(p, WS_ESLOT);
    const half_t* YO = wsp<half_t>(p, WS_YOUT);
    for (int r = bid * 4 + wid; r < M; r += nb * 4) {
        const int b = r / SEQA, s = r - b * SEQA;
        if (last && s < NCTX) continue;
        const int es0 = ESLOT[r * 2], es1 = ESLOT[r * 2 + 1];
        const float g0 = GATE[r * 2], g1 = GATE[r * 2 + 1];
        const size_t s0 = (size_t)(tab[65 + (es0 >> 16)] + tab[97 + (es0 >> 16) * NSHARD + ((es0 >> 13) & 7)] + (es0 & 8191)), s1 = (size_t)(tab[65 + (es1 >> 16)] + tab[97 + (es1 >> 16) * NSHARD + ((es1 >> 13) & 7)] + (es1 & 8191));
        float4* xr = (float4*)(wsp<float>(p, WS_XS) + (size_t)r * 1024);
        const h4_t* y0 = (const h4_t*)(YO + s0 * 1024); const h4_t* y1 = (const h4_t*)(YO + s1 * 1024);
        const float4* m5 = (const float4*)mods_ptr(p, layer, mods_row(r), 5);
        float4 v[4], xg[4], gg[4]; h4_t ya[4], yb[4]; float ss = 0.f;
#pragma unroll
        for (int j = 0; j < 4; ++j) { xg[j] = xr[lane + 64 * j]; gg[j] = m5[lane + 64 * j]; ya[j] = y0[lane + 64 * j]; yb[j] = y1[lane + 64 * j]; }
        __builtin_amdgcn_sched_barrier(0);
#pragma unroll
        for (int j = 0; j < 4; ++j) {
            const float4 x = xg[j], g = gg[j]; const h4_t ah = ya[j], ch = yb[j];
            const float4 a = make_float4((float)ah.x, (float)ah.y, (float)ah.z, (float)ah.w), c = make_float4((float)ch.x, (float)ch.y, (float)ch.z, (float)ch.w);
            float4 o;
            o.x = x.x + g.x * (g0 * a.x + g1 * c.x); o.y = x.y + g.y * (g0 * a.y + g1 * c.y);
            o.z = x.z + g.z * (g0 * a.z + g1 * c.z); o.w = x.w + g.w * (g0 * a.w + g1 * c.w);
            v[j] = o; ss += o.x * o.x + o.y * o.y + o.z * o.z + o.w * o.w;
        }
        ss = wave_sum(ss);
        if (!last) {
#pragma unroll
            for (int j = 0; j < 4; ++j) xr[lane + 64 * j] = v[j];
            norm_row_store(p, layer + 1, r, 0, v, ss, lane, nullptr);
        } else {
            const float rstd = rsqrtf(ss * (1.f / 1024.f) + 1e-6f);
            float4* dst = (float4*)(p.out + ((size_t)(b * NLAT + s - NCTX)) * 1024);
            const float4* fg = (const float4*)p.final_gain;
            float4 fgv[4];
#pragma unroll
            for (int j = 0; j < 4; ++j) fgv[j] = fg[lane + 64 * j];
            __builtin_amdgcn_sched_barrier(0);
#pragma unroll
            for (int j = 0; j < 4; ++j) { const float4 g = fgv[j]; float4 o; o.x = v[j].x * rstd * g.x; o.y = v[j].y * rstd * g.y; o.z = v[j].z * rstd * g.z; o.w = v[j].w * rstd * g.w; dst[lane + 64 * j] = o; }
        }
    }
}


#define XB_TMO      128
#define XB_XCNT(j)  (256  + 64 * (j))
#define XB_XSUB(j)  (1280 + 64 * (j))
#define XB_XGEN(j)  (2304 + 64 * (j))
#define XB_TOP      3328
#define XB_TOPGEN   3392
#define XCD_BAR_WORDS 3456
#define XB_SPIN_CAP (1u << 22)

__device__ __forceinline__ unsigned xb_ld(unsigned* p)              { return __hip_atomic_load(p, __ATOMIC_RELAXED, __HIP_MEMORY_SCOPE_AGENT); }
__device__ __forceinline__ unsigned xb_add(unsigned* p, unsigned v) { return __hip_atomic_fetch_add(p, v, __ATOMIC_RELAXED, __HIP_MEMORY_SCOPE_AGENT); }
__device__ __forceinline__ unsigned xb_xcc_id() { return (unsigned)__builtin_amdgcn_s_getreg((3 << 11) | 20) & 0xFu; }
#define XB_SPIN(cond, bar) do { unsigned _sp = 0; while (cond) { __builtin_amdgcn_s_sleep(1); \
    if ((++_sp & 255u) == 0u) { if (xb_ld(&(bar)[XB_TMO])) break; if (_sp > XB_SPIN_CAP) { atomicAdd(&(bar)[XB_TMO], 1u); break; } } } } while (0)

struct XcdBarrier {
    unsigned* bar; unsigned x;
    volatile LAS unsigned* st;
};
__device__ __forceinline__ XcdBarrier xcd_barrier_post(unsigned* bar, volatile LAS unsigned* st) {
    XcdBarrier b; b.bar = bar; b.x = xb_xcc_id(); b.st = st;
    if (threadIdx.x == 0) (void)xb_add(&bar[XB_XCNT(b.x)], 1u);
    return b;
}
__device__ __forceinline__ void xcd_barrier_complete(unsigned* bar, unsigned x, unsigned& nloc, unsigned& nx) {
    const unsigned G = gridDim.x * gridDim.y * gridDim.z;
    unsigned sum, cnt, mine, sp = 0u;
    for (;;) {
        sum = 0u; cnt = 0u; mine = 0u;
#pragma unroll
        for (unsigned j = 0; j < 16; ++j) { const unsigned c = xb_ld(&bar[XB_XCNT(j)]); sum += c; cnt += (c > 0u) ? 1u : 0u; mine = (j == x) ? c : mine; }
        if (sum == G) break;
        __builtin_amdgcn_s_sleep(1);
        if ((++sp & 255u) == 0u) { if (xb_ld(&bar[XB_TMO])) break; if (sp > XB_SPIN_CAP) { atomicAdd(&bar[XB_TMO], 1u); break; } }
    }
    nloc = mine > 0u ? mine : 1u; nx = cnt > 0u ? cnt : 1u;
}
__device__ __forceinline__ void xcd_barrier(const XcdBarrier& b) {
    asm volatile("s_waitcnt vmcnt(0)" ::: "memory");
    __syncthreads();
    if (threadIdx.x == 0) {
        unsigned* bar = b.bar;
        __builtin_amdgcn_s_waitcnt(0);
        unsigned nloc = b.st[0], nx = b.st[1];
        if (nloc == 0u) { xcd_barrier_complete(bar, b.x, nloc, nx); b.st[0] = nloc; b.st[1] = nx; }
        const unsigned old = xb_add(&bar[XB_XSUB(b.x)], 1u);
        const unsigned gen = old / nloc;
        if (old + 1u == (gen + 1u) * nloc) {
            __builtin_amdgcn_fence(__ATOMIC_RELEASE, "agent");
            asm volatile("s_waitcnt vmcnt(0)" ::: "memory");
            const unsigned og = xb_add(&bar[XB_TOP], 1u);
            const unsigned tg = og / nx;
            if (og + 1u == (tg + 1u) * nx) xb_add(&bar[XB_TOPGEN], 1u);
            else XB_SPIN(xb_ld(&bar[XB_TOPGEN]) == tg, bar);
            __builtin_amdgcn_fence(__ATOMIC_ACQUIRE, "agent");
            xb_add(&bar[XB_XGEN(b.x)], 1u);
            asm volatile("s_waitcnt vmcnt(0)" ::: "memory");
        } else {
            XB_SPIN(xb_ld(&bar[XB_XGEN(b.x)]) == gen, bar);
            __builtin_amdgcn_fence(__ATOMIC_ACQUIRE, "agent");
            asm volatile("s_waitcnt vmcnt(0)" ::: "memory");
        }
    }
    __syncthreads();
}

enum { PH_MODS = 0, PH_COPY, PH_NORM1, PH_GEMM_IN, PH_PREP, PH_ATTN, PH_SCAN, PH_POST, PH_GEMM_OUT, PH_ROUTE, PH_MOE1, PH_MOE2, PH_COMBINE, PH_LORA };

template <int PH>
__device__ __forceinline__ void run_phase(const Params& p, int tid, int layer, int bid, int nb, unsigned char* smem) {
    const bool even = (layer & 1) == 0;
    const int e = layer >> 1;
    if (PH == PH_MODS) phase_mods(p, tid, bid, nb, smem);
    else if (PH == PH_COPY) {
        convert_dense_weights(p, tid, bid, nb);
        float* WR = wsp<float>(p, WS_WR);
        for (int i = bid * NT + tid; i < 4 * 64 * 3 * 64 * 4; i += nb * NT) {
            const int sp = i & 3, ln = (i >> 2) & 63, rest = i >> 8, ct = rest % 3, S = (rest / 3) & 63, ly = rest / (3 * 64);
            const int k = 16 * S + 4 * (ln >> 4) + sp, j = ln & 15;
            float v = 0.f;
            if (ct < 2) v = p.moe_w_rt[((size_t)ly * 1024 + k) * 32 + ct * 16 + j];
            else if (j < 4) v = p.moe_w_grp[((size_t)ly * 1024 + k) * 4 + j];
            WR[i] = v;
        }
    }
    else if (PH == PH_NORM1) phase_norm1(p, tid, layer, bid, nb);
    else if (PH == PH_GEMM_IN) {
        const half_t* W16 = wsp<half_t>(p, WS_W16);
        if (even) phase_gemm_dense<3>(p, tid, layer, wsp<half_t>(p, WS_H16), W16 + W16_EV_IN + (size_t)e * 1024 * EVEN_COLS, EVEN_COLS, bid, nb, smem);
        else phase_gemm_dense<2>(p, tid, layer, wsp<half_t>(p, WS_H16), W16 + W16_OD_IN + (size_t)e * 1024 * ODD_COLS, ODD_COLS, bid, nb, smem);
    } else if (PH == PH_PREP) { if (even) phase_prep_even(p, tid, layer, bid, nb, smem); }
    else if (PH == PH_ATTN) {
        if (even) phase_attn_mfma<0>(p, tid, bid, nb, smem); else phase_attn_mfma<1>(p, tid, bid, nb, smem);
    }
    else if (PH == PH_LORA) { if (even) phase_lora(p, tid, layer, bid, nb, smem); }
    else if (PH == PH_SCAN) { if (even) phase_scan(p, tid, layer, bid, nb, smem); }
    else if (PH == PH_POST) { if (even) phase_readout(p, tid, layer, bid, nb); else phase_diff_finish(p, tid, layer, bid, nb); }
    else if (PH == PH_GEMM_OUT) phase_gemm_dense<1>(p, tid, layer, wsp<half_t>(p, WS_MIX16), wsp<half_t>(p, WS_W16) + (even ? W16_EV_OUT : W16_OD_OUT) + (size_t)e * 1024 * 1024, 1024, bid, nb, smem);
    else if (PH == PH_ROUTE) phase_route(p, tid, layer, bid, nb, smem);
    else if (PH == PH_MOE1) phase_moe1(p, tid, layer, bid, nb, smem);
    else if (PH == PH_MOE2) phase_moe2(p, tid, layer, bid, nb, smem);
    else if (PH == PH_COMBINE) phase_combine(p, tid, layer, bid, nb, smem);
}

template <int PH>
__global__ void __launch_bounds__(NT, 2) k_phase(Params p, int layer) {
    extern __shared__ __attribute__((aligned(16))) unsigned char smem[];
    run_phase<PH>(p, threadIdx.x, layer, blockIdx.x, gridDim.x, smem);
}

__device__ __forceinline__ unsigned* load_bar_ptr(const unsigned char* tab) {
    const LAS unsigned* t = (const LAS unsigned*)tab;
    const unsigned lo = __builtin_amdgcn_readfirstlane(t[2 * 41]), hi = __builtin_amdgcn_readfirstlane(t[2 * 41 + 1]);
    const unsigned long long u = (((unsigned long long)hi << 32) | lo) + WS_BAR;
    return (unsigned*)(__attribute__((address_space(1))) unsigned*)u;
}
#ifndef PROBE_BAR2
#define PROBE_BAR2 0
#endif
#define GRID_BARRIER() { if (PROBE_BAR2) { XcdBarrier b3_; b3_.bar = load_bar_ptr(smem + LDS_BYTES + 16); b3_.x = xb_xcc_id(); b3_.st = (volatile LAS unsigned*)(smem + LDS_BYTES); xcd_barrier(b3_); } XcdBarrier b2_; b2_.bar = load_bar_ptr(smem + LDS_BYTES + 16); b2_.x = xb_xcc_id(); b2_.st = (volatile LAS unsigned*)(smem + LDS_BYTES); xcd_barrier(b2_); }
#ifndef PROBE_MASK
#define PROBE_MASK 0u
#endif
#define RUN1(PH, layer) { int tid_ = threadIdx.x; asm volatile("" : "+v"(tid_)); int bid_ = bid; asm volatile("" : "+s"(bid_)); unsigned lo_ = 0; asm volatile("" : "+s"(lo_)); \
    unsigned char* smem_ = smem + lo_; const Params q = load_params(smem_ + LDS_BYTES + 16); run_phase<PH>(q, tid_, layer, bid_, nb, smem_); }
#define RUN(PH, layer) { if ((PROBE_MASK >> PH) & 1u) { RUN1(PH, layer); __syncthreads(); } RUN1(PH, layer); }
#ifndef PROBE_STAMP
#define PROBE_STAMP -1
#endif
#define STAMP(id) { if (PROBE_STAMP >= 0 && threadIdx.x == 0 && bid == 0) { volatile LAS unsigned long long* st_ = (volatile LAS unsigned long long*)(smem + LDS_BYTES + 16 + NPTR * 8); \
    const unsigned long long now_ = wall_clock64(); if ((id) == PROBE_STAMP) st_[1] += now_ - st_[0]; st_[0] = now_; } }
__global__ void __launch_bounds__(NT, 2) k_mega(Params p) {
    extern __shared__ __attribute__((aligned(16))) unsigned char smem[];
    const int bid = blockIdx.x, nb = gridDim.x;
    if (threadIdx.x == 0) *(uint4*)(smem + LDS_BYTES) = make_uint4(0u, 0u, 0u, 0u);
    {
        unsigned long long v[NPTR];
        __builtin_memcpy(v, &p, sizeof(Params));
        unsigned long long* tab = (unsigned long long*)(smem + LDS_BYTES + 16);
        if (threadIdx.x == 0) {
#pragma unroll
            for (int i = 0; i < NPTR; ++i) tab[i] = v[i];
            if (PROBE_STAMP >= 0) { tab[NPTR] = wall_clock64(); tab[NPTR + 1] = 0ull; }
        }
    }
    unsigned* barw = (unsigned*)(p.ws + WS_BAR);
    __syncthreads();
    (void)xcd_barrier_post(barw, (volatile LAS unsigned*)(smem + LDS_BYTES));
    RUN(PH_MODS, 0);
    RUN(PH_COPY, 0);
    GRID_BARRIER();
    RUN(PH_NORM1, 0);
    GRID_BARRIER();
    STAMP(10);
#pragma unroll 1
    for (int layer = 0; layer < DEPTH; ++layer) {
        RUN(PH_GEMM_IN, layer);
        GRID_BARRIER();
        STAMP(0);
        RUN(PH_ATTN, layer);
        if ((layer & 1) == 0) {
            RUN(PH_PREP, layer);
            GRID_BARRIER();
            STAMP(1);
            RUN(PH_LORA, layer);
            GRID_BARRIER();
            STAMP(2);
            RUN(PH_SCAN, layer);
            GRID_BARRIER();
            STAMP(3);
        } else {
            GRID_BARRIER();
            STAMP(11);
        }
        RUN(PH_POST, layer);
        GRID_BARRIER();
        STAMP(4);
        RUN(PH_GEMM_OUT, layer);
        GRID_BARRIER();
        STAMP(5);
        RUN(PH_ROUTE, layer);
        GRID_BARRIER();
        STAMP(6);
        RUN(PH_MOE1, layer);
        GRID_BARRIER();
        STAMP(7);
        RUN(PH_MOE2, layer);
        GRID_BARRIER();
        STAMP(8);
        RUN(PH_COMBINE, layer);
        if (layer + 1 < DEPTH || PROBE_STAMP >= 0) GRID_BARRIER();
        STAMP(9);
    }
    if (PROBE_STAMP >= 0 && threadIdx.x == 0 && bid == 0) {
        volatile LAS unsigned long long* st_ = (volatile LAS unsigned long long*)(smem + LDS_BYTES + 16 + NPTR * 8);
        const unsigned long long t0 = wall_clock64(), span = st_[1];
        while (wall_clock64() - t0 < span) __builtin_amdgcn_s_sleep(8);
    }
}

template <int PH>
static void launch_phase(const Params& p, int layer, int grid, hipStream_t stream) {
    static bool attr_set = false;
    if (!attr_set) { (void)hipFuncSetAttribute((const void*)k_phase<PH>, hipFuncAttributeMaxDynamicSharedMemorySize, LDS_BYTES); attr_set = true; }
    hipLaunchKernelGGL(k_phase<PH>, dim3(grid), dim3(NT), LDS_BYTES, stream, p, layer);
}

extern "C" void kernel_launch(void* const* d_in, const int* in_sizes, int n_in, void* d_out, int out_size, void* d_ws, size_t ws_size, hipStream_t stream) {
    if (n_in != 40 || ws_size < WS_END) { fprintf(stderr, "kernel_launch: unexpected inputs (n_in %d, ws %zu, need %zu)\n", n_in, ws_size, (size_t)WS_END); return; }
    Params p{};
    const float** pp = (const float**)&p;
    for (int i = 0; i < 40; ++i) pp[i] = (const float*)d_in[i];
    p.out = (float*)d_out; p.ws = (unsigned char*)d_ws;
    (void)hipMemsetAsync(d_ws, 0, WS_ZERO_BYTES, stream);
#if ONE_LAUNCH
    static int grid = 0;
    if (grid == 0) {
        int dev = 0, cus = 0, per_cu = 0;
        (void)hipGetDevice(&dev);
        (void)hipDeviceGetAttribute(&cus, hipDeviceAttributeMultiprocessorCount, dev);
        (void)hipFuncSetAttribute((const void*)k_mega, hipFuncAttributeMaxDynamicSharedMemorySize, MEGA_LDS);
        if (hipOccupancyMaxActiveBlocksPerMultiprocessor(&per_cu, (const void*)k_mega, NT, MEGA_LDS) != hipSuccess || per_cu < 1) per_cu = 1;
        (void)hipGetLastError();
        if (cus <= 0) cus = 256;
        grid = cus * (per_cu < 2 ? per_cu : 2);
    }
    hipLaunchKernelGGL(k_mega, dim3(grid), dim3(NT), MEGA_LDS, stream, p);
#else
    const int grid = 1024;
    launch_phase<PH_MODS>(p, 0, 512, stream);
    launch_phase<PH_COPY>(p, 0, grid, stream);
    launch_phase<PH_NORM1>(p, 0, grid, stream);
    for (int layer = 0; layer < DEPTH; ++layer) {
        launch_phase<PH_GEMM_IN>(p, layer, grid, stream);
        launch_phase<PH_ATTN>(p, layer, grid, stream);
        if ((layer & 1) == 0) { launch_phase<PH_PREP>(p, layer, grid, stream); launch_phase<PH_LORA>(p, layer, grid, stream); launch_phase<PH_SCAN>(p, layer, 512, stream); }
        launch_phase<PH_POST>(p, layer, grid, stream);
        launch_phase<PH_GEMM_OUT>(p, layer, grid, stream);
        launch_phase<PH_ROUTE>(p, layer, grid, stream);
        launch_phase<PH_MOE1>(p, layer, grid, stream);
        launch_phase<PH_MOE2>(p, layer, grid, stream);
        launch_phase<PH_COMBINE>(p, layer, grid, stream);
    }
#endif
}
```

```cpp
#include <hip/hip_runtime.h>
#include <stdint.h>
#include <stdio.h>

#ifndef USE_MFMA_ATTN
#define USE_MFMA_ATTN 1
#endif
#ifndef USE_MFMA_GEMM
#define USE_MFMA_GEMM 1
#endif
#ifndef ONE_LAUNCH
#define ONE_LAUNCH 1
#endif

#define LAS __attribute__((address_space(3)))
typedef _Float16 half_t;
typedef _Float16 h4_t __attribute__((ext_vector_type(4)));
typedef _Float16 h8_t __attribute__((ext_vector_type(8)));

constexpr int D = 1024, NB = 8, NLAT = 2048, NCTX = 256, SEQA = NLAT + NCTX  , M = NB * SEQA  ;
constexpr int DEPTH = 4;
constexpr int EVEN_COLS = 2560, ODD_COLS = 3072;
constexpr int NEXP = 32, EH = 512;
constexpr int LISTCAP = 36864, MAXSLOT = 40960;
constexpr int NSHARD = 8, SHCAP = LISTCAP / NSHARD;
constexpr float DECAY_SCALE = 0.60653065971263342f;
constexpr float GN_EPS = 64e-5f;
constexpr float QSCALE = 0.125f * 1.4426950408889634f;
constexpr int NT = 256;
constexpr int LDS_BYTES = 75776;

constexpr size_t WS_BAR = 0;
constexpr size_t WS_CNT = 16384;
constexpr size_t WS_ZERO_BYTES = 24576;
constexpr size_t WS_ROPE = 24576;
constexpr size_t WS_MODS = 32768;
constexpr size_t WS_XS = 1u << 20;
constexpr size_t SZ_F32_1024 = (size_t)M * 1024 * 4;
constexpr size_t SZ_H16_1024 = (size_t)M * 1024 * 2;
constexpr size_t SZ_F32_512 = (size_t)M * 512 * 4;
constexpr size_t WS_H16 = WS_XS + SZ_F32_1024;
constexpr size_t WS_BIG = WS_H16 + SZ_H16_1024;
constexpr size_t SZ_BIG = (size_t)M * 8 * 2 * 128 * 4;
constexpr size_t WS_Q16 = WS_BIG + SZ_BIG;
constexpr size_t WS_K16 = WS_Q16 + SZ_H16_1024;
constexpr size_t WS_V16 = WS_K16 + SZ_H16_1024;
constexpr size_t WS_MIX16 = WS_V16 + SZ_H16_1024;
constexpr size_t WS_SR = WS_MIX16 + SZ_H16_1024;
constexpr size_t WS_SV = WS_SR + SZ_F32_512;
constexpr size_t WS_SKK = WS_SV + SZ_F32_512;
constexpr size_t WS_SW = WS_SKK + SZ_F32_512;
constexpr size_t WS_SA = WS_SW + 2 * SZ_F32_512;
constexpr size_t WS_SK = WS_SA + 2 * SZ_F32_512;
constexpr size_t WS_G = WS_SK + 2 * SZ_F32_512;
constexpr size_t WS_VF = WS_G + SZ_F32_512;
constexpr size_t WS_BONUS = WS_VF + SZ_F32_512;
constexpr size_t WS_LIN16 = WS_BONUS + (size_t)2 * M * 8 * 4;
constexpr size_t WS_LIST = WS_LIN16 + (size_t)M * 256 * 2;
constexpr size_t WS_GATE = WS_LIST + (size_t)NEXP * LISTCAP * 4;
constexpr size_t WS_ESLOT = WS_GATE + (size_t)M * 2 * 4;
constexpr size_t WS_W16 = WS_ESLOT + (size_t)M * 2 * 4;
constexpr size_t W16_EV_IN = 0, W16_OD_IN = W16_EV_IN + (size_t)2 * 1024 * EVEN_COLS, W16_EV_OUT = W16_OD_IN + (size_t)2 * 1024 * ODD_COLS,
                 W16_OD_OUT = W16_EV_OUT + (size_t)2 * 1024 * 1024, W16_W2 = W16_OD_OUT + (size_t)2 * 1024 * 1024, W16_A2 = W16_W2 + (size_t)4 * 64 * 512,
                 W16_G2 = W16_A2 + (size_t)4 * 64 * 512, W16_MOE = W16_G2 + (size_t)2 * 128 * 512,
                 W16_MOE_GATE = W16_MOE, W16_MOE_UP = W16_MOE + (size_t)32 * 1024 * 512, W16_MOE_DOWN = W16_MOE_UP + (size_t)32 * 1024 * 512,
                 W16_ELEMS = W16_MOE_DOWN + (size_t)32 * 512 * 1024;
constexpr size_t WS_WR = WS_W16 + W16_ELEMS * 2;
constexpr size_t WS_END = WS_WR + (size_t)4 * 64 * 3 * 64 * 4 * 4;
constexpr size_t WS_YSC = WS_BIG;
constexpr size_t WS_ATT32 = WS_BIG;
constexpr size_t WS_HM16 = WS_BIG;
constexpr size_t WS_YOUT = WS_BIG + (size_t)MAXSLOT * 512 * 2;
constexpr size_t WS_RW32 = WS_BIG;
static_assert(WS_YOUT + (size_t)MAXSLOT * 1024 * 2 <= WS_BIG + SZ_BIG, "BIG region too small");
static_assert(WS_END < (size_t)1040 * 1000 * 1000, "workspace too large");

struct Params {
    const float *x, *c, *ctx, *c_ctx, *mod_w, *mod_b, *ev_w_in, *ev_w_out, *ev_q_gain, *ev_k_gain, *ev_mu_prev, *ev_mu_next, *ev_w0, *ev_w2,
        *ev_a0, *ev_a2, *ev_g2, *ev_k_k, *ev_k_a, *ev_r_k, *ev_gn_w, *ev_gn_b, *ev_v0, *ev_v1, *ev_v2, *od_w_in, *od_w_out, *od_lq1, *od_lk1,
        *od_lq2, *od_lk2, *od_subln, *moe_w_grp, *moe_b_grp, *moe_w_rt, *moe_b_rt, *moe_w_gate, *moe_w_up, *moe_w_down, *final_gain;
    float* out;
    unsigned char* ws;
};

template <int CTRL> __device__ __forceinline__ float dpp_mov(float v) {
    return __int_as_float(__builtin_amdgcn_update_dpp(0, __float_as_int(v), CTRL, 0xF, 0xF, true));
}
__device__ __forceinline__ float sum16(float v) {
    v += dpp_mov<0xB1>(v);
    v += dpp_mov<0x4E>(v);
    v += dpp_mov<0x141>(v);
    v += dpp_mov<0x140>(v);
    return v;
}
__device__ __forceinline__ float wave_sum(float v) {
    v = sum16(v);
    const float a = __int_as_float(__builtin_amdgcn_readlane(__float_as_int(v), 0)), b = __int_as_float(__builtin_amdgcn_readlane(__float_as_int(v), 16));
    const float c = __int_as_float(__builtin_amdgcn_readlane(__float_as_int(v), 32)), d = __int_as_float(__builtin_amdgcn_readlane(__float_as_int(v), 48));
    return (a + b) + (c + d);
}
__device__ __forceinline__ h4_t to_h4(float4 v) { h4_t h; h.x = (half_t)v.x; h.y = (half_t)v.y; h.z = (half_t)v.z; h.w = (half_t)v.w; return h; }
__device__ __forceinline__ float4 from_h4(h4_t h) { return make_float4((float)h.x, (float)h.y, (float)h.z, (float)h.w); }
__device__ __forceinline__ float sigmoidf_(float x) { return 1.f / (1.f + expf(-x)); }
__device__ __forceinline__ float fsigmoid(float x) { return __builtin_amdgcn_rcpf(1.f + __builtin_amdgcn_exp2f(-1.4426950408889634f * x)); }
__device__ __forceinline__ float siluf_(float x) { return x / (1.f + expf(-x)); }
__device__ __forceinline__ int mods_row(int r) { const int b = r / SEQA, s = r - b * SEQA; return s < NCTX ? 8 : b; }
__device__ __forceinline__ const float* mods_ptr(const Params& p, int layer, int mr, int chunk) {
    return (const float*)(p.ws + WS_MODS) + ((size_t)(layer * 9 + mr)) * 6144 + chunk * 1024;
}
template <class T> __device__ __forceinline__ T* wsp(const Params& p, size_t off) { return (T*)(p.ws + off); }

constexpr int NPTR = 42;
constexpr int MEGA_LDS = LDS_BYTES + 16 + NPTR * 8 + 16;
static_assert(sizeof(Params) == NPTR * 8, "Params must be 42 pointers");
__device__ __forceinline__ Params load_params(const unsigned char* tab) {
    const LAS unsigned* t = (const LAS unsigned*)tab;
    Params q;
    const void* v[NPTR];
#pragma unroll
    for (int i = 0; i < NPTR; ++i) {
        const unsigned lo = __builtin_amdgcn_readfirstlane(t[2 * i]), hi = __builtin_amdgcn_readfirstlane(t[2 * i + 1]);
        const unsigned long long u = ((unsigned long long)hi << 32) | lo;
        v[i] = (const void*)(const __attribute__((address_space(1))) void*)u;
    }
    __builtin_memcpy(&q, v, sizeof(Params));
    return q;
}
__device__ __forceinline__ void convert_w16(const float* __restrict__ src, half_t* __restrict__ dst, size_t n, int tid, int bid, int nb) {
    const size_t n8 = n >> 3, st = (size_t)nb * NT;
#pragma unroll 1
    for (size_t i0 = (size_t)bid * NT + tid; i0 < n8; i0 += 4 * st) {
        float4 a[4], b[4];
#pragma unroll
        for (int u = 0; u < 4; ++u) {
            const size_t i = i0 + u * st;
            if (i < n8) { a[u] = ((const float4*)src)[2 * i]; b[u] = ((const float4*)src)[2 * i + 1]; } else { a[u] = make_float4(0.f, 0.f, 0.f, 0.f); b[u] = a[u]; }
        }
        __builtin_amdgcn_sched_barrier(0);
#pragma unroll
        for (int u = 0; u < 4; ++u) {
            const size_t i = i0 + u * st;
            h8_t h; h[0] = (half_t)a[u].x; h[1] = (half_t)a[u].y; h[2] = (half_t)a[u].z; h[3] = (half_t)a[u].w; h[4] = (half_t)b[u].x; h[5] = (half_t)b[u].y; h[6] = (half_t)b[u].z; h[7] = (half_t)b[u].w;
            if (i < n8) ((h8_t*)dst)[i] = h;
        }
    }
}
__device__ __forceinline__ void convert_dense_weights(const Params& p, int tid, int bid, int nb) {
    half_t* W16 = wsp<half_t>(p, WS_W16);
    convert_w16(p.ev_w_in, W16 + W16_EV_IN, (size_t)2 * 1024 * EVEN_COLS, tid, bid, nb);
    convert_w16(p.od_w_in, W16 + W16_OD_IN, (size_t)2 * 1024 * ODD_COLS, tid, bid, nb);
    convert_w16(p.ev_w_out, W16 + W16_EV_OUT, (size_t)2 * 1024 * 1024, tid, bid, nb);
    convert_w16(p.od_w_out, W16 + W16_OD_OUT, (size_t)2 * 1024 * 1024, tid, bid, nb);
    convert_w16(p.ev_w2, W16 + W16_W2, (size_t)4 * 64 * 512, tid, bid, nb);
    convert_w16(p.ev_a2, W16 + W16_A2, (size_t)4 * 64 * 512, tid, bid, nb);
    convert_w16(p.ev_g2, W16 + W16_G2, (size_t)2 * 128 * 512, tid, bid, nb);
}
constexpr int MOE_CV_CHUNKS = 3 * 2097152;
__device__ __forceinline__ void convert_moe_steps(const unsigned char* ptab, int layer, int tid, int bid, int nb, int q0, int q1) {
    if (q0 >= q1) return;
    const Params p = load_params(ptab);
    half_t* W16 = wsp<half_t>(p, WS_W16) + W16_MOE;
    const size_t lofs = (size_t)layer * 32 * 1024 * 512;
#pragma unroll 1
    for (int q = q0; q < q1; q += 4) {
        float4 a[4], b[4];
#pragma unroll
        for (int u = 0; u < 4; ++u) {
            const size_t i = ((size_t)(q + u) * nb + bid) * NT + tid;
            const bool ok = q + u < q1 && i < (size_t)MOE_CV_CHUNKS;
            const int tsel = (int)(i >> 21); const size_t off = (i & 2097151u) * 8;
            const float* src = (tsel == 0 ? p.moe_w_gate : tsel == 1 ? p.moe_w_up : p.moe_w_down) + lofs + off;
            if (ok) { a[u] = ((const float4*)src)[0]; b[u] = ((const float4*)src)[1]; } else { a[u] = make_float4(0.f, 0.f, 0.f, 0.f); b[u] = a[u]; }
        }
        __builtin_amdgcn_sched_barrier(0);
#pragma unroll
        for (int u = 0; u < 4; ++u) {
            const size_t i = ((size_t)(q + u) * nb + bid) * NT + tid;
            const bool ok = q + u < q1 && i < (size_t)MOE_CV_CHUNKS;
            const int tsel = (int)(i >> 21); const size_t off = (i & 2097151u) * 8;
            h8_t h; h[0] = (half_t)a[u].x; h[1] = (half_t)a[u].y; h[2] = (half_t)a[u].z; h[3] = (half_t)a[u].w; h[4] = (half_t)b[u].x; h[5] = (half_t)b[u].y; h[6] = (half_t)b[u].z; h[7] = (half_t)b[u].w;
            if (ok) *(h8_t*)(W16 + (size_t)tsel * 32 * 1024 * 512 + off) = h;
        }
    }
}

__device__ __forceinline__ void phase_mods(const Params& p, int tid, int bid, int nb, unsigned char* smem) {
    float* cond = (float*)smem;
    float* part = cond + 9 * 1024;
    const int t = tid;
    {
        float4 cv[9];
#pragma unroll
        for (int r = 0; r < 9; ++r) cv[r] = r < 8 ? ((const float4*)(p.c + r * 1024))[t] : ((const float4*)p.c_ctx)[t];
        __builtin_amdgcn_sched_barrier(0);
#pragma unroll
        for (int r = 0; r < 9; ++r) ((float4*)(cond + r * 1024))[t] = make_float4(siluf_(cv[r].x), siluf_(cv[r].y), siluf_(cv[r].z), siluf_(cv[r].w));
    }
    __syncthreads();
    if (bid == 0) {
        float2* ROPE = wsp<float2>(p, WS_ROPE);
        for (int i = t; i < 64 * 16; i += NT) { const float ang = (float)(i >> 4) * powf(10000.0f, -(float)(i & 15) / 16.0f); ROPE[i] = make_float2(cosf(ang), sinf(ang)); }
    }
    float* mods = wsp<float>(p, WS_MODS);
    for (int item = bid; item < 512; item += nb) {
        const int layer = item >> 7, col0 = (item & 127) * 48;
        const int cq = t % 12, dg = t / 12;
        if (dg < 16) {
            float acc[9][4];
#pragma unroll
            for (int r = 0; r < 9; ++r)
#pragma unroll
                for (int j = 0; j < 4; ++j) acc[r][j] = 0.f;
            const float* W = p.mod_w + (size_t)layer * 1024 * 6144 + col0 + cq * 4;
#pragma unroll 1
            for (int i0 = 0; i0 < 64; i0 += 16) {
                float4 w[16];
#pragma unroll
                for (int u = 0; u < 16; ++u) w[u] = *(const float4*)(W + (size_t)(dg * 64 + i0 + u) * 6144);
                __builtin_amdgcn_sched_barrier(0);
#pragma unroll
                for (int u = 0; u < 16; ++u) {
                    const int d = dg * 64 + i0 + u;
#pragma unroll
                    for (int r = 0; r < 9; ++r) { const float cv = cond[r * 1024 + d]; acc[r][0] += cv * w[u].x; acc[r][1] += cv * w[u].y; acc[r][2] += cv * w[u].z; acc[r][3] += cv * w[u].w; }
                }
            }
#pragma unroll
            for (int r = 0; r < 9; ++r)
#pragma unroll
                for (int j = 0; j < 4; ++j) part[(dg * 9 + r) * 48 + cq * 4 + j] = acc[r][j];
        }
        __syncthreads();
        for (int o = t; o < 9 * 48; o += NT) {
            const int r = o / 48, cc = o % 48;
            float s = p.mod_b[layer * 6144 + col0 + cc];
            for (int g = 0; g < 16; ++g) s += part[(g * 9 + r) * 48 + cc];
            mods[((size_t)(layer * 9 + r)) * 6144 + col0 + cc] = s;
        }
        __syncthreads();
    }
}

__device__ __forceinline__ void mods_load(const Params& p, int layer, int r, int chunk_shift, int lane, float4 (&a)[4], float4 (&b)[4]) {
    const int mr = mods_row(r);
    const float4* sh = (const float4*)mods_ptr(p, layer, mr, chunk_shift);
    const float4* sc = (const float4*)mods_ptr(p, layer, mr, chunk_shift + 1);
#pragma unroll
    for (int j = 0; j < 4; ++j) { a[j] = sh[lane + 64 * j]; b[j] = sc[lane + 64 * j]; }
}
__device__ __forceinline__ void norm_row_store(const Params& p, int r, const float4 (&v)[4], float ss, int lane, float* hbuf  , const float4 (&a)[4], const float4 (&b)[4]) {
    const float rstd = rsqrtf(ss * (1.f / 1024.f) + 1e-6f);
    half_t* H = wsp<half_t>(p, WS_H16) + (size_t)r * 1024;
#pragma unroll
    for (int j = 0; j < 4; ++j) {
        float4 h;
        h.x = v[j].x * rstd * (1.f + b[j].x) + a[j].x; h.y = v[j].y * rstd * (1.f + b[j].y) + a[j].y;
        h.z = v[j].z * rstd * (1.f + b[j].z) + a[j].z; h.w = v[j].w * rstd * (1.f + b[j].w) + a[j].w;
        h4_t hh; hh.x = (half_t)h.x; hh.y = (half_t)h.y; hh.z = (half_t)h.z; hh.w = (half_t)h.w;
        *(h4_t*)(H + (lane + 64 * j) * 4) = hh;
        if (hbuf) *(float4*)(hbuf + (lane + 64 * j) * 4) = h;
    }
}
__device__ __forceinline__ void phase_norm1(const Params& p, int tid, int layer, int bid, int nb) {
    const int wid = tid >> 6, lane = tid & 63;
    for (int r = bid * 4 + wid; r < M; r += nb * 4) {
        const int b = r / SEQA, s = r - b * SEQA;
        const float4* xr = (s < NCTX) ? (const float4*)(p.ctx + ((size_t)(b * NCTX + s)) * 1024) : (const float4*)(p.x + ((size_t)(b * NLAT + s - NCTX)) * 1024);
        float4* xs = (float4*)(wsp<float>(p, WS_XS) + (size_t)r * 1024);
        float4 v[4], ma[4], mb[4]; float ss = 0.f;
#pragma unroll
        for (int j = 0; j < 4; ++j) v[j] = xr[lane + 64 * j];
        mods_load(p, layer, r, 0, lane, ma, mb);
        __builtin_amdgcn_sched_barrier(0);
#pragma unroll
        for (int j = 0; j < 4; ++j) { xs[lane + 64 * j] = v[j]; ss += v[j].x * v[j].x + v[j].y * v[j].y + v[j].z * v[j].z + v[j].w * v[j].w; }
        ss = wave_sum(ss);
        norm_row_store(p, r, v, ss, lane, nullptr, ma, mb);
    }
}

typedef float f32x16_t __attribute__((ext_vector_type(16)));
typedef short s16x4_t __attribute__((__vector_size__(8)));
typedef short s16x8_t __attribute__((ext_vector_type(8)));
constexpr int GT_P = 132;
constexpr int GA_CS = 2064, GB_RS = 320, G_SA_BYTES = 8 * GA_CS, G_SB_BYTES = 64 * GB_RS, G_LDS_BYTES = G_SA_BYTES + G_SB_BYTES;
struct TileSrc { const half_t* A; const half_t* B0; const half_t* B1; unsigned aoff[4]; };
struct GemmRegs { h8_t xa0, xa1, xa2, xa3, xb0, xb1, xb2, xb3, ya0, ya1, ya2, ya3, yb0, yb1, yb2, yb3; };
template <class RowSrc> __device__ __forceinline__ void tile_aoff(TileSrc& T, RowSrc rowsrc, int lda, int tid) {
#pragma unroll
    for (int j = 0; j < 4; ++j) { const long rsj = rowsrc((tid + 256 * j) >> 3); T.aoff[j] = ((unsigned)(rsj >= 0 ? rsj : 0) * (unsigned)lda + (tid & 7) * 8) * 2u; }
}
struct EpiLd { float4 a, b; };
template <bool DUAL, class LdF, class Epi>
__device__ __forceinline__ void gemm_tile_mfma(const TileSrc& cur, const TileSrc& nxt, bool has_next, bool preloaded, GemmRegs& R, int ldb, int K, LdF ldf, Epi epi, unsigned char* smem, int tid) {
    const int lane = tid & 63, wid = tid >> 6, wm = wid >> 1, wn = wid & 1;
    const unsigned bvoff = (DUAL ? (unsigned)(tid >> 3) * (unsigned)ldb + (tid & 7) * 8 : (unsigned)(tid >> 4) * (unsigned)ldb + (tid & 15) * 8) * 2u;
    const int bst = DUAL ? (tid >> 3) * GB_RS + ((tid & 7) >> 2) * 128 + (tid & 3) * 16 : (tid >> 4) * GB_RS + (tid & 15) * 16;
    const int ast = (tid & 7) * GA_CS + (tid >> 3) * 16;
    f32x16_t acc[2][2];
#pragma unroll
    for (int i = 0; i < 2; ++i)
#pragma unroll
        for (int j = 0; j < 2; ++j)
#pragma unroll
            for (int r = 0; r < 16; ++r) acc[i][j][r] = 0.f;
    const int nkt = K >> 6;
#define GLD(dst, off, base) asm volatile("global_load_dwordx4 %0, %1, %2" : "=v"(dst) : "v"(off), "s"(base) : "memory")
#define PIN4(a, b, c, d) asm volatile("" : "+v"(a), "+v"(b), "+v"(c), "+v"(d) :: "memory")
#define BBASE(T, kt, j) (DUAL ? (((j) & 1) ? (T).B1 : (T).B0) + (size_t)((kt) * 64 + 32 * ((j) >> 1)) * ldb : (T).B0 + (size_t)((kt) * 64 + 16 * (j)) * ldb)
#define LOADSET(P, kt, T)                                                                                               \
    {                                                                                                                   \
        const half_t* Ak_ = (T).A + (kt) * 64;                                                                          \
        GLD(R.P##a0, (T).aoff[0], Ak_); GLD(R.P##a1, (T).aoff[1], Ak_); GLD(R.P##a2, (T).aoff[2], Ak_); GLD(R.P##a3, (T).aoff[3], Ak_); \
        GLD(R.P##b0, bvoff, BBASE(T, kt, 0)); GLD(R.P##b1, bvoff, BBASE(T, kt, 1)); GLD(R.P##b2, bvoff, BBASE(T, kt, 2)); GLD(R.P##b3, bvoff, BBASE(T, kt, 3)); \
    }
#define WAITSET(P, newer) { if (newer) asm volatile("s_waitcnt vmcnt(8)" ::: "memory"); else asm volatile("s_waitcnt vmcnt(0)" ::: "memory"); \
        PIN4(R.P##a0, R.P##a1, R.P##a2, R.P##a3); PIN4(R.P##b0, R.P##b1, R.P##b2, R.P##b3); }
#define STORESET(P, buf)                                                                                                \
    {                                                                                                                   \
        unsigned char* sA_ = smem + (buf) * G_LDS_BYTES + ast; unsigned char* sB_ = smem + (buf) * G_LDS_BYTES + G_SA_BYTES + bst; \
        *(h8_t*)(sA_) = R.P##a0; *(h8_t*)(sA_ + 512) = R.P##a1; *(h8_t*)(sA_ + 1024) = R.P##a2; *(h8_t*)(sA_ + 1536) = R.P##a3;    \
        *(h8_t*)(sB_) = R.P##b0; *(h8_t*)(sB_ + (DUAL ? 64 : 16 * GB_RS)) = R.P##b1;                                      \
        *(h8_t*)(sB_ + (DUAL ? 32 * GB_RS : 32 * GB_RS)) = R.P##b2; *(h8_t*)(sB_ + (DUAL ? 32 * GB_RS + 64 : 48 * GB_RS)) = R.P##b3; \
    }
#define LDFRAG(ks, AF, BF)                                                                                              \
    {                                                                                                                   \
        _Pragma("unroll") for (int i = 0; i < 2; ++i) AF[i] = *(const h8_t*)(sA + (2 * (ks) + (lane >> 5)) * GA_CS + (wm * 64 + i * 32 + (lane & 31)) * 16); \
        _Pragma("unroll") for (int j = 0; j < 2; ++j) {                                                                 \
            const int row0 = 16 * (ks) + 8 * (lane >> 5) + ((lane & 15) >> 2);                                          \
            const int col = wn * 64 + j * 32 + 16 * ((lane >> 4) & 1) + 4 * (lane & 3);                                  \
            const s16x4_t lo = __builtin_amdgcn_ds_read_tr16_b64_v4i16((LAS s16x4_t*)(sB + row0 * GB_RS + col * 2));     \
            const s16x4_t hi = __builtin_amdgcn_ds_read_tr16_b64_v4i16((LAS s16x4_t*)(sB + (row0 + 4) * GB_RS + col * 2)); \
            s16x8_t b8; b8[0] = lo[0]; b8[1] = lo[1]; b8[2] = lo[2]; b8[3] = lo[3]; b8[4] = hi[0]; b8[5] = hi[1]; b8[6] = hi[2]; b8[7] = hi[3]; \
            BF[j] = __builtin_bit_cast(h8_t, b8);                                                                       \
        }                                                                                                               \
    }
#define MFMA4(AF, BF)                                                                                                   \
    { _Pragma("unroll") for (int i = 0; i < 2; ++i) _Pragma("unroll") for (int j = 0; j < 2; ++j) acc[i][j] = __builtin_amdgcn_mfma_f32_32x32x16_f16(AF[i], BF[j], acc[i][j], 0, 0, 0); }
#define MFMA_STAGE(buf)                                                                                                 \
    {                                                                                                                   \
        const unsigned char* sA = smem + (buf) * G_LDS_BYTES; const unsigned char* sB = sA + G_SA_BYTES;                  \
        h8_t afA[2], bfA[2], afB[2], bfB[2];                                                                            \
        LDFRAG(0, afA, bfA); __builtin_amdgcn_sched_barrier(0);                                                          \
        LDFRAG(1, afB, bfB); __builtin_amdgcn_sched_barrier(0); MFMA4(afA, bfA); __builtin_amdgcn_sched_barrier(0);      \
        LDFRAG(2, afA, bfA); __builtin_amdgcn_sched_barrier(0); MFMA4(afB, bfB); __builtin_amdgcn_sched_barrier(0);      \
        LDFRAG(3, afB, bfB); __builtin_amdgcn_sched_barrier(0); MFMA4(afA, bfA); __builtin_amdgcn_sched_barrier(0);      \
        MFMA4(afB, bfB);                                                                                                \
    }
    if (!preloaded) { LOADSET(x, 0, cur); if (nkt > 1) LOADSET(y, 1, cur); }
    WAITSET(x, nkt > 1);
    __syncthreads();
    STORESET(x, 0);
    if (nkt > 2) LOADSET(x, 2, cur);
    __syncthreads();
    for (int kt = 0; kt < nkt; kt += 2) {
        if (kt + 1 < nkt) { WAITSET(y, kt + 2 < nkt); STORESET(y, 1); if (kt + 3 < nkt) LOADSET(y, kt + 3, cur); }
        MFMA_STAGE(0);
        __syncthreads();
        if (kt + 1 >= nkt) break;
        if (kt + 2 < nkt) { WAITSET(x, kt + 3 < nkt); STORESET(x, 0); if (kt + 4 < nkt) LOADSET(x, kt + 4, cur); }
        MFMA_STAGE(1);
        __syncthreads();
    }
    if (has_next) { LOADSET(x, 0, nxt); if (nkt > 1) LOADSET(y, 1, nxt); }
#undef MFMA_STAGE
#undef MFMA4
#undef LDFRAG
#undef STORESET
#undef WAITSET
#undef LOADSET
#undef BBASE
#undef PIN4
#undef GLD
    float* T = (float*)smem;
#pragma unroll
    for (int i = 0; i < 2; ++i)
#pragma unroll
        for (int r = 0; r < 16; ++r) {
            const int lr = wm * 64 + i * 32 + (r & 3) + 8 * (r >> 2) + 4 * (lane >> 5);
            if (DUAL) { const float g = acc[i][0][r]; T[lr * GT_P + wn * 32 + (lane & 31)] = g * fsigmoid(g) * acc[i][1][r]; }
            else { T[lr * GT_P + wn * 64 + (lane & 31)] = acc[i][0][r]; T[lr * GT_P + wn * 64 + 32 + (lane & 31)] = acc[i][1][r]; }
        }
    __syncthreads();
    constexpr int CPR = DUAL ? 16 : 32, EB = 4;
    const int c4 = (tid % CPR) * 4;
#pragma unroll 1
    for (int q0 = 0; q0 < 128 * CPR / 256; q0 += EB) {
        EpiLd ld[EB]; float4 tv[EB];
#pragma unroll
        for (int k = 0; k < EB; ++k) ld[k] = ldf((tid + 256 * (q0 + k)) / CPR, c4);
#pragma unroll
        for (int k = 0; k < EB; ++k) tv[k] = *(const float4*)(T + ((tid + 256 * (q0 + k)) / CPR) * GT_P + c4);
        __builtin_amdgcn_sched_barrier(0);
#pragma unroll
        for (int k = 0; k < EB; ++k) epi((tid + 256 * (q0 + k)) / CPR, c4, tv[k], ld[k], T);
    }
    __syncthreads();
}

__device__ __forceinline__ EpiLd rope_ld(int d, int tpos, const float2* __restrict__ ROPE) {
    const int pos = (d & 32) ? (tpos & 63) : (tpos >> 6);
    EpiLd l; l.a = *(const float4*)(ROPE + pos * 16 + (d & 15)); l.b = *(const float4*)(ROPE + pos * 16 + (d & 15) + 2);
    return l;
}
__device__ __forceinline__ float4 rope4(float4 v, float4 o  , int d, const EpiLd& cs) {
    const float4 cs01 = cs.a, cs23 = cs.b;
    float4 r;
    if (d & 16) { r.x = o.x * cs01.y + v.x * cs01.x; r.y = o.y * cs01.w + v.y * cs01.z; r.z = o.z * cs23.y + v.z * cs23.x; r.w = o.w * cs23.w + v.w * cs23.z; }
    else { r.x = v.x * cs01.x - o.x * cs01.y; r.y = v.y * cs01.z - o.y * cs01.w; r.z = v.z * cs23.x - o.z * cs23.y; r.w = v.w * cs23.z - o.w * cs23.w; }
    return r;
}
template <int MODE>
__device__ __forceinline__ void phase_gemm_dense(const Params& p, int tid, int layer, const half_t* A, const half_t* W, int N, int bid, int nb, unsigned char* smem) {
    const int ntn = N / 128, ntiles = (M / 128) * ntn;
    float* XS = wsp<float>(p, WS_XS);
    half_t* Q16 = wsp<half_t>(p, WS_Q16); half_t* K16 = wsp<half_t>(p, WS_K16); half_t* V16 = wsp<half_t>(p, WS_V16);
    half_t* RW = wsp<half_t>(p, WS_RW32);
    const float2* ROPE = wsp<float2>(p, WS_ROPE);
    const int e = layer >> 1;
    const bool xcd_order = (nb & 7) == 0;
    const int nper = 18 * ntn, nslot = nb >> 3;
    const int cv_total = (MOE_CV_CHUNKS + nb * NT - 1) / (nb * NT);
    int cv_done = 0;
    auto tile_of = [=](int it, int& tm, int& tn) -> bool {
        if (xcd_order) {
            const int L = it * nslot + (bid >> 3);
            if (L >= nper) return false;
            const int mg = L / (6 * ntn), rem = L - mg * 6 * ntn;
            tn = rem / 6; tm = (bid & 7) * 18 + mg * 6 + (rem - tn * 6);
        } else {
            const int tile = it * nb + bid;
            if (tile >= ntiles) return false;
            tm = tile / ntn; tn = tile % ntn;
        }
        return true;
    };
    auto make_src = [=](int tm, int tn) -> TileSrc {
        TileSrc T; T.A = A; T.B0 = W + tn * 128; T.B1 = nullptr;
        const int m0 = tm * 128;
        tile_aoff(T, [=](int i) -> long { return m0 + i; }, 1024, tid);
        return T;
    };
    GemmRegs R;
    int tm = 0, tn = 0;
    bool have = tile_of(0, tm, tn), pre = false;
    TileSrc cur = make_src(tm, tn);
    for (int it = 0; have; ++it) {
        int tm2 = 0, tn2 = 0;
        const bool hn = tile_of(it + 1, tm2, tn2);
        const TileSrc nx = make_src(tm2, tn2);
        const int m0 = tm * 128, n0 = tn * 128;
        const int s0 = m0 % SEQA;
        const bool lat = s0 >= NCTX;
        const int jc = (tid & 31) * 4;
        const EpiLd noload = {make_float4(0.f, 0.f, 0.f, 0.f), make_float4(0.f, 0.f, 0.f, 0.f)};
        if (MODE == 1) {
            const float4 g = *(const float4*)(mods_ptr(p, layer, mods_row(m0), 2) + n0 + jc);
            auto ldf = [=](int i, int j) -> EpiLd { EpiLd l; l.a = *(const float4*)(XS + (size_t)(m0 + i) * 1024 + n0 + j); l.b = l.a; return l; };
            auto epi = [=](int i, int j, float4 v, const EpiLd& l, const float*) {
                float4 x = l.a;
                x.x += g.x * v.x; x.y += g.y * v.y; x.z += g.z * v.z; x.w += g.w * v.w;
                *(float4*)(XS + (size_t)(m0 + i) * 1024 + n0 + j) = x;
            };
            gemm_tile_mfma<false>(cur, nx, hn, pre, R, N, 1024, ldf, epi, smem, tid);
        } else if (MODE == 2) {
            const int region = tn >> 3;
            half_t* dstb = (region == 0 ? Q16 : region == 1 ? K16 : V16) + (n0 & 1023);
            const bool dorope = region < 2 && lat;
            auto ldf = [=](int i, int j) -> EpiLd { return dorope ? rope_ld(j & 63, s0 - NCTX + i, ROPE) : noload; };
            auto epi = [=](int i, int j, float4 v, const EpiLd& l, const float* T) {
                if (dorope) v = rope4(v, *(const float4*)(T + i * GT_P + (j ^ 16)), j & 63, l);
                if (region == 0) { v.x *= QSCALE; v.y *= QSCALE; v.z *= QSCALE; v.w *= QSCALE; }
                *(h4_t*)(dstb + (size_t)(m0 + i) * 1024 + j) = to_h4(v);
            };
            gemm_tile_mfma<false>(cur, nx, hn, pre, R, N, 1024, ldf, epi, smem, tid);
        } else {
            const float* gain = (tn == 4 ? p.ev_k_gain : p.ev_q_gain) + e * 64;
            const float4 g = *(const float4*)(gain + (jc & 63)), go = *(const float4*)(gain + ((jc & 63) ^ 16));
            const bool dorope = tn < 5 && lat;
            auto ldf = [=](int i, int j) -> EpiLd { return dorope ? rope_ld(j & 63, s0 - NCTX + i, ROPE) : noload; };
            auto epi = [=](int i, int j, float4 v, const EpiLd& l, const float* T) {
                const int r = m0 + i;
                if (tn >= 6) *(h4_t*)(RW + (size_t)r * 1792 + (n0 - 768) + j) = to_h4(v);
                else if (tn == 5) *(h4_t*)(V16 + (size_t)r * 128 + (n0 - 640) + j) = to_h4(v);
                else {
                    const int d = j & 63;
                    const float ss = sum16(v.x * v.x + v.y * v.y + v.z * v.z + v.w * v.w);
                    const float rstd = rsqrtf(ss * (1.f / 64.f) + 1e-6f);
                    v.x *= rstd * g.x; v.y *= rstd * g.y; v.z *= rstd * g.z; v.w *= rstd * g.w;
                    if (lat) {
                        float4 o = *(const float4*)(T + i * GT_P + (j ^ 16));
                        o.x *= rstd * go.x; o.y *= rstd * go.y; o.z *= rstd * go.z; o.w *= rstd * go.w;
                        v = rope4(v, o, d, l);
                    }
                    if (tn == 4) *(h4_t*)(K16 + (size_t)r * 128 + (n0 - 512) + j) = to_h4(v);
                    else { v.x *= QSCALE; v.y *= QSCALE; v.z *= QSCALE; v.w *= QSCALE; *(h4_t*)(Q16 + (size_t)r * 512 + n0 + j) = to_h4(v); }
                }
            };
            gemm_tile_mfma<false>(cur, nx, hn, pre, R, N, 1024, ldf, epi, smem, tid);
        }
        if (MODE >= 2) { const int q1 = cv_done + 8 < cv_total ? cv_done + 8 : cv_total; convert_moe_steps(smem + LDS_BYTES + 16, layer, tid, bid, nb, cv_done, q1); cv_done = q1; }
        cur = nx; tm = tm2; tn = tn2; have = hn; pre = hn;
    }
    if (MODE >= 2) convert_moe_steps(smem + LDS_BYTES + 16, layer, tid, bid, nb, cv_done, cv_total);
}

__device__ __forceinline__ void phase_prep_even(const Params& p, int tid, int layer, int bid, int nb, unsigned char* smem) {
    constexpr int TK = 16;
    const int e = layer >> 1;
    float* vbuf = (float*)smem;
    float* t1 = vbuf + TK * 512;
    float* t1p = t1 + TK * 32;
    const int t = tid, wid = t >> 6, lane = t & 63;
    const half_t* RW = wsp<half_t>(p, WS_RW32);
    half_t* SR = wsp<half_t>(p, WS_SR); half_t* SV = wsp<half_t>(p, WS_SV); half_t* SKK = wsp<half_t>(p, WS_SKK); half_t* SK = wsp<half_t>(p, WS_SK);
    half_t* VF = wsp<half_t>(p, WS_VF); half_t* LIN = wsp<half_t>(p, WS_LIN16);
    float* mus = t1p + 8 * TK * 32;
    for (int i = t; i < 2 * 1792; i += NT) mus[i] = i < 1792 ? p.ev_mu_prev[e * 1792 + i] : p.ev_mu_next[e * 1792 + i - 1792];
    __syncthreads();
    const float4* MUP = (const float4*)mus + lane; const float4* MUN = (const float4*)(mus + 1792) + lane;
    const float4 kk0 = *(const float4*)(p.ev_k_k + e * 512 + lane * 4), kk1 = *(const float4*)(p.ev_k_k + e * 512 + 256 + lane * 4);
    for (int item = bid; item < M / TK; item += nb) {
        const int r0 = item * TK;
#pragma unroll 1
        for (int q4 = 0; q4 < TK / 4; ++q4) {
            const int tok = q4 * 4 + wid, r = r0 + tok, s = r % SEQA;
            const float fp = (s != 0 && s != NCTX) ? 1.f : 0.f, fn = (s != NCTX - 1 && s != SEQA - 1) ? 1.f : 0.f;
            const h4_t* row = (const h4_t*)(RW + (size_t)r * 1792) + lane;
            const h4_t* rowp = (const h4_t*)(RW + (size_t)(r > 0 ? r - 1 : 0) * 1792) + lane;
            const h4_t* rown = (const h4_t*)(RW + (size_t)(r < M - 1 ? r + 1 : M - 1) * 1792) + lane;
            h4_t ch[7], ph[7], nh[7];
#pragma unroll
            for (int q = 0; q < 7; ++q) { ch[q] = row[64 * q]; ph[q] = rowp[64 * q]; nh[q] = rown[64 * q]; }
            __builtin_amdgcn_sched_barrier(0);
            float4 c[7], pv[7], nx[7];
#pragma unroll
            for (int q = 0; q < 7; ++q) { c[q] = from_h4(ch[q]); pv[q] = from_h4(ph[q]); nx[q] = from_h4(nh[q]); }
#pragma unroll
            for (int q = 0; q < 7; ++q) {
                pv[q].x *= fp; pv[q].y *= fp; pv[q].z *= fp; pv[q].w *= fp;
                nx[q].x *= fn; nx[q].y *= fn; nx[q].z *= fn; nx[q].w *= fn;
            }
            float4 u[7];
#pragma unroll
            for (int q = 0; q < 7; ++q) {
                const float4 mp = MUP[64 * q], mn = MUN[64 * q];
                u[q].x = c[q].x + mp.x * (pv[q].x - c[q].x) + mn.x * (nx[q].x - c[q].x); u[q].y = c[q].y + mp.y * (pv[q].y - c[q].y) + mn.y * (nx[q].y - c[q].y);
                u[q].z = c[q].z + mp.z * (pv[q].z - c[q].z) + mn.z * (nx[q].z - c[q].z); u[q].w = c[q].w + mp.w * (pv[q].w - c[q].w) + mn.w * (nx[q].w - c[q].w);
            }
            const size_t o = (size_t)r * 512 + lane * 4;
            *(h4_t*)(SR + o) = to_h4(u[0]); *(h4_t*)(SR + o + 256) = to_h4(u[1]);
            *(h4_t*)(SK + o) = to_h4(u[2]); *(h4_t*)(SK + o + 256) = to_h4(u[3]);
            {
                float4 a = make_float4(u[2].x * kk0.x, u[2].y * kk0.y, u[2].z * kk0.z, u[2].w * kk0.w), b2 = make_float4(u[3].x * kk1.x, u[3].y * kk1.y, u[3].z * kk1.z, u[3].w * kk1.w);
                const float na = 1.f / fmaxf(sqrtf(sum16(a.x * a.x + a.y * a.y + a.z * a.z + a.w * a.w)), 1e-12f);
                const float nb2 = 1.f / fmaxf(sqrtf(sum16(b2.x * b2.x + b2.y * b2.y + b2.z * b2.z + b2.w * b2.w)), 1e-12f);
                *(h4_t*)(SKK + o) = to_h4(make_float4(a.x * na, a.y * na, a.z * na, a.w * na));
                *(h4_t*)(SKK + o + 256) = to_h4(make_float4(b2.x * nb2, b2.y * nb2, b2.z * nb2, b2.w * nb2));
            }
            if (e == 0) { const h4_t v4 = to_h4(u[4]), v5 = to_h4(u[5]); *(h4_t*)(SV + o) = v4; *(h4_t*)(SV + o + 256) = v5; *(h4_t*)(VF + o) = v4; *(h4_t*)(VF + o + 256) = v5; }
            else { *(float4*)(vbuf + tok * 512 + lane * 4) = u[4]; *(float4*)(vbuf + tok * 512 + 256 + lane * 4) = u[5]; }
            {
                float4 x = u[6];
                if (lane < 16) { x.x = tanhf(x.x); x.y = tanhf(x.y); x.z = tanhf(x.z); x.w = tanhf(x.w); }
                else if (lane >= 32) { x.x = sigmoidf_(x.x); x.y = sigmoidf_(x.y); x.z = sigmoidf_(x.z); x.w = sigmoidf_(x.w); }
                *(h4_t*)(LIN + (size_t)r * 256 + lane * 4) = to_h4(x);
            }
        }
        if (e > 0) {
            __syncthreads();
            {
                const int j = t & 31, cg = t >> 5;
                const float* v1 = p.ev_v1 + (size_t)(e - 1) * 512 * 32 + (size_t)cg * 64 * 32 + j;
                float acc[TK];
#pragma unroll
                for (int tok = 0; tok < TK; ++tok) acc[tok] = 0.f;
#pragma unroll 2
                for (int cc = 0; cc < 64; cc += 8) {
                    float w[8];
#pragma unroll
                    for (int k = 0; k < 8; ++k) w[k] = v1[(cc + k) * 32];
#pragma unroll
                    for (int tok = 0; tok < TK; ++tok) {
                        const float4 xa = *(const float4*)(vbuf + tok * 512 + cg * 64 + cc), xb = *(const float4*)(vbuf + tok * 512 + cg * 64 + cc + 4);
                        acc[tok] += xa.x * w[0] + xa.y * w[1] + xa.z * w[2] + xa.w * w[3] + xb.x * w[4] + xb.y * w[5] + xb.z * w[6] + xb.w * w[7];
                    }
                }
#pragma unroll
                for (int tok = 0; tok < TK; ++tok) t1p[(cg * TK + tok) * 32 + j] = acc[tok];
            }
            __syncthreads();
            for (int o2 = t; o2 < TK * 32; o2 += NT) {
                float a = 0.f;
#pragma unroll
                for (int g = 0; g < 8; ++g) a += t1p[g * TK * 32 + o2];
                t1[o2] = a;
            }
            __syncthreads();
#pragma unroll
            for (int jj = 0; jj < 2; ++jj) {
                const int c = t + 256 * jj;
                const float* v2 = p.ev_v2 + (size_t)(e - 1) * 32 * 512 + c;
                const float v0 = p.ev_v0[(e - 1) * 512 + c];
                float z[TK];
#pragma unroll
                for (int tok = 0; tok < TK; ++tok) z[tok] = v0;
#pragma unroll 2
                for (int j = 0; j < 32; j += 4) {
                    const float w0 = v2[j * 512], w1 = v2[(j + 1) * 512], w2 = v2[(j + 2) * 512], w3 = v2[(j + 3) * 512];
#pragma unroll
                    for (int tok = 0; tok < TK; ++tok) { const float4 tt = *(const float4*)(t1 + tok * 32 + j); z[tok] += tt.x * w0 + tt.y * w1 + tt.z * w2 + tt.w * w3; }
                }
#pragma unroll
                for (int tok = 0; tok < TK; ++tok) {
                    const size_t o = (size_t)(r0 + tok) * 512 + c;
                    const float vv = vbuf[tok * 512 + c];
                    SV[o] = (half_t)(vv + ((float)VF[o] - vv) * sigmoidf_(z[tok]));
                }
            }
            __syncthreads();
        }
    }
}

__device__ __forceinline__ void phase_lora(const Params& p, int tid, int layer, int bid, int nb, unsigned char* smem) {
    const int e = layer >> 1;
    const half_t* LIN = wsp<half_t>(p, WS_LIN16);
    float* SW = wsp<float>(p, WS_SW); half_t* SA = wsp<half_t>(p, WS_SA); half_t* G = wsp<half_t>(p, WS_G);
    constexpr int NTILE = (M / 128) * 4;
    GemmRegs R;
    for (int item = bid; item < 5 * NTILE; item += nb) {
        const int job = item / NTILE, tile = item % NTILE, tm = tile >> 2, tn = tile & 3, m0 = tm * 128, n0 = tn * 128;
        auto rowsrc = [=](int i) -> long { return m0 + i; };
        if (job < 4) {
            const int dr = job & 1;
            const bool isw = job < 2;
            const half_t* W = wsp<half_t>(p, WS_W16) + (isw ? W16_W2 : W16_A2) + ((size_t)(e * 2 + dr) * 64) * 512 + n0;
            const float* bias = (isw ? p.ev_w0 : p.ev_a0) + (e * 2 + dr) * 512 + n0;
            float* dstw = SW + (size_t)dr * M * 512 + n0; half_t* dsta = SA + (size_t)dr * M * 512 + n0;
            TileSrc T; T.A = LIN + (isw ? 0 : 64); T.B0 = W; T.B1 = nullptr; tile_aoff(T, rowsrc, 256, tid);
            const float4 b = *(const float4*)(bias + (tid & 31) * 4);
            auto ldf = [=](int, int) -> EpiLd { return EpiLd{make_float4(0.f, 0.f, 0.f, 0.f), make_float4(0.f, 0.f, 0.f, 0.f)}; };
            auto epi = [=](int i, int j, float4 v, const EpiLd&, const float*) {
                float4 o; o.x = fsigmoid(b.x + v.x); o.y = fsigmoid(b.y + v.y); o.z = fsigmoid(b.z + v.z); o.w = fsigmoid(b.w + v.w);
                if (isw) {
                    constexpr float C = -DECAY_SCALE * 1.4426950408889634f;
                    o.x = __builtin_amdgcn_exp2f(C * o.x); o.y = __builtin_amdgcn_exp2f(C * o.y); o.z = __builtin_amdgcn_exp2f(C * o.z); o.w = __builtin_amdgcn_exp2f(C * o.w);
                }
                if (isw) *(float4*)(dstw + (size_t)(m0 + i) * 512 + j) = o; else *(h4_t*)(dsta + (size_t)(m0 + i) * 512 + j) = to_h4(o);
            };
            gemm_tile_mfma<false>(T, T, false, false, R, 512, 64, ldf, epi, smem, tid);
        } else {
            const half_t* W = wsp<half_t>(p, WS_W16) + W16_G2 + (size_t)e * 128 * 512 + n0;
            TileSrc T; T.A = LIN + 128; T.B0 = W; T.B1 = nullptr; tile_aoff(T, rowsrc, 256, tid);
            auto ldf = [=](int, int) -> EpiLd { return EpiLd{make_float4(0.f, 0.f, 0.f, 0.f), make_float4(0.f, 0.f, 0.f, 0.f)}; };
            auto epi = [=](int i, int j, float4 v, const EpiLd&, const float*) { *(h4_t*)(G + (size_t)(m0 + i) * 512 + n0 + j) = to_h4(v); };
            gemm_tile_mfma<false>(T, T, false, false, R, 512, 128, ldf, epi, smem, tid);
        }
    }
}

template <int MODE>
__device__ __forceinline__ void phase_attn_mfma(const Params& p, int tid, int bid, int nb, unsigned char* smem) {
    constexpr int DV = MODE == 0 ? 64 : 128, NDT = DV / 32, VRS = MODE == 0 ? 192 : 320, KCS = 1040, VCH = DV / 8, NVJ = VCH * 64 / 256;
    unsigned char* sK = smem;
    unsigned char* sV = smem + 8 * KCS;
    const int lane = tid & 63, wid = tid >> 6, h5 = lane >> 5, l31 = lane & 31;
    constexpr int NH = MODE == 0 ? 8 : 16;
    constexpr int NLATU = 8 * NH * 16, NU = NLATU + 8 * NH * 2;
    const half_t* Q16 = wsp<half_t>(p, WS_Q16); const half_t* K16 = wsp<half_t>(p, WS_K16); const half_t* V16 = wsp<half_t>(p, WS_V16);
    constexpr int qstride = MODE == 0 ? 512 : 1024, kstride = MODE == 0 ? 128 : 1024;
    for (int u = bid; u < NU; u += nb) {
        int b, hh, qrow0, nkeys;
        if (u < NLATU) { b = u / (NH * 16); const int rem = u % (NH * 16); hh = rem >> 4; qrow0 = b * SEQA + NCTX + (rem & 15) * 128; nkeys = SEQA; }
        else { const int v = u - NLATU; b = v / (NH * 2); const int rem = v % (NH * 2); hh = rem >> 1; qrow0 = b * SEQA + (rem & 1) * 128; nkeys = NCTX; }
        const int qoff = MODE == 0 ? hh * 64 : (hh >> 1) * 128 + (hh & 1) * 64;
        const int koff = MODE == 0 ? (hh >> 2) * 64 : qoff;
        const int voff = MODE == 0 ? (hh >> 2) * 64 : (hh >> 1) * 128;
        const size_t kbase = (size_t)b * SEQA;
        h8_t qf[4];
        {
            const half_t* qp = Q16 + (size_t)(qrow0 + wid * 32 + l31) * qstride + qoff + 8 * h5;
#pragma unroll
            for (int ks = 0; ks < 4; ++ks) qf[ks] = *(const h8_t*)(qp + 16 * ks);
        }
        f32x16_t o[NDT];
#pragma unroll
        for (int dt = 0; dt < NDT; ++dt)
#pragma unroll
            for (int r = 0; r < 16; ++r) o[dt][r] = 0.f;
        float mref = 0.f, lrun = 0.f;
        h8_t rk[2], rv[NVJ];
#define ATT_LOAD(kt)                                                                                                         \
        {                                                                                                                    \
            _Pragma("unroll") for (int j = 0; j < 2; ++j) { const int i_ = tid + 256 * j;                                     \
                rk[j] = *(const h8_t*)(K16 + (kbase + (kt) * 64 + (i_ >> 3)) * kstride + koff + (i_ & 7) * 8); }              \
            _Pragma("unroll") for (int j = 0; j < NVJ; ++j) { const int i_ = tid + 256 * j;                                   \
                rv[j] = *(const h8_t*)(V16 + (kbase + (kt) * 64 + (i_ / VCH)) * kstride + voff + (i_ % VCH) * 8); }           \
        }
        const int ntile = nkeys >> 6;
        ATT_LOAD(0);
        for (int kt = 0; kt < ntile; ++kt) {
            __syncthreads();
#pragma unroll
            for (int j = 0; j < 2; ++j) { const int i_ = tid + 256 * j; *(h8_t*)(sK + (i_ & 7) * KCS + (i_ >> 3) * 16) = rk[j]; }
#pragma unroll
            for (int j = 0; j < NVJ; ++j) { const int i_ = tid + 256 * j; *(h8_t*)(sV + (i_ / VCH) * VRS + (i_ % VCH) * 16) = rv[j]; }
            __syncthreads();
            if (kt + 1 < ntile) ATT_LOAD(kt + 1);
            f32x16_t sc[2];
#pragma unroll
            for (int kh = 0; kh < 2; ++kh)
#pragma unroll
                for (int r = 0; r < 16; ++r) sc[kh][r] = -mref;
#pragma unroll
            for (int ks = 0; ks < 4; ++ks)
#pragma unroll
                for (int kh = 0; kh < 2; ++kh) {
                    const h8_t kf = *(const h8_t*)(sK + (2 * ks + h5) * KCS + (kh * 32 + l31) * 16);
                    sc[kh] = __builtin_amdgcn_mfma_f32_32x32x16_f16(kf, qf[ks], sc[kh], 0, 0, 0);
                }
            float tmax = sc[0][0];
#pragma unroll
            for (int r = 1; r < 16; ++r) tmax = fmaxf(tmax, sc[0][r]);
#pragma unroll
            for (int r = 0; r < 16; ++r) tmax = fmaxf(tmax, sc[1][r]);
            if (kt == 0 || __any(tmax > 6.0f)) {
                tmax = fmaxf(tmax, __shfl_xor(tmax, 32, 64));
                const float delta = kt == 0 ? tmax : fmaxf(tmax, 0.f);
                const float alpha = kt == 0 ? 1.f : __builtin_amdgcn_exp2f(-delta);
                mref += delta;
                lrun *= alpha;
#pragma unroll
                for (int dt = 0; dt < NDT; ++dt)
#pragma unroll
                    for (int r = 0; r < 16; ++r) o[dt][r] *= alpha;
#pragma unroll
                for (int kh = 0; kh < 2; ++kh)
#pragma unroll
                    for (int r = 0; r < 16; ++r) sc[kh][r] -= delta;
            }
            float psum = 0.f;
#pragma unroll
            for (int kh = 0; kh < 2; ++kh)
#pragma unroll
                for (int r = 0; r < 16; ++r) { const float pv = __builtin_amdgcn_exp2f(sc[kh][r]); sc[kh][r] = pv; psum += pv; }
            lrun += psum;
#pragma unroll
            for (int kh = 0; kh < 2; ++kh)
#pragma unroll
                for (int s2 = 0; s2 < 2; ++s2) {
                    h8_t pf;
#pragma unroll
                    for (int j = 0; j < 8; ++j) pf[j] = (half_t)sc[kh][8 * s2 + j];
                    const int row0 = kh * 32 + 16 * s2 + 4 * h5 + ((lane & 15) >> 2);
#pragma unroll
                    for (int dt = 0; dt < NDT; ++dt) {
                        const int col = dt * 32 + 16 * ((lane >> 4) & 1) + 4 * (lane & 3);
                        const s16x4_t lo = __builtin_amdgcn_ds_read_tr16_b64_v4i16((LAS s16x4_t*)(sV + row0 * VRS + col * 2));
                        const s16x4_t hi = __builtin_amdgcn_ds_read_tr16_b64_v4i16((LAS s16x4_t*)(sV + (row0 + 8) * VRS + col * 2));
                        s16x8_t v8; v8[0] = lo[0]; v8[1] = lo[1]; v8[2] = lo[2]; v8[3] = lo[3]; v8[4] = hi[0]; v8[5] = hi[1]; v8[6] = hi[2]; v8[7] = hi[3];
                        o[dt] = __builtin_amdgcn_mfma_f32_32x32x16_f16(__builtin_bit_cast(h8_t, v8), pf, o[dt], 0, 0, 0);
                    }
                }
        }
#undef ATT_LOAD
        const float ltot = lrun + __shfl_xor(lrun, 32, 64);
        const float inv = 1.f / ltot;
        const int qrow = qrow0 + wid * 32 + l31;
#pragma unroll
        for (int dt = 0; dt < NDT; ++dt)
#pragma unroll
            for (int rg = 0; rg < 4; ++rg) {
                const int d0 = dt * 32 + 8 * rg + 4 * h5;
                if (MODE == 0) {
                    h4_t ov; ov.x = (half_t)(o[dt][4 * rg + 0] * inv); ov.y = (half_t)(o[dt][4 * rg + 1] * inv); ov.z = (half_t)(o[dt][4 * rg + 2] * inv); ov.w = (half_t)(o[dt][4 * rg + 3] * inv);
                    *(h4_t*)(wsp<half_t>(p, WS_MIX16) + (size_t)qrow * 1024 + hh * 64 + d0) = ov;
                } else {
                    const float4 ov = make_float4(o[dt][4 * rg + 0] * inv, o[dt][4 * rg + 1] * inv, o[dt][4 * rg + 2] * inv, o[dt][4 * rg + 3] * inv);
                    *(h4_t*)(wsp<half_t>(p, WS_ATT32) + (((size_t)qrow * 8 + (hh >> 1)) * 2 + (hh & 1)) * 128 + d0) = to_h4(ov);
                }
            }
    }
}

__device__ __forceinline__ void phase_diff_finish(const Params& p, int tid, int layer, int bid, int nb) {
    const int o = layer >> 1, wid = tid >> 6, lane = tid & 63, l31 = lane & 31;
    const float linit = 0.8f - 0.6f * expf(-0.3f * (float)layer);
    const float d1 = wave_sum(p.od_lq1[o * 64 + lane] * p.od_lk1[o * 64 + lane]);
    const float d2 = wave_sum(p.od_lq2[o * 64 + lane] * p.od_lk2[o * 64 + lane]);
    const float lam = expf(d1) - expf(d2) + linit;
    const float4 sl = *(const float4*)(p.od_subln + o * 128 + l31 * 4);
    const half_t* ATT = wsp<half_t>(p, WS_ATT32);
    half_t* MIX = wsp<half_t>(p, WS_MIX16);
    for (int task = bid * 4 + wid; task < M * 4; task += nb * 4) {
        const int r = task >> 2, h = (task & 3) * 2 + (lane >> 5);
        const half_t* a = ATT + ((size_t)r * 8 + h) * 256 + l31 * 4;
        const h4_t x0h = *(const h4_t*)a, x1h = *(const h4_t*)(a + 128);
        const float4 x0 = from_h4(x0h), x1 = from_h4(x1h);
        const float4 v = make_float4(x0.x - lam * x1.x, x0.y - lam * x1.y, x0.z - lam * x1.z, x0.w - lam * x1.w);
        float ss = sum16(v.x * v.x + v.y * v.y + v.z * v.z + v.w * v.w);
        ss += __shfl_xor(ss, 16, 64);
        const float sc = rsqrtf(ss * (1.f / 128.f) + 1e-5f) * (1.f - linit);
        *(h4_t*)(MIX + (size_t)r * 1024 + h * 128 + l31 * 4) = to_h4(make_float4(v.x * sc * sl.x, v.y * sc * sl.y, v.z * sc * sl.z, v.w * sc * sl.w));
    }
}

__device__ __forceinline__ void phase_scan(const Params& p, int tid, int layer, int bid, int nb, unsigned char* smem) {
    const int e = layer >> 1;
    constexpr int CH = 32;
    float* lds = (float*)smem;
    float* Lw = lds;
    float* Lv = lds + 5 * CH * 64;
    float* Ly = Lv + CH * 16;
    const int t = tid, wid = t >> 6, lane = t & 63, rloc = lane >> 4, kq = lane & 15;
    for (int item = bid; item < 512; item += nb) {
        const int chain = item >> 2, rq = item & 3, dir = chain & 1, bh = chain >> 1, b = bh >> 3, h = bh & 7;
        const size_t rowbase = (size_t)b * SEQA;
        const float* SWp = wsp<float>(p, WS_SW) + (size_t)dir * M * 512;
        const half_t* SAp = wsp<half_t>(p, WS_SA) + (size_t)dir * M * 512;
        const half_t* SKp = wsp<half_t>(p, WS_SK); const half_t* SQp = wsp<half_t>(p, WS_SKK); const half_t* SRp = wsp<half_t>(p, WS_SR);
        const half_t* SV = wsp<half_t>(p, WS_SV);
        half_t* YS = wsp<half_t>(p, WS_YSC) + (size_t)dir * M * 512;
        auto tok_of = [=](int i) -> int { return dir == 0 ? i : (i < NCTX ? (NCTX - 1 - i) : (SEQA + NCTX - 1 - i)); };
        const int lf4 = t & 15, lst = t >> 4;
        const float4 ka4 = *(const float4*)(p.ev_k_a + e * 512 + h * 64 + lf4 * 4);
        float4 pw0, pw1; h4_t pa0, pk0, pq0, pr0, pa1, pk1, pq1, pr1, prev;
        pw0 = pw1 = make_float4(0, 0, 0, 0); pa0 = pk0 = pq0 = pr0 = pa1 = pk1 = pq1 = pr1 = prev = (h4_t){0, 0, 0, 0};
#define SCAN_LDP(cc, sto, W_, A_, K_, Q_, R_)                                                                                      \
        {                                                                                                                          \
            const size_t off = (rowbase + tok_of((cc) * CH + lst + (sto))) * 512 + h * 64 + lf4 * 4;                                \
            W_ = *(const float4*)(SWp + off);                                                                                      \
            A_ = *(const h4_t*)(SAp + off);                                                                                        \
            K_ = *(const h4_t*)(SKp + off);                                                                                        \
            Q_ = *(const h4_t*)(SQp + off);                                                                                        \
            R_ = *(const h4_t*)(SRp + off);                                                                                        \
        }
#define SCAN_ISSUE(cc)                                                                                                             \
        {                                                                                                                          \
            SCAN_LDP(cc, 0, pw0, pa0, pk0, pq0, pr0) SCAN_LDP(cc, 16, pw1, pa1, pk1, pq1, pr1)                                      \
            if (t < 128) { const int st = t >> 2, f4 = t & 3; const size_t row = rowbase + tok_of((cc) * CH + st);                  \
                prev = *(const h4_t*)(SV + row * 512 + h * 64 + rq * 16 + f4 * 4); }                                                \
        }
#define SCAN_STP(sto, W_, Ah_, Kh_, Qh_, Rh_)                                                                                      \
        {                                                                                                                          \
            const float4 A_ = from_h4(Ah_), K_ = from_h4(Kh_), Q_ = from_h4(Qh_);                                                   \
            float* d_ = Lw + (lst + (sto)) * 64 + lf4 * 4;                                                                         \
            *(float4*)(d_) = W_;                                                                                                   \
            *(float4*)(d_ + CH * 64) = make_float4(Q_.x * A_.x, Q_.y * A_.y, Q_.z * A_.z, Q_.w * A_.w);                             \
            *(float4*)(d_ + 2 * CH * 64) = make_float4(K_.x * (1.f + (A_.x - 1.f) * ka4.x), K_.y * (1.f + (A_.y - 1.f) * ka4.y),    \
                                                      K_.z * (1.f + (A_.z - 1.f) * ka4.z), K_.w * (1.f + (A_.w - 1.f) * ka4.w));    \
            *(float4*)(d_ + 3 * CH * 64) = Q_;                                                                                     \
            *(float4*)(d_ + 4 * CH * 64) = from_h4(Rh_);                                                                           \
        }
#define SCAN_COMMIT()                                                                                                              \
        {                                                                                                                          \
            SCAN_STP(0, pw0, pa0, pk0, pq0, pr0) SCAN_STP(16, pw1, pa1, pk1, pq1, pr1)                                              \
            if (t < 128) { const int st = t >> 2, f4 = t & 3; *(float4*)(Lv + st * 16 + f4 * 4) = from_h4(prev); }                  \
        }
        typedef float f32x2_t __attribute__((ext_vector_type(2)));
        f32x2_t S01 = {0.f, 0.f}, S23 = {0.f, 0.f};
        SCAN_ISSUE(0);
        SCAN_COMMIT();
        __syncthreads();
        for (int c = 0; c < SEQA / CH; ++c) {
            if (c + 1 < SEQA / CH) SCAN_ISSUE(c + 1);
            float4 nw4 = *(const float4*)(Lw + 0 * CH * 64 + kq * 4), nb4 = *(const float4*)(Lw + 1 * CH * 64 + kq * 4), nd4 = *(const float4*)(Lw + 2 * CH * 64 + kq * 4);
            float4 na4 = *(const float4*)(Lw + 3 * CH * 64 + kq * 4), nr4 = *(const float4*)(Lw + 4 * CH * 64 + kq * 4);
            float nvr = Lv[wid * 4 + rloc];
#pragma unroll 4
            for (int st = 0; st < CH; ++st) {
                const float4 w4 = nw4, b4 = nb4, d4 = nd4, a4 = na4, r4 = nr4;
                const float vr = nvr;
                const int sn = (st + 1 < CH) ? st + 1 : st;
                nw4 = *(const float4*)(Lw + 0 * CH * 64 + sn * 64 + kq * 4);
                nb4 = *(const float4*)(Lw + 1 * CH * 64 + sn * 64 + kq * 4);
                nd4 = *(const float4*)(Lw + 2 * CH * 64 + sn * 64 + kq * 4);
                na4 = *(const float4*)(Lw + 3 * CH * 64 + sn * 64 + kq * 4);
                nr4 = *(const float4*)(Lw + 4 * CH * 64 + sn * 64 + kq * 4);
                nvr = Lv[sn * 16 + wid * 4 + rloc];
                f32x2_t pp = S01 * (f32x2_t){a4.x, a4.y};
                pp = S23 * (f32x2_t){a4.z, a4.w} + pp;
                const float pk = sum16(pp.x + pp.y);
                const f32x2_t t01 = (f32x2_t){d4.x, d4.y} * vr - (f32x2_t){b4.x, b4.y} * pk, t23 = (f32x2_t){d4.z, d4.w} * vr - (f32x2_t){b4.z, b4.w} * pk;
                S01 = S01 * (f32x2_t){w4.x, w4.y} + t01;
                S23 = S23 * (f32x2_t){w4.z, w4.w} + t23;
                f32x2_t yy = S01 * (f32x2_t){r4.x, r4.y};
                yy = S23 * (f32x2_t){r4.z, r4.w} + yy;
                Ly[st * 256 + t] = yy.x + yy.y;
            }
            __syncthreads();
            {
                const int rw = t & 15;
#pragma unroll
                for (int hh = 0; hh < 2; ++hh) {
                    const int st = (t >> 4) + 16 * hh;
                    const float4* pp = (const float4*)(Ly + st * 256 + rw * 16);
                    const float4 a = pp[0], b2 = pp[1], c2 = pp[2], d2 = pp[3];
                    const float y = ((a.x + a.y) + (a.z + a.w)) + ((b2.x + b2.y) + (b2.z + b2.w)) + ((c2.x + c2.y) + (c2.z + c2.w)) + ((d2.x + d2.y) + (d2.z + d2.w));
                    YS[(rowbase + tok_of(c * CH + st)) * 512 + h * 64 + rq * 16 + rw] = (half_t)y;
                }
            }
            if (c + 1 < SEQA / CH) SCAN_COMMIT();
            __syncthreads();
        }
    }
}

__device__ __forceinline__ void phase_readout(const Params& p, int tid, int layer, int bid, int nb) {
    const int e = layer >> 1, wid = tid >> 6, lane = tid & 63;
    const half_t* Y0 = wsp<half_t>(p, WS_YSC); const half_t* Y1 = Y0 + (size_t)M * 512;
    const half_t* SV = wsp<half_t>(p, WS_SV); const half_t* G = wsp<half_t>(p, WS_G);
    const half_t* SR = wsp<half_t>(p, WS_SR); const half_t* SK = wsp<half_t>(p, WS_SK); const half_t* SA0 = wsp<half_t>(p, WS_SA); const half_t* SA1 = SA0 + (size_t)M * 512;
    half_t* MIX = wsp<half_t>(p, WS_MIX16);
    for (int task = bid * 4 + wid; task < M * 2; task += nb * 4) {
        const int r = task >> 1, c = (task & 1) * 256 + lane * 4;
        const size_t o = (size_t)r * 512 + c;
        const h4_t y0h = *(const h4_t*)(Y0 + o), y1h = *(const h4_t*)(Y1 + o);
        const h4_t srh = *(const h4_t*)(SR + o), skh = *(const h4_t*)(SK + o), a0h = *(const h4_t*)(SA0 + o), a1h = *(const h4_t*)(SA1 + o), svh = *(const h4_t*)(SV + o), ggh = *(const h4_t*)(G + o);
        const float4 ka = *(const float4*)(p.ev_k_a + e * 512 + c), rk = *(const float4*)(p.ev_r_k + e * 512 + c);
        const float4 gw = *(const float4*)(p.ev_gn_w + e * 512 + c), gb = *(const float4*)(p.ev_gn_b + e * 512 + c);
        __builtin_amdgcn_sched_barrier(0);
        const float4 y0 = from_h4(y0h), y1 = from_h4(y1h);
        const float4 sr = from_h4(srh), sk = from_h4(skh), a0 = from_h4(a0h), a1 = from_h4(a1h), sv = from_h4(svh), gg = from_h4(ggh);
        const float4 y = make_float4(y0.x + y1.x, y0.y + y1.y, y0.z + y1.z, y0.w + y1.w);
        const float mu = sum16(y.x + y.y + y.z + y.w) * (1.f / 64.f);
        const float4 d = make_float4(y.x - mu, y.y - mu, y.z - mu, y.w - mu);
        const float var = sum16(d.x * d.x + d.y * d.y + d.z * d.z + d.w * d.w) * (1.f / 64.f);
        const float bonus = sum16(sr.x * sk.x * rk.x * (2.f + (a0.x + a1.x - 2.f) * ka.x) + sr.y * sk.y * rk.y * (2.f + (a0.y + a1.y - 2.f) * ka.y)
                                + sr.z * sk.z * rk.z * (2.f + (a0.z + a1.z - 2.f) * ka.z) + sr.w * sk.w * rk.w * (2.f + (a0.w + a1.w - 2.f) * ka.w));
        const float rs = rsqrtf(var + GN_EPS);
        float4 out;
        out.x = (d.x * rs * gw.x + gb.x + bonus * sv.x) * gg.x; out.y = (d.y * rs * gw.y + gb.y + bonus * sv.y) * gg.y;
        out.z = (d.z * rs * gw.z + gb.z + bonus * sv.z) * gg.z; out.w = (d.w * rs * gw.w + gb.w + bonus * sv.w) * gg.w;
        *(h4_t*)(MIX + (size_t)r * 1024 + 512 + c) = to_h4(out);
    }
}

typedef float f32x4v_t __attribute__((ext_vector_type(4)));
__device__ __forceinline__ void phase_route(const Params& p, int tid, int layer, int bid, int nb, unsigned char* smem) {
    constexpr int RB = 16, HP = 1028;
    float* hbuf = (float*)smem;
    float* lg = hbuf + RB * HP;
    float* part = hbuf;
    const int t = tid, wid = t >> 6, lane = t & 63;
    const bool last = (layer == DEPTH - 1);
    const int shard = bid & (NSHARD - 1);
    int* cnt = wsp<int>(p, WS_CNT) + (layer * NSHARD + shard) * 32;
    int* list = wsp<int>(p, WS_LIST);
    float* GATE = wsp<float>(p, WS_GATE); int* ESLOT = wsp<int>(p, WS_ESLOT);
    const f32x4v_t* WRl = (const f32x4v_t*)(wsp<float>(p, WS_WR)) + (size_t)layer * 64 * 3 * 64 + lane;
    for (int rg = bid; rg < M / RB; rg += nb) {
        const int r0 = rg * RB;
        if (last && (r0 % SEQA) < NCTX) continue;
        {
            float4 v[4][4], ma[4], mb[4]; float ss[4];
#pragma unroll
            for (int q = 0; q < 4; ++q) {
                const float4* xr = (const float4*)(wsp<float>(p, WS_XS) + (size_t)(r0 + wid * 4 + q) * 1024);
#pragma unroll
                for (int j = 0; j < 4; ++j) v[q][j] = xr[lane + 64 * j];
            }
            mods_load(p, layer, r0, 3, lane, ma, mb);
            __builtin_amdgcn_sched_barrier(0);
#pragma unroll
            for (int q = 0; q < 4; ++q) {
                float a = 0.f;
#pragma unroll
                for (int j = 0; j < 4; ++j) a += v[q][j].x * v[q][j].x + v[q][j].y * v[q][j].y + v[q][j].z * v[q][j].z + v[q][j].w * v[q][j].w;
                ss[q] = wave_sum(a);
            }
#pragma unroll
            for (int q = 0; q < 4; ++q) norm_row_store(p, r0 + wid * 4 + q, v[q], ss[q], lane, hbuf + (wid * 4 + q) * HP, ma, mb);
        }
        __syncthreads();
        {
            f32x4v_t acc0 = {0.f, 0.f, 0.f, 0.f}, acc1 = {0.f, 0.f, 0.f, 0.f}, acc2 = {0.f, 0.f, 0.f, 0.f};
            const float* ap = hbuf + (lane & 15) * HP + 4 * (lane >> 4) + wid * 256;
            const f32x4v_t* bp = WRl + (size_t)wid * 16 * 3 * 64;
            f32x4v_t W[18];
#pragma unroll
            for (int S = 0; S < 6; ++S) { W[S * 3] = bp[S * 192]; W[S * 3 + 1] = bp[S * 192 + 64]; W[S * 3 + 2] = bp[S * 192 + 128]; }
            __builtin_amdgcn_sched_barrier(0);
#pragma unroll
            for (int S = 0; S < 16; ++S) {
                const int sl = (S % 6) * 3;
                const float4 a = *(const float4*)(ap + 16 * S);
                acc0 = __builtin_amdgcn_mfma_f32_16x16x4f32(a.x, W[sl][0], acc0, 0, 0, 0); acc1 = __builtin_amdgcn_mfma_f32_16x16x4f32(a.x, W[sl + 1][0], acc1, 0, 0, 0); acc2 = __builtin_amdgcn_mfma_f32_16x16x4f32(a.x, W[sl + 2][0], acc2, 0, 0, 0);
                acc0 = __builtin_amdgcn_mfma_f32_16x16x4f32(a.y, W[sl][1], acc0, 0, 0, 0); acc1 = __builtin_amdgcn_mfma_f32_16x16x4f32(a.y, W[sl + 1][1], acc1, 0, 0, 0); acc2 = __builtin_amdgcn_mfma_f32_16x16x4f32(a.y, W[sl + 2][1], acc2, 0, 0, 0);
                acc0 = __builtin_amdgcn_mfma_f32_16x16x4f32(a.z, W[sl][2], acc0, 0, 0, 0); acc1 = __builtin_amdgcn_mfma_f32_16x16x4f32(a.z, W[sl + 1][2], acc1, 0, 0, 0); acc2 = __builtin_amdgcn_mfma_f32_16x16x4f32(a.z, W[sl + 2][2], acc2, 0, 0, 0);
                acc0 = __builtin_amdgcn_mfma_f32_16x16x4f32(a.w, W[sl][3], acc0, 0, 0, 0); acc1 = __builtin_amdgcn_mfma_f32_16x16x4f32(a.w, W[sl + 1][3], acc1, 0, 0, 0); acc2 = __builtin_amdgcn_mfma_f32_16x16x4f32(a.w, W[sl + 2][3], acc2, 0, 0, 0);
                __builtin_amdgcn_sched_barrier(0);
                if (S + 6 < 16) { W[sl] = bp[(S + 6) * 192]; W[sl + 1] = bp[(S + 6) * 192 + 64]; W[sl + 2] = bp[(S + 6) * 192 + 128]; __builtin_amdgcn_sched_barrier(0); }
            }
            __syncthreads();
#pragma unroll
            for (int rgi = 0; rgi < 4; ++rgi) {
                const int rr = 4 * (lane >> 4) + rgi, cc = lane & 15;
                part[((wid * 3 + 0) * 16 + rr) * 16 + cc] = acc0[rgi]; part[((wid * 3 + 1) * 16 + rr) * 16 + cc] = acc1[rgi]; part[((wid * 3 + 2) * 16 + rr) * 16 + cc] = acc2[rgi];
            }
        }
        __syncthreads();
        for (int o = t; o < RB * 36; o += NT) {
            const int rr = o / 36, cc = o % 36;
            const int ct = cc < 4 ? 2 : (cc - 4) >> 4, col = cc < 4 ? cc : (cc - 4) & 15;
            float sacc = cc < 4 ? p.moe_b_grp[layer * 4 + cc] : p.moe_b_rt[layer * 32 + cc - 4];
#pragma unroll
            for (int g = 0; g < 4; ++g) sacc += part[((g * 3 + ct) * 16 + rr) * 16 + col];
            lg[o] = sacc;
        }
        __syncthreads();
        if (t < RB) {
            const int r = r0 + t;
            const float* L = lg + t * 36;
            int sel = 0; float mx = L[0];
            for (int g = 1; g < 4; ++g) if (L[g] > mx) { mx = L[g]; sel = g; }
            float z = 0.f;
            for (int g = 0; g < 4; ++g) z += expf(L[g] - mx);
            const float grp_w = 1.f / z;
            const float* E = L + 4 + sel * 8;
            int i1 = 0; float v1 = E[0];
            for (int j = 1; j < 8; ++j) if (E[j] > v1) { v1 = E[j]; i1 = j; }
            int i2 = -1; float v2 = -INFINITY;
            for (int j = 0; j < 8; ++j) if (j != i1 && E[j] > v2) { v2 = E[j]; i2 = j; }
            const float e2 = expf(v2 - v1);
            const float g1 = grp_w / (1.f + e2), g2 = grp_w * e2 / (1.f + e2);
            const int ea = sel * 8 + i1, eb = sel * 8 + i2;
            const int pa = atomicAdd(&cnt[ea], 1);
            const int pb = atomicAdd(&cnt[eb], 1);
            list[(size_t)ea * LISTCAP + shard * SHCAP + pa] = r;
            list[(size_t)eb * LISTCAP + shard * SHCAP + pb] = r;
            GATE[r * 2 + 0] = g1; GATE[r * 2 + 1] = g2;
            ESLOT[r * 2 + 0] = (ea << 16) | (shard << 13) | pa; ESLOT[r * 2 + 1] = (eb << 16) | (shard << 13) | pb;
        }
        __syncthreads();
    }
}

template <int TM>
__device__ __forceinline__ void moe_tables(const Params& p, int tid, int layer, int* tab  ) {
    if (tid < 32) {
        const int* cnt = wsp<int>(p, WS_CNT) + layer * NSHARD * 32;
        int cs[NSHARD];
#pragma unroll
        for (int sh = 0; sh < NSHARD; ++sh) cs[sh] = cnt[sh * 32 + tid];
        __builtin_amdgcn_sched_barrier(0);
        int tot = 0;
#pragma unroll
        for (int sh = 0; sh < NSHARD; ++sh) { tab[97 + tid * NSHARD + sh] = tot; tot += cs[sh]; }
        tab[tid] = tot;
    }
    __syncthreads();
    if (tid == 0) {
        int ts = 0;
        for (int e = 0; e < 32; ++e) { const int c = tab[e]; tab[32 + e] = ts; tab[65 + e] = ts * TM; ts += (c + TM - 1) / TM; }
        tab[64] = ts;
    }
    __syncthreads();
}
constexpr int MOE_TM = 128;
constexpr int MOE_TAB_OFF = 2 * G_LDS_BYTES + 128;
__device__ __forceinline__ void moe_item(const int* tab, int rb, int& e, int& lb, int& orow0) {
    e = 0;
    while (e < 31 && tab[32 + e + 1] <= rb) ++e;
    lb = rb - tab[32 + e]; orow0 = tab[65 + e] + lb * MOE_TM;
}
__device__ __forceinline__ void phase_moe1(const Params& p, int tid, int layer, int bid, int nb, unsigned char* smem) {
    constexpr int TM = MOE_TM;
    int* tab = (int*)(smem + MOE_TAB_OFF);
    moe_tables<TM>(p, tid, layer, tab);
    const int nrb = tab[64], nitems = nrb * 8;
    const half_t* H16 = wsp<half_t>(p, WS_H16);
    half_t* HM = wsp<half_t>(p, WS_HM16);
    const int* list = wsp<int>(p, WS_LIST);
    const half_t* W16 = wsp<half_t>(p, WS_W16);
    auto make_src = [=](int item) -> TileSrc {
        const int rb = item >> 3, nt = item & 7;
        int e, lb, orow0; moe_item(tab, rb, e, lb, orow0);
        const int cnt = tab[e];
        const int* le = list + (size_t)e * LISTCAP;
        const int* sb = tab + 97 + e * NSHARD;
        TileSrc T; T.A = H16;
        T.B0 = W16 + W16_MOE_GATE + (size_t)e * 1024 * 512 + nt * 64; T.B1 = W16 + W16_MOE_UP + (size_t)e * 1024 * 512 + nt * 64;
        tile_aoff(T, [=](int i) -> long {
            const int pos = lb * TM + i;
            if (pos >= cnt) return -1L;
            int sh = 0;
#pragma unroll
            for (int q = 1; q < NSHARD; ++q) sh += (sb[q] <= pos) ? 1 : 0;
            return (long)le[sh * SHCAP + pos - sb[sh]];
        }, 1024, tid);
        return T;
    };
    GemmRegs R;
    bool pre = false;
    if (bid < nitems) {
        TileSrc cur = make_src(bid);
        for (int item = bid; item < nitems; item += nb) {
            const bool hn = item + nb < nitems;
            const TileSrc nx = hn ? make_src(item + nb) : cur;
            const int rb = item >> 3, nt = item & 7;
            int e, lb, orow0; moe_item(tab, rb, e, lb, orow0);
            auto ldf = [=](int, int) -> EpiLd { return EpiLd{make_float4(0.f, 0.f, 0.f, 0.f), make_float4(0.f, 0.f, 0.f, 0.f)}; };
            auto epi = [=](int i, int j, float4 v, const EpiLd&, const float*) { *(h4_t*)(HM + (size_t)(orow0 + i) * 512 + nt * 64 + j) = to_h4(v); };
            gemm_tile_mfma<true>(cur, nx, hn, pre, R, 512, 1024, ldf, epi, smem, tid);
            cur = nx; pre = hn;
        }
    }
}
__device__ __forceinline__ void phase_moe2(const Params& p, int tid, int layer, int bid, int nb, unsigned char* smem) {
    constexpr int TM = MOE_TM, TN = 128, NTN = 1024 / TN;
    int* tab = (int*)(smem + MOE_TAB_OFF);
    moe_tables<TM>(p, tid, layer, tab);
    const int nrb = tab[64], nitems = nrb * NTN;
    const half_t* HM = wsp<half_t>(p, WS_HM16);
    half_t* YO = wsp<half_t>(p, WS_YOUT);
    const half_t* W16 = wsp<half_t>(p, WS_W16);
    auto make_src = [=](int item) -> TileSrc {
        const int rb = item / NTN, nt = item % NTN;
        int e, lb, orow0; moe_item(tab, rb, e, lb, orow0);
        TileSrc T; T.A = HM; T.B0 = W16 + W16_MOE_DOWN + (size_t)e * 512 * 1024 + nt * TN; T.B1 = nullptr;
        tile_aoff(T, [=](int i) -> long { return orow0 + i; }, 512, tid);
        return T;
    };
    GemmRegs R;
    bool pre = false;
    if (bid < nitems) {
        TileSrc cur = make_src(bid);
        for (int item = bid; item < nitems; item += nb) {
            const bool hn = item + nb < nitems;
            const TileSrc nx = hn ? make_src(item + nb) : cur;
            const int rb = item / NTN, nt = item % NTN;
            int e, lb, orow0; moe_item(tab, rb, e, lb, orow0);
            auto ldf = [=](int, int) -> EpiLd { return EpiLd{make_float4(0.f, 0.f, 0.f, 0.f), make_float4(0.f, 0.f, 0.f, 0.f)}; };
            auto epi = [=](int i, int j, float4 v, const EpiLd&, const float*) { *(h4_t*)(YO + (size_t)(orow0 + i) * 1024 + nt * TN + j) = to_h4(v); };
            gemm_tile_mfma<false>(cur, nx, hn, pre, R, 1024, 512, ldf, epi, smem, tid);
            cur = nx; pre = hn;
        }
    }
}

__device__ __forceinline__ void phase_combine(const Params& p, int tid, int layer, int bid, int nb, unsigned char* smem) {
    constexpr int TM = MOE_TM;
    int* tab = (int*)smem;
    moe_tables<TM>(p, tid, layer, tab);
    const int wid = tid >> 6, lane = tid & 63;
    const bool last = (layer == DEPTH - 1);
    const float* GATE = wsp<float>(p, WS_GATE); const int* ESLOT = wsp<int>(p, WS_ESLOT);
    const half_t* YO = wsp<half_t>(p, WS_YOUT);
    int rfirst = bid * 4 + wid;
    int es0n = 0, es1n = 0; float g0n = 0.f, g1n = 0.f;
    if (rfirst < M) { es0n = ESLOT[rfirst * 2]; es1n = ESLOT[rfirst * 2 + 1]; g0n = GATE[rfirst * 2]; g1n = GATE[rfirst * 2 + 1]; }
    for (int r = rfirst; r < M; r += nb * 4) {
        const int b = r / SEQA, s = r - b * SEQA;
        const int es0 = es0n, es1 = es1n; const float g0 = g0n, g1 = g1n;
        { const int rn = r + nb * 4; if (rn < M) { es0n = ESLOT[rn * 2]; es1n = ESLOT[rn * 2 + 1]; g0n = GATE[rn * 2]; g1n = GATE[rn * 2 + 1]; } }
        if (last && s < NCTX) continue;
        const size_t s0 = (size_t)(tab[65 + (es0 >> 16)] + tab[97 + (es0 >> 16) * NSHARD + ((es0 >> 13) & 7)] + (es0 & 8191)), s1 = (size_t)(tab[65 + (es1 >> 16)] + tab[97 + (es1 >> 16) * NSHARD + ((es1 >> 13) & 7)] + (es1 & 8191));
        float4* xr = (float4*)(wsp<float>(p, WS_XS) + (size_t)r * 1024);
        const h4_t* y0 = (const h4_t*)(YO + s0 * 1024); const h4_t* y1 = (const h4_t*)(YO + s1 * 1024);
        const float4* m5 = (const float4*)mods_ptr(p, layer, mods_row(r), 5);
        float4 ma[4], mb[4];
        float4 v[4], xg[4], gg[4]; h4_t ya[4], yb[4]; float ss = 0.f;
#pragma unroll
        for (int j = 0; j < 4; ++j) { xg[j] = xr[lane + 64 * j]; gg[j] = m5[lane + 64 * j]; ya[j] = y0[lane + 64 * j]; yb[j] = y1[lane + 64 * j]; }
        if (!last) mods_load(p, layer + 1, r, 0, lane, ma, mb);
        else {
#pragma unroll
            for (int j = 0; j < 4; ++j) { ma[j] = ((const float4*)p.final_gain)[lane + 64 * j]; mb[j] = ma[j]; }
        }
        __builtin_amdgcn_sched_barrier(0);
#pragma unroll
        for (int j = 0; j < 4; ++j) {
            const float4 x = xg[j], g = gg[j]; const h4_t ah = ya[j], ch = yb[j];
            const float4 a = make_float4((float)ah.x, (float)ah.y, (float)ah.z, (float)ah.w), c = make_float4((float)ch.x, (float)ch.y, (float)ch.z, (float)ch.w);
            float4 o;
            o.x = x.x + g.x * (g0 * a.x + g1 * c.x); o.y = x.y + g.y * (g0 * a.y + g1 * c.y);
            o.z = x.z + g.z * (g0 * a.z + g1 * c.z); o.w = x.w + g.w * (g0 * a.w + g1 * c.w);
            v[j] = o; ss += o.x * o.x + o.y * o.y + o.z * o.z + o.w * o.w;
        }
        ss = wave_sum(ss);
        if (!last) {
#pragma unroll
            for (int j = 0; j < 4; ++j) xr[lane + 64 * j] = v[j];
            norm_row_store(p, r, v, ss, lane, nullptr, ma, mb);
        } else {
            const float rstd = rsqrtf(ss * (1.f / 1024.f) + 1e-6f);
            float4* dst = (float4*)(p.out + ((size_t)(b * NLAT + s - NCTX)) * 1024);
#pragma unroll
            for (int j = 0; j < 4; ++j) { const float4 g = ma[j]; float4 o; o.x = v[j].x * rstd * g.x; o.y = v[j].y * rstd * g.y; o.z = v[j].z * rstd * g.z; o.w = v[j].w * rstd * g.w; dst[lane + 64 * j] = o; }
        }
    }
}


#define XB_TMO      128
#define XB_XCNT(j)  (256  + 64 * (j))
#define XB_XSUB(j)  (1280 + 64 * (j))
#define XB_XGEN(j)  (2304 + 64 * (j))
#define XB_TOP      3328
#define XB_TOPGEN   3392
#define XCD_BAR_WORDS 3456
#define XB_SPIN_CAP (1u << 22)

__device__ __forceinline__ unsigned xb_ld(unsigned* p)              { return __hip_atomic_load(p, __ATOMIC_RELAXED, __HIP_MEMORY_SCOPE_AGENT); }
__device__ __forceinline__ unsigned xb_add(unsigned* p, unsigned v) { return __hip_atomic_fetch_add(p, v, __ATOMIC_RELAXED, __HIP_MEMORY_SCOPE_AGENT); }
__device__ __forceinline__ unsigned xb_xcc_id() { return (unsigned)__builtin_amdgcn_s_getreg((3 << 11) | 20) & 0xFu; }
#define XB_SPIN(cond, bar) do { unsigned _sp = 0; while (cond) { __builtin_amdgcn_s_sleep(1); \
    if ((++_sp & 255u) == 0u) { if (xb_ld(&(bar)[XB_TMO])) break; if (_sp > XB_SPIN_CAP) { atomicAdd(&(bar)[XB_TMO], 1u); break; } } } } while (0)

struct XcdBarrier {
    unsigned* bar; unsigned x;
    volatile LAS unsigned* st;
};
__device__ __forceinline__ XcdBarrier xcd_barrier_post(unsigned* bar, volatile LAS unsigned* st) {
    XcdBarrier b; b.bar = bar; b.x = xb_xcc_id(); b.st = st;
    if (threadIdx.x == 0) (void)xb_add(&bar[XB_XCNT(b.x)], 1u);
    return b;
}
__device__ __forceinline__ void xcd_barrier_complete(unsigned* bar, unsigned x, unsigned& nloc, unsigned& nx) {
    const unsigned G = gridDim.x * gridDim.y * gridDim.z;
    unsigned sum, cnt, mine, sp = 0u;
    for (;;) {
        sum = 0u; cnt = 0u; mine = 0u;
#pragma unroll
        for (unsigned j = 0; j < 16; ++j) { const unsigned c = xb_ld(&bar[XB_XCNT(j)]); sum += c; cnt += (c > 0u) ? 1u : 0u; mine = (j == x) ? c : mine; }
        if (sum == G) break;
        __builtin_amdgcn_s_sleep(1);
        if ((++sp & 255u) == 0u) { if (xb_ld(&bar[XB_TMO])) break; if (sp > XB_SPIN_CAP) { atomicAdd(&bar[XB_TMO], 1u); break; } }
    }
    nloc = mine > 0u ? mine : 1u; nx = cnt > 0u ? cnt : 1u;
}
__device__ __forceinline__ void xcd_barrier(const XcdBarrier& b) {
    asm volatile("s_waitcnt vmcnt(0)" ::: "memory");
    __syncthreads();
    if (threadIdx.x == 0) {
        unsigned* bar = b.bar;
        __builtin_amdgcn_s_waitcnt(0);
        unsigned nloc = b.st[0], nx = b.st[1];
        if (nloc == 0u) { xcd_barrier_complete(bar, b.x, nloc, nx); b.st[0] = nloc; b.st[1] = nx; }
        const unsigned old = xb_add(&bar[XB_XSUB(b.x)], 1u);
        const unsigned gen = old / nloc;
        if (old + 1u == (gen + 1u) * nloc) {
            __builtin_amdgcn_fence(__ATOMIC_RELEASE, "agent");
            asm volatile("s_waitcnt vmcnt(0)" ::: "memory");
            const unsigned og = xb_add(&bar[XB_TOP], 1u);
            const unsigned tg = og / nx;
            if (og + 1u == (tg + 1u) * nx) xb_add(&bar[XB_TOPGEN], 1u);
            else XB_SPIN(xb_ld(&bar[XB_TOPGEN]) == tg, bar);
            __builtin_amdgcn_fence(__ATOMIC_ACQUIRE, "agent");
            xb_add(&bar[XB_XGEN(b.x)], 1u);
            asm volatile("s_waitcnt vmcnt(0)" ::: "memory");
        } else {
            XB_SPIN(xb_ld(&bar[XB_XGEN(b.x)]) == gen, bar);
            __builtin_amdgcn_fence(__ATOMIC_ACQUIRE, "agent");
            asm volatile("s_waitcnt vmcnt(0)" ::: "memory");
        }
    }
    __syncthreads();
}

enum { PH_MODS = 0, PH_COPY, PH_NORM1, PH_GEMM_IN, PH_PREP, PH_ATTN, PH_SCAN, PH_POST, PH_GEMM_OUT, PH_ROUTE, PH_MOE1, PH_MOE2, PH_COMBINE, PH_LORA };

template <int PH>
__device__ __forceinline__ void run_phase(const Params& p, int tid, int layer, int bid, int nb, unsigned char* smem) {
    const bool even = (layer & 1) == 0;
    const int e = layer >> 1;
    if (PH == PH_MODS) phase_mods(p, tid, bid, nb, smem);
    else if (PH == PH_COPY) {
        convert_dense_weights(p, tid, bid, nb);
        float* WR = wsp<float>(p, WS_WR);
        for (int i = bid * NT + tid; i < 4 * 64 * 3 * 64 * 4; i += nb * NT) {
            const int sp = i & 3, ln = (i >> 2) & 63, rest = i >> 8, ct = rest % 3, S = (rest / 3) & 63, ly = rest / (3 * 64);
            const int k = 16 * S + 4 * (ln >> 4) + sp, j = ln & 15;
            float v = 0.f;
            if (ct < 2) v = p.moe_w_rt[((size_t)ly * 1024 + k) * 32 + ct * 16 + j];
            else if (j < 4) v = p.moe_w_grp[((size_t)ly * 1024 + k) * 4 + j];
            WR[i] = v;
        }
    }
    else if (PH == PH_NORM1) phase_norm1(p, tid, layer, bid, nb);
    else if (PH == PH_GEMM_IN) {
        const half_t* W16 = wsp<half_t>(p, WS_W16);
        if (even) phase_gemm_dense<3>(p, tid, layer, wsp<half_t>(p, WS_H16), W16 + W16_EV_IN + (size_t)e * 1024 * EVEN_COLS, EVEN_COLS, bid, nb, smem);
        else phase_gemm_dense<2>(p, tid, layer, wsp<half_t>(p, WS_H16), W16 + W16_OD_IN + (size_t)e * 1024 * ODD_COLS, ODD_COLS, bid, nb, smem);
    } else if (PH == PH_PREP) { if (even) phase_prep_even(p, tid, layer, bid, nb, smem); }
    else if (PH == PH_ATTN) {
        if (even) phase_attn_mfma<0>(p, tid, bid, nb, smem); else phase_attn_mfma<1>(p, tid, bid, nb, smem);
    }
    else if (PH == PH_LORA) { if (even) phase_lora(p, tid, layer, bid, nb, smem); }
    else if (PH == PH_SCAN) { if (even) phase_scan(p, tid, layer, bid, nb, smem); }
    else if (PH == PH_POST) { if (even) phase_readout(p, tid, layer, bid, nb); else phase_diff_finish(p, tid, layer, bid, nb); }
    else if (PH == PH_GEMM_OUT) phase_gemm_dense<1>(p, tid, layer, wsp<half_t>(p, WS_MIX16), wsp<half_t>(p, WS_W16) + (even ? W16_EV_OUT : W16_OD_OUT) + (size_t)e * 1024 * 1024, 1024, bid, nb, smem);
    else if (PH == PH_ROUTE) phase_route(p, tid, layer, bid, nb, smem);
    else if (PH == PH_MOE1) phase_moe1(p, tid, layer, bid, nb, smem);
    else if (PH == PH_MOE2) phase_moe2(p, tid, layer, bid, nb, smem);
    else if (PH == PH_COMBINE) phase_combine(p, tid, layer, bid, nb, smem);
}

template <int PH>
__global__ void __launch_bounds__(NT, 2) k_phase(Params p, int layer) {
    extern __shared__ __attribute__((aligned(16))) unsigned char smem[];
    run_phase<PH>(p, threadIdx.x, layer, blockIdx.x, gridDim.x, smem);
}

__device__ __forceinline__ unsigned* load_bar_ptr(const unsigned char* tab) {
    const LAS unsigned* t = (const LAS unsigned*)tab;
    const unsigned lo = __builtin_amdgcn_readfirstlane(t[2 * 41]), hi = __builtin_amdgcn_readfirstlane(t[2 * 41 + 1]);
    const unsigned long long u = (((unsigned long long)hi << 32) | lo) + WS_BAR;
    return (unsigned*)(__attribute__((address_space(1))) unsigned*)u;
}
#ifndef PROBE_BAR2
#define PROBE_BAR2 0
#endif
#define GRID_BARRIER() { if (PROBE_BAR2) { XcdBarrier b3_; b3_.bar = load_bar_ptr(smem + LDS_BYTES + 16); b3_.x = xb_xcc_id(); b3_.st = (volatile LAS unsigned*)(smem + LDS_BYTES); xcd_barrier(b3_); } XcdBarrier b2_; b2_.bar = load_bar_ptr(smem + LDS_BYTES + 16); b2_.x = xb_xcc_id(); b2_.st = (volatile LAS unsigned*)(smem + LDS_BYTES); xcd_barrier(b2_); }
#ifndef PROBE_MASK
#define PROBE_MASK 0u
#endif
#define RUN1(PH, layer) { int tid_ = threadIdx.x; asm volatile("" : "+v"(tid_)); int bid_ = bid; asm volatile("" : "+s"(bid_)); unsigned lo_ = 0; asm volatile("" : "+s"(lo_)); \
    unsigned char* smem_ = smem + lo_; const Params q = load_params(smem_ + LDS_BYTES + 16); run_phase<PH>(q, tid_, layer, bid_, nb, smem_); }
#define RUN(PH, layer) { if ((PROBE_MASK >> PH) & 1u) { RUN1(PH, layer); __syncthreads(); } RUN1(PH, layer); }
#ifndef PROBE_STAMP
#define PROBE_STAMP -1
#endif
#ifndef PROBE_MULT
#define PROBE_MULT 1
#endif
#define STAMP(id) { if (PROBE_STAMP >= 0 && threadIdx.x == 0 && bid == 0) { volatile LAS unsigned long long* st_ = (volatile LAS unsigned long long*)(smem + LDS_BYTES + 16 + NPTR * 8); \
    const unsigned long long now_ = wall_clock64(); if ((id) == PROBE_STAMP) st_[1] += now_ - st_[0]; st_[0] = now_; } }
__global__ void __launch_bounds__(NT, 2) k_mega(Params p) {
    extern __shared__ __attribute__((aligned(16))) unsigned char smem[];
    const int bid = blockIdx.x, nb = gridDim.x;
    if (threadIdx.x == 0) *(uint4*)(smem + LDS_BYTES) = make_uint4(0u, 0u, 0u, 0u);
    {
        unsigned long long v[NPTR];
        __builtin_memcpy(v, &p, sizeof(Params));
        unsigned long long* tab = (unsigned long long*)(smem + LDS_BYTES + 16);
        if (threadIdx.x == 0) {
#pragma unroll
            for (int i = 0; i < NPTR; ++i) tab[i] = v[i];
            if (PROBE_STAMP >= 0) { tab[NPTR] = wall_clock64(); tab[NPTR + 1] = 0ull; }
        }
    }
    unsigned* barw = (unsigned*)(p.ws + WS_BAR);
    __syncthreads();
    (void)xcd_barrier_post(barw, (volatile LAS unsigned*)(smem + LDS_BYTES));
    RUN(PH_MODS, 0);
    RUN(PH_COPY, 0);
    GRID_BARRIER();
    STAMP(12);
    RUN(PH_NORM1, 0);
    GRID_BARRIER();
    STAMP(10);
#pragma unroll 1
    for (int layer = 0; layer < DEPTH; ++layer) {
        RUN(PH_GEMM_IN, layer);
        GRID_BARRIER();
        STAMP(0);
        RUN(PH_ATTN, layer);
        if ((layer & 1) == 0) {
            RUN(PH_PREP, layer);
            GRID_BARRIER();
            STAMP(1);
            RUN(PH_LORA, layer);
            GRID_BARRIER();
            STAMP(2);
            RUN(PH_SCAN, layer);
            GRID_BARRIER();
            STAMP(3);
        } else {
            GRID_BARRIER();
            STAMP(11);
        }
        RUN(PH_POST, layer);
        GRID_BARRIER();
        STAMP(4);
        RUN(PH_GEMM_OUT, layer);
        GRID_BARRIER();
        STAMP(5);
        RUN(PH_ROUTE, layer);
        GRID_BARRIER();
        STAMP(6);
        RUN(PH_MOE1, layer);
        GRID_BARRIER();
        STAMP(7);
        RUN(PH_MOE2, layer);
        GRID_BARRIER();
        STAMP(8);
        RUN(PH_COMBINE, layer);
        if (layer + 1 < DEPTH || PROBE_STAMP >= 0) GRID_BARRIER();
        STAMP(9);
    }
    if (PROBE_STAMP >= 0 && threadIdx.x == 0 && bid == 0) {
        volatile LAS unsigned long long* st_ = (volatile LAS unsigned long long*)(smem + LDS_BYTES + 16 + NPTR * 8);
        const unsigned long long t0 = wall_clock64(), span = st_[1];
        while (wall_clock64() - t0 < span * PROBE_MULT) __builtin_amdgcn_s_sleep(8);
    }
}

template <int PH>
static void launch_phase(const Params& p, int layer, int grid, hipStream_t stream) {
    static bool attr_set = false;
    if (!attr_set) { (void)hipFuncSetAttribute((const void*)k_phase<PH>, hipFuncAttributeMaxDynamicSharedMemorySize, LDS_BYTES); attr_set = true; }
    hipLaunchKernelGGL(k_phase<PH>, dim3(grid), dim3(NT), LDS_BYTES, stream, p, layer);
}

extern "C" void kernel_launch(void* const* d_in, const int* in_sizes, int n_in, void* d_out, int out_size, void* d_ws, size_t ws_size, hipStream_t stream) {
    if (n_in != 40 || ws_size < WS_END) { fprintf(stderr, "kernel_launch: unexpected inputs (n_in %d, ws %zu, need %zu)\n", n_in, ws_size, (size_t)WS_END); return; }
    Params p{};
    const float** pp = (const float**)&p;
    for (int i = 0; i < 40; ++i) pp[i] = (const float*)d_in[i];
    p.out = (float*)d_out; p.ws = (unsigned char*)d_ws;
    (void)hipMemsetAsync(d_ws, 0, WS_ZERO_BYTES, stream);
#if ONE_LAUNCH
    static int grid = 0;
    if (grid == 0) {
        int dev = 0, cus = 0, per_cu = 0;
        (void)hipGetDevice(&dev);
        (void)hipDeviceGetAttribute(&cus, hipDeviceAttributeMultiprocessorCount, dev);
        (void)hipFuncSetAttribute((const void*)k_mega, hipFuncAttributeMaxDynamicSharedMemorySize, MEGA_LDS);
        if (hipOccupancyMaxActiveBlocksPerMultiprocessor(&per_cu, (const void*)k_mega, NT, MEGA_LDS) != hipSuccess || per_cu < 1) per_cu = 1;
        (void)hipGetLastError();
        if (cus <= 0) cus = 256;
        grid = cus * (per_cu < 2 ? per_cu : 2);
    }
    hipLaunchKernelGGL(k_mega, dim3(grid), dim3(NT), MEGA_LDS, stream, p);
#else
    const int grid = 1024;
    launch_phase<PH_MODS>(p, 0, 512, stream);
    launch_phase<PH_COPY>(p, 0, grid, stream);
    launch_phase<PH_NORM1>(p, 0, grid, stream);
    for (int layer = 0; layer < DEPTH; ++layer) {
        launch_phase<PH_GEMM_IN>(p, layer, grid, stream);
        launch_phase<PH_ATTN>(p, layer, grid, stream);
        if ((layer & 1) == 0) { launch_phase<PH_PREP>(p, layer, grid, stream); launch_phase<PH_LORA>(p, layer, grid, stream); launch_phase<PH_SCAN>(p, layer, 512, stream); }
        launch_phase<PH_POST>(p, layer, grid, stream);
        launch_phase<PH_GEMM_OUT>(p, layer, grid, stream);
        launch_phase<PH_ROUTE>(p, layer, grid, stream);
        launch_phase<PH_MOE1>(p, layer, grid, stream);
        launch_phase<PH_MOE2>(p, layer, grid, stream);
        launch_phase<PH_COMBINE>(p, layer, grid, stream);
    }
#endif
}
```
